# Optimizing an MI355X kernel written in HIP

```python
import math
import jax, jax.numpy as jnp
from jax import lax
import numpy as np

D_MODEL = 1024
BATCH = 16
SEQ = 4096
DEPTH = 1

CHUNK = 64
CONV_W = 4
D_RNN = (4 * D_MODEL // 3) // 128 * 128
RNN_BLOCK_W = 128
RNN_BLOCKS = D_RNN // RNN_BLOCK_W
RG_C = 8.0
DN_HEAD_DIM = 128
DN_HEADS = D_MODEL // DN_HEAD_DIM
DN_W = DN_HEADS * DN_HEAD_DIM
N_MEM = 256
CA_HEADS = 4
CA_HEAD_DIM = D_MODEL // CA_HEADS
N_GROUPS = 8
EXPERTS_PER_GROUP = 8
N_EXPERTS = N_GROUPS * EXPERTS_PER_GROUP
TOP_K = 2
D_EXPERT = D_MODEL // 2
MOE_BLOCK = 256
EPS = 1e-6
IN_WIDTHS = (D_RNN, D_RNN, 3 * DN_W, DN_W, DN_HEADS, DN_HEADS, D_MODEL, D_MODEL)
D_IN = 2 * D_RNN + 4 * DN_W + 2 * DN_HEADS + 2 * D_MODEL

kernel_name = "hybrid_rglru_gdn_hmoe_block"


def rmsnorm(x, w):
    xf = x.astype(jnp.float32)
    y = xf * lax.rsqrt(jnp.mean(xf * xf, axis=-1, keepdims=True) + EPS)
    return (y * w.astype(jnp.float32)).astype(x.dtype)


def l2norm(x):
    return x * lax.rsqrt(jnp.sum(x * x, axis=-1, keepdims=True) + EPS)


def split_columns(t, widths):
    offsets = np.cumsum(widths)[:-1].tolist()
    return jnp.split(t, offsets, axis=-1)


def causal_dwconv(x, w):
    width = w.shape[0]
    s = x.shape[1]
    xp = jnp.pad(x, ((0, 0), (width - 1, 0), (0, 0)))
    return sum(xp[:, k:k + s] * w[k] for k in range(width))


def rglru(x, wa, ba, wx, bx, lam):
    bsz, s, c = x.shape
    xf = x.astype(jnp.float32)
    xb = xf.reshape(bsz, s, RNN_BLOCKS, RNN_BLOCK_W)
    r = jax.nn.sigmoid(jnp.einsum('bsnk,nkj->bsnj', xb, wa.astype(jnp.float32)).reshape(bsz, s, c) + ba)
    i = jax.nn.sigmoid(jnp.einsum('bsnk,nkj->bsnj', xb, wx.astype(jnp.float32)).reshape(bsz, s, c) + bx)
    log_a = -RG_C * r * jax.nn.softplus(-lam.astype(jnp.float32))
    a = jnp.exp(log_a)
    b = jnp.sqrt(-jnp.expm1(2.0 * log_a)) * (i * xf)

    def combine(left, right):
        a1, b1 = left
        a2, b2 = right
        return a1 * a2, a2 * b1 + b2

    _, h = lax.associative_scan(combine, (a, b), axis=1)
    return h.astype(x.dtype)


def gated_delta_rule(q, k, v, g, beta):
    bsz, s, h, dk = q.shape
    dv = v.shape[-1]
    nc = s // CHUNK
    out_dtype = v.dtype

    def to_chunks(t):
        t = jnp.moveaxis(t.astype(jnp.float32), 2, 1)
        return t.reshape((bsz, h, nc, CHUNK) + t.shape[3:])

    q = to_chunks(q) * (dk ** -0.5)
    k = to_chunks(k)
    v = to_chunks(v)
    beta = to_chunks(beta)
    g = jnp.cumsum(to_chunks(g), axis=-1)
    idx = jnp.arange(CHUNK)
    causal = idx[:, None] >= idx[None, :]
    strict = idx[:, None] > idx[None, :]
    decay = jnp.exp(jnp.where(causal, g[..., :, None] - g[..., None, :], -jnp.inf))
    k_beta = k * beta[..., None]
    v_beta = v * beta[..., None]
    lower = jnp.where(strict, jnp.einsum('bhncd,bhnmd->bhncm', k_beta, k) * decay, 0.0)
    eye = jnp.eye(CHUNK, dtype=jnp.float32)
    t_mat = lax.linalg.triangular_solve(lower + eye, jnp.broadcast_to(eye, lower.shape),
                                        left_side=True, lower=True)
    u = jnp.einsum('bhncm,bhnmv->bhncv', t_mat, v_beta)
    w = jnp.einsum('bhncm,bhnmk->bhnck', t_mat, k_beta * jnp.exp(g)[..., None])
    intra = jnp.where(causal, jnp.einsum('bhncd,bhnmd->bhncm', q, k) * decay, 0.0)
    q_dec = q * jnp.exp(g)[..., None]
    k_dec = k * jnp.exp(g[..., -1:] - g)[..., None]
    g_last = jnp.exp(g[..., -1])

    def step(state, inp):
        u_c, w_c, intra_c, qd_c, kd_c, gl_c = inp
        v_new = u_c - jnp.einsum('bhck,bhkv->bhcv', w_c, state)
        o_c = jnp.einsum('bhck,bhkv->bhcv', qd_c, state) + jnp.einsum('bhcm,bhmv->bhcv', intra_c, v_new)
        state = state * gl_c[..., None, None] + jnp.einsum('bhck,bhcv->bhkv', kd_c, v_new)
        return state, o_c

    xs = tuple(jnp.moveaxis(t, 2, 0) for t in (u, w, intra, q_dec, k_dec, g_last))
    state0 = jnp.zeros((bsz, h, dk, dv), jnp.float32)
    _, o = lax.scan(step, state0, xs)
    o = jnp.moveaxis(o, 0, 2).reshape(bsz, h, s, dv)
    return jnp.transpose(o, (0, 2, 1, 3)).astype(out_dtype)


def memory_cross_attention(u, mem_n, w_q, w_kv, w_o):
    bsz, s, _ = u.shape
    n_mem = mem_n.shape[1]
    q = (u @ w_q).reshape(bsz, s, CA_HEADS, CA_HEAD_DIM)
    kv = (mem_n @ w_kv).reshape(bsz, n_mem, 2, CA_HEADS, CA_HEAD_DIM)
    k, v = kv[:, :, 0], kv[:, :, 1]
    scores = jnp.einsum('bshd,bmhd->bhsm', q.astype(jnp.float32), k.astype(jnp.float32)) * (CA_HEAD_DIM ** -0.5)
    p = jax.nn.softmax(scores, axis=-1)
    o = jnp.einsum('bhsm,bmhd->bshd', p, v.astype(jnp.float32)).astype(u.dtype)
    return o.reshape(bsz, s, CA_HEADS * CA_HEAD_DIM) @ w_o


def hierarchical_moe(u, wg, bg, we, be, w_gate, w_up, w_down):
    bsz, s, d = u.shape
    n = bsz * s
    t = u.reshape(n, d)
    tf = t.astype(jnp.float32)
    grp_logits = tf @ wg.astype(jnp.float32) + bg
    grp_prob = jax.nn.softmax(grp_logits, axis=-1)
    _, grp = lax.top_k(grp_logits, 1)
    p_grp = jnp.take_along_axis(grp_prob, grp, axis=1)
    exp_logits = (tf @ we.astype(jnp.float32) + be).reshape(n, N_GROUPS, EXPERTS_PER_GROUP)
    in_grp = jnp.take_along_axis(exp_logits, grp[:, :, None], axis=1)[:, 0]
    p_in = jax.nn.softmax(in_grp, axis=-1)
    top_p, top_i = lax.top_k(p_in, TOP_K)
    top_p = top_p / jnp.sum(top_p, axis=-1, keepdims=True)
    expert = grp * EXPERTS_PER_GROUP + top_i
    weight = p_grp * top_p

    nk = n * TOP_K
    flat_e = expert.reshape(nk)
    flat_tok = jnp.repeat(jnp.arange(n), TOP_K)
    flat_w = weight.reshape(nk)
    order = jnp.argsort(flat_e)
    se, stok, sw = flat_e[order], flat_tok[order], flat_w[order]
    counts = jnp.bincount(flat_e, length=N_EXPERTS)
    padded = (counts + MOE_BLOCK - 1) // MOE_BLOCK * MOE_BLOCK
    start = jnp.cumsum(counts) - counts
    pend = jnp.cumsum(padded)
    pstart = pend - padded
    dest = pstart[se] + jnp.arange(nk) - start[se]
    n_blocks = (nk + N_EXPERTS * (MOE_BLOCK - 1)) // MOE_BLOCK
    rows = n_blocks * MOE_BLOCK
    xs = jnp.zeros((rows, d), t.dtype).at[dest].set(t[stok])
    block_e = jnp.clip(jnp.searchsorted(pend, jnp.arange(n_blocks) * MOE_BLOCK, side='right'), 0, N_EXPERTS - 1)

    def expert_block(args):
        xb, e = args
        hid = jax.nn.silu(xb @ w_gate[e]) * (xb @ w_up[e])
        return hid @ w_down[e]

    yb = lax.map(expert_block, (xs.reshape(n_blocks, MOE_BLOCK, d), block_e))
    y = yb.reshape(rows, d)[dest] * sw[:, None].astype(t.dtype)
    out = jax.ops.segment_sum(y, stok, num_segments=n)
    return out.reshape(bsz, s, d)


def setup_inputs(seed: int = 0) -> dict:
    key = jax.random.key(seed)
    ks = jax.random.split(key, 40)
    f32 = jnp.float32
    L = DEPTH

    def nrm(k, shape, scale):
        return jax.random.normal(k, shape, f32) * scale

    def gain(k, shape):
        return 1.0 + 0.05 * jax.random.normal(k, shape, f32)

    lam_u = jax.random.uniform(ks[10], (L, D_RNN), f32, 0.9, 0.999)
    lam_a = lam_u ** (1.0 / RG_C)
    dt = jnp.exp(jax.random.uniform(ks[14], (L, DN_HEADS), f32, math.log(1e-3), math.log(1e-1)))
    return {
        "x": nrm(ks[0], (BATCH, SEQ, D_MODEL), 1.0),
        "mem": nrm(ks[1], (BATCH, N_MEM, D_MODEL), 1.0),
        "norm1_w": gain(ks[2], (L, D_MODEL)),
        "w_in": nrm(ks[3], (L, D_MODEL, D_IN), D_MODEL ** -0.5),
        "rnn_conv_w": nrm(ks[4], (L, CONV_W, D_RNN), CONV_W ** -0.5),
        "rnn_conv_b": nrm(ks[5], (L, D_RNN), 0.02),
        "rglru_wa": nrm(ks[6], (L, RNN_BLOCKS, RNN_BLOCK_W, RNN_BLOCK_W), RNN_BLOCK_W ** -0.5),
        "rglru_ba": nrm(ks[7], (L, D_RNN), 0.02),
        "rglru_wx": nrm(ks[8], (L, RNN_BLOCKS, RNN_BLOCK_W, RNN_BLOCK_W), RNN_BLOCK_W ** -0.5),
        "rglru_bx": nrm(ks[9], (L, D_RNN), 0.02),
        "rglru_lambda": jnp.log(lam_a) - jnp.log1p(-lam_a),
        "w_branch_a": nrm(ks[11], (L, D_RNN, D_MODEL), D_RNN ** -0.5),
        "dn_conv_w": nrm(ks[12], (L, CONV_W, 3 * DN_W), CONV_W ** -0.5),
        "dn_a_log": jnp.log(jax.random.uniform(ks[13], (L, DN_HEADS), f32, 1.0, 16.0)),
        "dn_dt_bias": dt + jnp.log(-jnp.expm1(-dt)),
        "dn_norm_w": gain(ks[15], (L, DN_HEAD_DIM)),
        "w_branch_b": nrm(ks[16], (L, DN_W, D_MODEL), DN_W ** -0.5),
        "w_out": nrm(ks[17], (L, D_MODEL, D_MODEL), D_MODEL ** -0.5),
        "norm2_w": gain(ks[18], (L, D_MODEL)),
        "mem_norm_w": gain(ks[19], (L, D_MODEL)),
        "w_cq": nrm(ks[20], (L, D_MODEL, CA_HEADS * CA_HEAD_DIM), D_MODEL ** -0.5),
        "w_ckv": nrm(ks[21], (L, D_MODEL, 2 * CA_HEADS * CA_HEAD_DIM), D_MODEL ** -0.5),
        "w_co": nrm(ks[22], (L, CA_HEADS * CA_HEAD_DIM, D_MODEL), D_MODEL ** -0.5),
        "norm3_w": gain(ks[23], (L, D_MODEL)),
        "w_router_group": nrm(ks[24], (L, D_MODEL, N_GROUPS), D_MODEL ** -0.5),
        "b_router_group": nrm(ks[25], (L, N_GROUPS), 0.01),
        "w_router_expert": nrm(ks[26], (L, D_MODEL, N_EXPERTS), D_MODEL ** -0.5),
        "b_router_expert": nrm(ks[27], (L, N_EXPERTS), 0.01),
        "w_exp_gate": nrm(ks[28], (L, N_EXPERTS, D_MODEL, D_EXPERT), D_MODEL ** -0.5),
        "w_exp_up": nrm(ks[29], (L, N_EXPERTS, D_MODEL, D_EXPERT), D_MODEL ** -0.5),
        "w_exp_down": nrm(ks[30], (L, N_EXPERTS, D_EXPERT, D_MODEL), D_EXPERT ** -0.5),
        "norm_f_w": gain(ks[31], (D_MODEL,)),
    }


def reference(x, mem, norm1_w, w_in, rnn_conv_w, rnn_conv_b, rglru_wa, rglru_ba, rglru_wx, rglru_bx,
              rglru_lambda, w_branch_a, dn_conv_w, dn_a_log, dn_dt_bias, dn_norm_w, w_branch_b, w_out,
              norm2_w, mem_norm_w, w_cq, w_ckv, w_co, norm3_w, w_router_group, b_router_group,
              w_router_expert, b_router_expert, w_exp_gate, w_exp_up, w_exp_down, norm_f_w):
    bsz, s, _ = x.shape
    h = x
    for l in range(DEPTH):
        u = rmsnorm(h, norm1_w[l])
        rx, rg, qkv, z, a_in, b_in, ga, gb = split_columns(u @ w_in[l], IN_WIDTHS)

        rx = causal_dwconv(rx, rnn_conv_w[l]) + rnn_conv_b[l]
        h_rnn = rglru(rx, rglru_wa[l], rglru_ba[l], rglru_wx[l], rglru_bx[l], rglru_lambda[l])
        y_a = (jax.nn.gelu(rg) * h_rnn) @ w_branch_a[l]

        qkv = jax.nn.silu(causal_dwconv(qkv, dn_conv_w[l]))
        q, k, v = jnp.split(qkv, 3, axis=-1)
        q = l2norm(q.reshape(bsz, s, DN_HEADS, DN_HEAD_DIM).astype(jnp.float32))
        k = l2norm(k.reshape(bsz, s, DN_HEADS, DN_HEAD_DIM).astype(jnp.float32))
        v = v.reshape(bsz, s, DN_HEADS, DN_HEAD_DIM)
        g = -jnp.exp(dn_a_log[l].astype(jnp.float32)) * jax.nn.softplus(a_in.astype(jnp.float32) + dn_dt_bias[l])
        beta = jax.nn.sigmoid(b_in.astype(jnp.float32))
        o = gated_delta_rule(q, k, v, g, beta)
        o = rmsnorm(o, dn_norm_w[l]) * jax.nn.silu(z.reshape(bsz, s, DN_HEADS, DN_HEAD_DIM))
        y_b = o.reshape(bsz, s, DN_W) @ w_branch_b[l]

        h = h + (jax.nn.sigmoid(ga) * y_a + jax.nn.sigmoid(gb) * y_b) @ w_out[l]

        h = h + memory_cross_attention(rmsnorm(h, norm2_w[l]), rmsnorm(mem, mem_norm_w[l]),
                                       w_cq[l], w_ckv[l], w_co[l])

        h = h + hierarchical_moe(rmsnorm(h, norm3_w[l]), w_router_group[l], b_router_group[l],
                                 w_router_expert[l], b_router_expert[l],
                                 w_exp_gate[l], w_exp_up[l], w_exp_down[l])
    return rmsnorm(h, norm_f_w)
```

```cpp
#include <hip/hip_runtime.h>
#include <cstdio>
#include <cstdint>

#ifndef DBG_STAGE
#define DBG_STAGE 0
#endif
#ifndef MK_N_LAUNCHES
#define MK_N_LAUNCHES 1
#endif

#define GAS __attribute__((address_space(1)))
#define LAS __attribute__((address_space(3)))
typedef unsigned short bf16;
typedef short bf16x8 __attribute__((ext_vector_type(8)));
typedef short bf16x4 __attribute__((ext_vector_type(4)));
typedef float f32x4 __attribute__((ext_vector_type(4)));
typedef float f32x2 __attribute__((ext_vector_type(2)));
typedef unsigned u32x4 __attribute__((ext_vector_type(4)));
typedef unsigned u32x2 __attribute__((ext_vector_type(2)));

constexpr int D = 1024, NB = 16, SEQ = 4096, NTOK = NB * SEQ;
constexpr int DRNN = 1280, NHD = 8, HD = 128, NMEM = 256, CAH = 4, CAD = 256;
constexpr int DIN = 8720;
constexpr int LDP = 5632;
constexpr int RXOFF = 0, RGOFF = 1280, QOFF = 2560, KOFF = 3584, VOFF = 4608;
constexpr int N1A = 5888, N1B = 3072;
constexpr int NEXP = 64, DEXP = 512;
constexpr int MAXTILES = 576;
constexpr float EPS = 1e-6f;

constexpr size_t MiB = 1u << 20;
constexpr size_t WS_CTL = 0;
constexpr size_t CTL_ZERO_BYTES = 256 * 1024;
constexpr size_t WS_S2TK = 1 * MiB;
constexpr size_t S2TK_BYTES = (size_t)MAXTILES * 256 * 4;
constexpr size_t WS_P1 = 4 * MiB;
constexpr size_t WS_WGU = 708 * MiB;
constexpr size_t WS_WD = 836 * MiB;
constexpr size_t WS_B1A = 900 * MiB;
constexpr size_t WS_B1B = 912 * MiB;
constexpr size_t WS_WAT = 918 * MiB;
constexpr size_t WS_WBT = 921 * MiB;
constexpr size_t WS_WOT = 923 * MiB;
constexpr size_t WS_WCQT = 925 * MiB;
constexpr size_t WS_WKVT = 927 * MiB;
constexpr size_t WS_WCOT = 931 * MiB;
constexpr size_t WS_G = 933 * MiB;
constexpr size_t WS_BETA = 935 * MiB;
constexpr size_t WS_KV = 937 * MiB;
constexpr size_t WS_VT = 953 * MiB;
constexpr size_t WS_MEMN = 961 * MiB;
constexpr size_t WS_WRT = 969 * MiB;
constexpr size_t WS_RSTD3 = 970 * MiB;
constexpr size_t WS_TOKE = 971 * MiB;
constexpr size_t WS_TOKW = 972 * MiB;
constexpr size_t WS_RGW = 973 * MiB;
constexpr size_t WS_END = 974 * MiB;
constexpr size_t WS_U2 = WS_P1, WS_QC = WS_P1 + 128 * MiB, WS_AO = WS_P1 + 256 * MiB;
constexpr size_t WS_XS = WS_P1, WS_HID = WS_P1 + 288 * MiB, WS_YE = WS_P1 + 432 * MiB;
constexpr int CW_BAR = 4096;
constexpr int CW_CNT = 8192;
constexpr int CW_FILL = 8192 + 64;

constexpr int LDS_BYTES = 159744;
constexpr int LDS_MISC = LDS_BYTES - 64;
constexpr int LDS_T2E = 131072;

#define LDS_WAIT() asm volatile("s_waitcnt lgkmcnt(0)" ::: "memory")
#define VM_WAIT() asm volatile("s_waitcnt vmcnt(0)" ::: "memory")
#define MFMA(x, y, c) __builtin_amdgcn_mfma_f32_16x16x32_bf16((x), (y), (c), 0, 0, 0)
typedef __bf16 bf16v2 __attribute__((ext_vector_type(2)));
__device__ __forceinline__ unsigned cvt_pk_bf16(float lo, float hi) { const f32x2 v = {lo, hi}; const bf16v2 r = __builtin_convertvector(v, bf16v2); return __builtin_bit_cast(unsigned, r); }
__device__ __forceinline__ bf16 f2bf(float f) { return (bf16)(cvt_pk_bf16(f, 0.f) & 0xffffu); }
__device__ __forceinline__ float bf2f(unsigned b) { return __uint_as_float(b << 16); }
__device__ __forceinline__ float bflo(unsigned w) { return __uint_as_float(w << 16); }
__device__ __forceinline__ float bfhi(unsigned w) { return __uint_as_float(w & 0xffff0000u); }
__device__ __forceinline__ void unpack8(const u32x4 w, float* f) { f[0] = bflo(w.x); f[1] = bfhi(w.x); f[2] = bflo(w.y); f[3] = bfhi(w.y); f[4] = bflo(w.z); f[5] = bfhi(w.z); f[6] = bflo(w.w); f[7] = bfhi(w.w); }
__device__ __forceinline__ u32x4 pack8(const f32x4 a, const f32x4 b) { u32x4 w; w.x = cvt_pk_bf16(a[0], a[1]); w.y = cvt_pk_bf16(a[2], a[3]); w.z = cvt_pk_bf16(b[0], b[1]); w.w = cvt_pk_bf16(b[2], b[3]); return w; }
__device__ __forceinline__ bf16x8 pack8v(const f32x4 a, const f32x4 b) { const u32x4 w = pack8(a, b); return __builtin_bit_cast(bf16x8, w); }
__device__ __forceinline__ float sigmoidf_(float x) { return 1.0f / (1.0f + __expf(-x)); }
__device__ __forceinline__ float siluf_(float x) { return x / (1.0f + __expf(-x)); }
__device__ __forceinline__ float softplusf_(float x) { return x > 20.f ? x : log1pf(__expf(x)); }
__device__ __forceinline__ float gelu_tanh(float x) { const float u = 1.5957691216057308f * (x + 0.044715f * x * x * x); return x / (1.0f + __expf(-u)); }
__device__ __forceinline__ float wave_sum(float v) {
#pragma unroll
    for (int o = 1; o < 64; o <<= 1) v += __shfl_xor(v, o);
    return v;
}

#define XB_TMO      128
#define XB_XCNT(j)  (256  + 64 * (j))
#define XB_XSUB(j)  (1280 + 64 * (j))
#define XB_XGEN(j)  (2304 + 64 * (j))
#define XB_TOP      3328
#define XB_TOPGEN   3392
#define XCD_BAR_WORDS 3456
#define XB_SPIN_CAP (1u << 18)
__device__ __forceinline__ unsigned xb_ld(unsigned* p)              { return __hip_atomic_load(p, __ATOMIC_RELAXED, __HIP_MEMORY_SCOPE_AGENT); }
__device__ __forceinline__ unsigned xb_add(unsigned* p, unsigned v) { return __hip_atomic_fetch_add(p, v, __ATOMIC_RELAXED, __HIP_MEMORY_SCOPE_AGENT); }
__device__ __forceinline__ unsigned xb_xcc_id() { return (unsigned)__builtin_amdgcn_s_getreg((3 << 11) | 20) & 0xFu; }
#define XB_SPIN(cond, bar) do { unsigned _sp = 0; while (cond) { __builtin_amdgcn_s_sleep(1); \
    if ((++_sp & 255u) == 0u) { if (xb_ld(&(bar)[XB_TMO])) break; if (_sp > XB_SPIN_CAP) { atomicAdd(&(bar)[XB_TMO], 1u); break; } } } } while (0)
struct XcdBarrier { unsigned* bar; unsigned x; volatile LAS unsigned* st; };
__device__ __forceinline__ XcdBarrier xcd_barrier_post(unsigned* bar, volatile LAS unsigned* st) {
    XcdBarrier b; b.bar = bar; b.x = xb_xcc_id(); b.st = st;
    if (threadIdx.x == 0) (void)xb_add(&bar[XB_XCNT(b.x)], 1u);
    return b;
}
__device__ __forceinline__ void xcd_barrier_complete(unsigned* bar, unsigned x, unsigned& nloc, unsigned& nx) {
    const unsigned G = gridDim.x * gridDim.y * gridDim.z;
    unsigned sum, cnt, mine, sp = 0u;
    for (;;) {
        sum = 0u; cnt = 0u; mine = 0u;
#pragma unroll
        for (unsigned j = 0; j < 16; ++j) { const unsigned c = xb_ld(&bar[XB_XCNT(j)]); sum += c; cnt += (c > 0u) ? 1u : 0u; mine = (j == x) ? c : mine; }
        if (sum == G) break;
        __builtin_amdgcn_s_sleep(1);
        if ((++sp & 255u) == 0u) { if (xb_ld(&bar[XB_TMO])) break; if (sp > XB_SPIN_CAP) { atomicAdd(&bar[XB_TMO], 1u); break; } }
    }
    nloc = mine > 0u ? mine : 1u; nx = cnt > 0u ? cnt : 1u;
}
__device__ __forceinline__ void xcd_barrier(const XcdBarrier& b) {
    asm volatile("s_waitcnt vmcnt(0)" ::: "memory");
    __syncthreads();
    if (threadIdx.x == 0) {
        unsigned* bar = b.bar;
        __builtin_amdgcn_s_waitcnt(0);
        unsigned nloc = b.st[0], nx = b.st[1];
        if (nloc == 0u) { xcd_barrier_complete(bar, b.x, nloc, nx); b.st[0] = nloc; b.st[1] = nx; }
        const unsigned old = xb_add(&bar[XB_XSUB(b.x)], 1u);
        const unsigned gen = old / nloc;
        if (old + 1u == (gen + 1u) * nloc) {
            __builtin_amdgcn_fence(__ATOMIC_RELEASE, "agent");
            asm volatile("s_waitcnt vmcnt(0)" ::: "memory");
            const unsigned og = xb_add(&bar[XB_TOP], 1u);
            const unsigned tg = og / nx;
            if (og + 1u == (tg + 1u) * nx) xb_add(&bar[XB_TOPGEN], 1u);
            else XB_SPIN(xb_ld(&bar[XB_TOPGEN]) == tg, bar);
            __builtin_amdgcn_fence(__ATOMIC_ACQUIRE, "agent");
            xb_add(&bar[XB_XGEN(b.x)], 1u);
            asm volatile("s_waitcnt vmcnt(0)" ::: "memory");
        } else {
            XB_SPIN(xb_ld(&bar[XB_XGEN(b.x)]) == gen, bar);
            __builtin_amdgcn_fence(__ATOMIC_ACQUIRE, "agent");
            asm volatile("s_waitcnt vmcnt(0)" ::: "memory");
        }
    }
    __syncthreads();
}

namespace pg8 {
constexpr int BM = 256, BK = 64, HALF = 128, HTB = HALF * BK * 2, STAGE_BYTES = 8 * HTB, NXCD = 8, WGM = 8;
__host__ __device__ __forceinline__ int lds_byte(int r, int c) { const int st = (r >> 4) * 2 + (c >> 5), rr = r & 15, cc = c & 31, ob = rr * 64 + cc * 2; return st * 1024 + (ob ^ (((ob >> 9) & 1) << 5)); }
__host__ __device__ __forceinline__ void stage_rc(int b, int& R, int& C) { const int st = b / 1024, sb = b % 1024, swz = sb ^ (((sb >> 9) & 1) << 5); R = (st >> 1) * 16 + swz / 64; C = (st & 1) * 32 + (swz % 64) / 2; }
__host__ __device__ __forceinline__ int perm32(int rho) { const int n = rho >> 4, i = rho & 15; return 8 * (i >> 2) + 4 * n + (i & 3); }
struct Unit { int pm, pn; };
struct Gemm { int lda, ldb, K; };

struct DenseOrder {
    int nM, nN, nwg, G, c; const char* A; const char* B; size_t atile, btile;
    __device__ void init(int nM_, int nN_, int G_, int c_, const void* A_, size_t lda, const void* B_, size_t ldb) { nM = nM_; nN = nN_; nwg = nM * nN; G = G_; c = c_; A = (const char*)A_; B = (const char*)B_; atile = 256 * lda * 2; btile = 256 * ldb * 2; }
    __device__ bool next(int i, Unit& u) const {
        const long L = (long)i * G + c; if (L >= nwg) return false;
        int wgid = (int)L; { const int q = nwg / NXCD, r = nwg % NXCD, xcd = wgid % NXCD, off = wgid / NXCD; wgid = (xcd < r ? xcd * (q + 1) : r * (q + 1) + (xcd - r) * q) + off; }
        const int nig = WGM * nN, gid = wgid / nig, fm = gid * WGM, gsz = (nM - fm) < WGM ? (nM - fm) : WGM;
        u.pm = fm + ((wgid % nig) % gsz); u.pn = (wgid % nig) / gsz; return true;
    }
    __device__ __forceinline__ const char* aptr(const Unit& u) const { return A + (size_t)u.pm * atile; }
    __device__ __forceinline__ const char* bptr(const Unit& u) const { return B + (size_t)u.pn * btile; }
};
struct MoeOrder : DenseOrder {
    const LAS unsigned char* t2e; size_t ebytes;
    __device__ __forceinline__ const char* bptr(const Unit& u) const { return B + (size_t)t2e[u.pm] * ebytes + (size_t)u.pn * btile; }
};

template <class F> struct EpiPerm {
    static constexpr bool PERM = true; F f;
    __device__ __forceinline__ void operator()(const f32x4 (&acc)[2][2][4][2], const Unit& u, int wr, int wc, int fr, int fq) const {
#pragma unroll
        for (int ai = 0; ai < 2; ++ai)
#pragma unroll
            for (int m = 0; m < 4; ++m) f(u, ai * HALF + wr * 64 + m * 16 + fr, wc * 32 + 8 * fq, acc[ai][0][m][0], acc[ai][0][m][1], acc[ai][1][m][0], acc[ai][1][m][1]);
    }
};
template <class F> struct EpiPlain {
    static constexpr bool PERM = false; F f;
    __device__ __forceinline__ void operator()(const f32x4 (&acc)[2][2][4][2], const Unit& u, int wr, int wc, int fr, int fq) const {
#pragma unroll
        for (int ai = 0; ai < 2; ++ai)
#pragma unroll
            for (int m = 0; m < 4; ++m)
#pragma unroll
                for (int bj = 0; bj < 2; ++bj)
#pragma unroll
                    for (int n = 0; n < 2; ++n) f(u, ai * HALF + wr * 64 + m * 16 + fr, bj * HALF + wc * 32 + n * 16 + 4 * fq, acc[ai][bj][m][n]);
    }
};

template <class Epi, class Sched>
__device__ __forceinline__ void gemm_phase(LAS unsigned char* lds, const Gemm g, const Sched& S, const Epi& E) {
    const int tid = threadIdx.x, wid = __builtin_amdgcn_readfirstlane(tid >> 6), lane = tid & 63, wr = wid >> 2, wc = wid & 3, fr = lane & 15, fq = lane >> 4;
    const int K = g.K, nt = K / BK;
    unsigned voffA[2], voffB[2];
#pragma unroll
    for (int i = 0; i < 2; ++i) { int R, C; stage_rc(tid * 16 + i * 8192, R, C); const int Rb = Epi::PERM ? ((R & ~31) + perm32(R & 31)) : R;
        voffA[i] = (unsigned)(R * g.lda + C) * 2u; voffB[i] = (unsigned)(Rb * g.ldb + C) * 2u; }
    const size_t kstep = (size_t)(BK * 2);
    const size_t hstepA = (size_t)HALF * g.lda * 2, hstepB = (size_t)HALF * g.ldb * 2;
    const unsigned ldsw = (unsigned)wid * 1024u;
    const int aoff = lds_byte(wr * 64 + fr, fq * 8), boff = lds_byte(wc * 32 + fr, fq * 8);
#define PG8_SA(b, h) (((b) * 2 + (h)) * HTB)
#define PG8_SB(b, h) ((4 + (b) * 2 + (h)) * HTB)
#define PG8_STAGE(bufoff, gbase, voff) do { _Pragma("unroll") for (int _i = 0; _i < 2; ++_i) \
        __builtin_amdgcn_global_load_lds((const unsigned*)((const char*)(gbase) + (voff)[_i]), (LAS unsigned*)(lds + (bufoff) + ldsw + _i * 8192), 16, 0, 0); } while (0)
#define PG8_LDA(dst, b, h) do { _Pragma("unroll") for (int m = 0; m < 4; ++m) _Pragma("unroll") for (int k = 0; k < 2; ++k) dst[m][k] = *(const LAS bf16x8*)(lds + PG8_SA(b, h) + aoff + m * 2048 + k * 1024); } while (0)
#define PG8_LDB(dst, b, h) do { _Pragma("unroll") for (int n = 0; n < 2; ++n) _Pragma("unroll") for (int k = 0; k < 2; ++k) dst[n][k] = *(const LAS bf16x8*)(lds + PG8_SB(b, h) + boff + n * 2048 + k * 1024); } while (0)
#define PG8_MMA(ai, bj, At, Bt) do { __builtin_amdgcn_s_setprio(1); _Pragma("unroll") for (int m = 0; m < 4; ++m) _Pragma("unroll") for (int n = 0; n < 2; ++n) _Pragma("unroll") for (int k = 0; k < 2; ++k) \
        acc[ai][bj][m][n] = __builtin_amdgcn_mfma_f32_16x16x32_bf16(Bt[n][k], At[m][k], acc[ai][bj][m][n], 0, 0, 0); __builtin_amdgcn_s_setprio(0); } while (0)
#define PG8_WAIT_V(n) asm volatile("s_waitcnt vmcnt(" #n ")" ::: "memory")
#define PG8_WAIT_L(n) asm volatile("s_waitcnt lgkmcnt(" #n ")" ::: "memory")
#define PG8_BAR __builtin_amdgcn_s_barrier()
#define PG8_SCHED __builtin_amdgcn_sched_barrier(0)
    Unit cur, nxt; int ui = 0;
    if (!S.next(0, cur)) return;
    f32x4 acc[2][2][4][2];
#pragma unroll
    for (int a = 0; a < 2; ++a)
#pragma unroll
        for (int b = 0; b < 2; ++b)
#pragma unroll
            for (int m = 0; m < 4; ++m)
#pragma unroll
                for (int n = 0; n < 2; ++n) acc[a][b][m][n] = (f32x4){0.f, 0.f, 0.f, 0.f};
    bf16x8 At[4][2], B0[2][2], B1[2][2];
    const char* cA = S.aptr(cur); const char* cB = S.bptr(cur);
    PG8_STAGE(PG8_SB(0, 0), cB, voffB); PG8_STAGE(PG8_SB(0, 1), cB + hstepB, voffB); PG8_STAGE(PG8_SA(0, 0), cA, voffA); PG8_STAGE(PG8_SA(0, 1), cA + hstepA, voffA);
    if (wr == 1) PG8_BAR;
    PG8_WAIT_V(2); PG8_BAR;
    PG8_STAGE(PG8_SB(1, 0), cB + kstep, voffB); PG8_STAGE(PG8_SA(1, 0), cA + kstep, voffA); PG8_STAGE(PG8_SB(1, 1), cB + hstepB + kstep, voffB);
    PG8_WAIT_V(6); PG8_BAR;
    for (;;) {
        const bool has_next = S.next(ui + 1, nxt);
        const char* nA = has_next ? S.aptr(nxt) : cA; const char* nB = has_next ? S.bptr(nxt) : cB;
        for (int t = 0; t < nt; t += 2) {
            const bool last = (t == nt - 2);
            const char* a1 = cA + (size_t)(t + 1) * kstep;
            const char* a2 = last ? nA : cA + (size_t)(t + 2) * kstep; const char* b2 = last ? nB : cB + (size_t)(t + 2) * kstep;
            const char* a3 = a2 + kstep; const char* b3 = b2 + kstep;
            PG8_LDB(B0, 0, 0); PG8_LDB(B1, 0, 1); PG8_SCHED; PG8_LDA(At, 0, 0); PG8_STAGE(PG8_SA(1, 1), a1 + hstepA, voffA);
            PG8_WAIT_V(8); PG8_WAIT_L(0); PG8_BAR; PG8_MMA(0, 0, At, B0); PG8_MMA(0, 1, At, B1); PG8_BAR; PG8_SCHED;
            PG8_LDA(At, 0, 1); PG8_STAGE(PG8_SB(0, 0), b2, voffB); PG8_STAGE(PG8_SB(0, 1), b2 + hstepB, voffB); PG8_STAGE(PG8_SA(0, 0), a2, voffA);
            PG8_WAIT_V(8); PG8_WAIT_L(0); PG8_BAR; PG8_MMA(1, 0, At, B0); PG8_MMA(1, 1, At, B1); PG8_BAR; PG8_SCHED;
            PG8_LDB(B0, 1, 0); PG8_LDB(B1, 1, 1); PG8_SCHED; PG8_LDA(At, 1, 0); PG8_STAGE(PG8_SA(0, 1), a2 + hstepA, voffA);
            PG8_WAIT_V(8); PG8_WAIT_L(0); PG8_BAR; PG8_MMA(0, 0, At, B0); PG8_MMA(0, 1, At, B1); PG8_BAR; PG8_SCHED;
            PG8_LDA(At, 1, 1); PG8_STAGE(PG8_SB(1, 0), b3, voffB); PG8_STAGE(PG8_SB(1, 1), b3 + hstepB, voffB); PG8_STAGE(PG8_SA(1, 0), a3, voffA);
            PG8_WAIT_V(8); PG8_WAIT_L(0); PG8_BAR; PG8_MMA(1, 0, At, B0); PG8_MMA(1, 1, At, B1); PG8_BAR; PG8_SCHED;
        }
        if (wr == 0) PG8_BAR;
        E(acc, cur, wr, wc, fr, fq);
        if (!has_next) break;
#pragma unroll
        for (int a = 0; a < 2; ++a)
#pragma unroll
            for (int b = 0; b < 2; ++b)
#pragma unroll
                for (int m = 0; m < 4; ++m)
#pragma unroll
                    for (int n = 0; n < 2; ++n) acc[a][b][m][n] = (f32x4){0.f, 0.f, 0.f, 0.f};
        cur = nxt; cA = nA; cB = nB; ++ui;
        if (wr == 1) PG8_BAR;
    }
    PG8_WAIT_V(0);
    PG8_BAR;
#undef PG8_SA
#undef PG8_SB
#undef PG8_STAGE
#undef PG8_LDA
#undef PG8_LDB
#undef PG8_MMA
#undef PG8_WAIT_V
#undef PG8_WAIT_L
#undef PG8_BAR
#undef PG8_SCHED
}
}
using pg8::Unit;

__device__ __forceinline__ void st8(bf16* p, const f32x4 a, const f32x4 b) { *(u32x4*)p = pack8(a, b); }
struct F1a {
    bf16* P1; float* gbuf; float* betabuf;
    __device__ __forceinline__ void operator()(const Unit& u, int r, int c, const f32x4 a0, const f32x4 a1, const f32x4 b0, const f32x4 b1) const {
        const size_t row = (size_t)u.pm * 256 + r;
        if (u.pn < 22) { bf16* p = P1 + row * LDP + u.pn * 256 + c; st8(p, a0, a1); st8(p + 128, b0, b1); }
        else if (c == 0) { *(f32x4*)(gbuf + row * 8) = a0; *(f32x4*)(gbuf + row * 8 + 4) = a1; }
        else if (c == 8) { *(f32x4*)(betabuf + row * 8) = a0; *(f32x4*)(betabuf + row * 8 + 4) = a1; }
    }
};
struct F1b {
    bf16* P1;
    __device__ __forceinline__ void zmul(bf16* p, const f32x4 a, const f32x4 b) const {
        const u32x4 w = *(const u32x4*)p; float o[8]; unpack8(w, o); f32x4 x, y;
#pragma unroll
        for (int j = 0; j < 4; ++j) { x[j] = o[j] * siluf_(a[j]); y[j] = o[4 + j] * siluf_(b[j]); }
        st8(p, x, y);
    }
    __device__ __forceinline__ void operator()(const Unit& u, int r, int c, const f32x4 a0, const f32x4 a1, const f32x4 b0, const f32x4 b1) const {
        bf16* rowp = P1 + ((size_t)u.pm * 256 + r) * LDP;
        if (u.pn < 4) { bf16* p = rowp + VOFF + u.pn * 256 + c; zmul(p, a0, a1); zmul(p + 128, b0, b1); }
        else if (u.pn < 8) { bf16* p = rowp + KOFF + (u.pn - 4) * 256 + c; st8(p, a0, a1); st8(p + 128, b0, b1); }
        else { bf16* p = rowp + RGOFF + (u.pn - 8) * 256 + c; st8(p, a0, a1); st8(p + 128, b0, b1); }
    }
};
struct F2a {
    bf16* P1;
    __device__ __forceinline__ void one(bf16* rowp, int col, const f32x4 a, const f32x4 b) const {
        const u32x4 w = *(const u32x4*)(rowp + KOFF + col); float g[8]; unpack8(w, g); f32x4 x, y;
#pragma unroll
        for (int j = 0; j < 4; ++j) { x[j] = a[j] * sigmoidf_(g[j]); y[j] = b[j] * sigmoidf_(g[4 + j]); }
        st8(rowp + QOFF + col, x, y);
    }
    __device__ __forceinline__ void operator()(const Unit& u, int r, int c, const f32x4 a0, const f32x4 a1, const f32x4 b0, const f32x4 b1) const {
        bf16* rowp = P1 + ((size_t)u.pm * 256 + r) * LDP; one(rowp, u.pn * 256 + c, a0, a1); one(rowp, u.pn * 256 + 128 + c, b0, b1);
    }
};
struct F2b {
    bf16* P1;
    __device__ __forceinline__ void one(bf16* rowp, int col, const f32x4 a, const f32x4 b) const {
        const u32x4 w = *(const u32x4*)(rowp + RGOFF + col); float g[8]; unpack8(w, g);
        const u32x4 mw = *(const u32x4*)(rowp + QOFF + col); float ma[8]; unpack8(mw, ma); f32x4 x, y;
#pragma unroll
        for (int j = 0; j < 4; ++j) { x[j] = ma[j] + a[j] * sigmoidf_(g[j]); y[j] = ma[4 + j] + b[j] * sigmoidf_(g[4 + j]); }
        st8(rowp + QOFF + col, x, y);
    }
    __device__ __forceinline__ void operator()(const Unit& u, int r, int c, const f32x4 a0, const f32x4 a1, const f32x4 b0, const f32x4 b1) const {
        bf16* rowp = P1 + ((size_t)u.pm * 256 + r) * LDP; one(rowp, u.pn * 256 + c, a0, a1); one(rowp, u.pn * 256 + 128 + c, b0, b1);
    }
};
struct FRes {
    const float* base; float* out;
    __device__ __forceinline__ void operator()(const Unit& u, int r, int c, const f32x4 v) const {
        const size_t o = ((size_t)u.pm * 256 + r) * D + u.pn * 256 + c; *(f32x4*)(out + o) = *(const f32x4*)(base + o) + v;
    }
};
struct FBf {
    bf16* O; int ldc;
    __device__ __forceinline__ void operator()(const Unit& u, int r, int c, const f32x4 a0, const f32x4 a1, const f32x4 b0, const f32x4 b1) const {
        bf16* p = O + ((size_t)u.pm * 256 + r) * ldc + u.pn * 256 + c; st8(p, a0, a1); st8(p + 128, b0, b1);
    }
};
struct FM1 {
    bf16* HID;
    __device__ __forceinline__ void operator()(const Unit& u, int r, int c, const f32x4 a0, const f32x4 a1, const f32x4 b0, const f32x4 b1) const {
        f32x4 x, y;
#pragma unroll
        for (int j = 0; j < 4; ++j) { x[j] = siluf_(a0[j]) * b0[j]; y[j] = siluf_(a1[j]) * b1[j]; }
        st8(HID + ((size_t)u.pm * 256 + r) * DEXP + u.pn * 128 + c, x, y);
    }
};
struct FM2 {
    bf16* YE; const int* s2tk; const float* tokw;
    __device__ __forceinline__ void operator()(const Unit& u, int r, int c, const f32x4 a0, const f32x4 a1, const f32x4 b0, const f32x4 b1) const {
        const int tk = s2tk[u.pm * 256 + r]; if (tk < 0) return;
        const float w = tokw[tk]; bf16* p = YE + (size_t)tk * D + u.pn * 256 + c; st8(p, a0 * w, a1 * w); st8(p + 128, b0 * w, b1 * w);
    }
};

struct Args { const float* in[32]; float* out; unsigned char* ws; int ph_lo, ph_hi; };
enum { I_X = 0, I_MEM, I_NORM1, I_WIN, I_RCW, I_RCB, I_WA, I_BA, I_WX, I_BX, I_LAM, I_WBA, I_DCW, I_ALOG, I_DTB, I_DNW, I_WBB, I_WOUT, I_NORM2, I_MEMNW, I_WCQ, I_WCKV, I_WCO,
       I_NORM3, I_WRG, I_BRG, I_WRE, I_BRE, I_WEG, I_WEU, I_WED, I_NORMF };

__device__ __forceinline__ void tr_item(const float* W, int ldw, int col0, bf16* WT, int ldt, int row0, int k0, float scale, LAS float* scr, int lane) {
#pragma unroll 8
    for (int i = 0; i < 32; ++i) { const int kk = 2 * i + (lane >> 5); scr[kk * 33 + (lane & 31)] = W[(size_t)(k0 + kk) * ldw + col0 + (lane & 31)] * scale; }
    LDS_WAIT(); asm volatile("" ::: "memory");
    const int c = lane & 7;
#pragma unroll
    for (int j = 0; j < 4; ++j) { const int n = (lane >> 3) + 8 * j; const LAS float* s = scr + (8 * c) * 33 + n;
        u32x4 o; o.x = cvt_pk_bf16(s[0 * 33], s[1 * 33]); o.y = cvt_pk_bf16(s[2 * 33], s[3 * 33]); o.z = cvt_pk_bf16(s[4 * 33], s[5 * 33]); o.w = cvt_pk_bf16(s[6 * 33], s[7 * 33]);
        *(u32x4*)(WT + (size_t)(row0 + n) * ldt + k0 + 8 * c) = o; }
    LDS_WAIT(); asm volatile("" ::: "memory");
}
__device__ __forceinline__ void rms_row_to_bf16(const float* xrow, const float* w, bf16* orow, int lane) {
    const f32x4* xr = (const f32x4*)xrow + lane; const f32x4* wr_ = (const f32x4*)w + lane;
    f32x4 v[4]; float s = 0.f;
#pragma unroll
    for (int j = 0; j < 4; ++j) { v[j] = xr[64 * j]; s += (v[j][0] * v[j][0] + v[j][1] * v[j][1]) + (v[j][2] * v[j][2] + v[j][3] * v[j][3]); }
    const float rstd = 1.0f / sqrtf(wave_sum(s) * (1.f / D) + EPS);
    u32x2* o8 = (u32x2*)orow + lane;
#pragma unroll
    for (int j = 0; j < 4; ++j) { const f32x4 g = wr_[64 * j]; u32x2 o; o.x = cvt_pk_bf16(v[j][0] * rstd * g[0], v[j][1] * rstd * g[1]); o.y = cvt_pk_bf16(v[j][2] * rstd * g[2], v[j][3] * rstd * g[3]); o8[64 * j] = o; }
}
__device__ __forceinline__ void p0_prologue(const Args& a, LAS unsigned char* lds, int G, int tid, int wave, int lane) {
    unsigned char* ws = a.ws;
    LAS float* scr = (LAS float*)(lds + wave * 16384);
    const int gw = blockIdx.x * 8 + wave, NGW = G * 8;
    constexpr int I0 = 16 * 176, I1 = 512, I4 = 20 * 32, I5 = 512, I8 = 16 * 64, IE = 64 * 256, IRG = 2 * 10 * 8;
    constexpr int NITEMS = I0 + 3 * I1 + I4 + 4 * I5 + I8 + 3 * IE + IRG;
    const float* w_in = a.in[I_WIN];
    for (int it = gw; it < NITEMS; it += NGW) {
        int r = it;
        if (r < I0) { tr_item(w_in, DIN, 32 * (r % 176), (bf16*)(ws + WS_B1A), D, 32 * (r % 176), 64 * (r / 176), 1.f, scr, lane); continue; } r -= I0;
        if (r < I1) { tr_item(w_in, DIN, 5632 + 32 * (r % 32), (bf16*)(ws + WS_B1B), D, 32 * (r % 32), 64 * (r / 32), 1.f, scr, lane); continue; } r -= I1;
        if (r < I1) { tr_item(w_in, DIN, 6672 + 32 * (r % 32), (bf16*)(ws + WS_B1B), D, 1024 + 32 * (r % 32), 64 * (r / 32), 1.f, scr, lane); continue; } r -= I1;
        if (r < I1) { tr_item(w_in, DIN, 7696 + 32 * (r % 32), (bf16*)(ws + WS_B1B), D, 2048 + 32 * (r % 32), 64 * (r / 32), 1.f, scr, lane); continue; } r -= I1;
        if (r < I4) { tr_item(a.in[I_WBA], D, 32 * (r % 32), (bf16*)(ws + WS_WAT), DRNN, 32 * (r % 32), 64 * (r / 32), 1.f, scr, lane); continue; } r -= I4;
        if (r < I5) { tr_item(a.in[I_WBB], D, 32 * (r % 32), (bf16*)(ws + WS_WBT), D, 32 * (r % 32), 64 * (r / 32), 1.f, scr, lane); continue; } r -= I5;
        if (r < I5) { tr_item(a.in[I_WOUT], D, 32 * (r % 32), (bf16*)(ws + WS_WOT), D, 32 * (r % 32), 64 * (r / 32), 1.f, scr, lane); continue; } r -= I5;
        if (r < I5) { tr_item(a.in[I_WCQ], D, 32 * (r % 32), (bf16*)(ws + WS_WCQT), D, 32 * (r % 32), 64 * (r / 32), 0.0625f, scr, lane); continue; } r -= I5;
        if (r < I5) { tr_item(a.in[I_WCO], D, 32 * (r % 32), (bf16*)(ws + WS_WCOT), D, 32 * (r % 32), 64 * (r / 32), 1.f, scr, lane); continue; } r -= I5;
        if (r < I8) { tr_item(a.in[I_WCKV], 2 * D, 32 * (r % 64), (bf16*)(ws + WS_WKVT), D, 32 * (r % 64), 64 * (r / 64), 1.f, scr, lane); continue; } r -= I8;
        if (r < IE) { const int e = r >> 8, q = r & 255, n0 = 32 * (q & 15);
            tr_item(a.in[I_WEG] + (size_t)e * D * DEXP, DEXP, n0, (bf16*)(ws + WS_WGU) + (size_t)e * 1024 * 1024, D, (n0 >> 7) * 256 + (n0 & 127), 64 * (q >> 4), 1.f, scr, lane); continue; } r -= IE;
        if (r < IE) { const int e = r >> 8, q = r & 255, n0 = 32 * (q & 15);
            tr_item(a.in[I_WEU] + (size_t)e * D * DEXP, DEXP, n0, (bf16*)(ws + WS_WGU) + (size_t)e * 1024 * 1024, D, (n0 >> 7) * 256 + 128 + (n0 & 127), 64 * (q >> 4), 1.f, scr, lane); continue; } r -= IE;
        if (r < IE) { const int e = r >> 8, q = r & 255;
            tr_item(a.in[I_WED] + (size_t)e * DEXP * D, D, 32 * (q & 31), (bf16*)(ws + WS_WD) + (size_t)e * 1024 * 512, DEXP, 32 * (q & 31), 64 * (q >> 5), 1.f, scr, lane); continue; } r -= IE;
        { const int mtx = r / 80, q = r % 80, blk = q >> 3, s = q & 7;
            tr_item(a.in[mtx ? I_WX : I_WA] + blk * 16384, 128, 32 * (s & 3), (bf16*)(ws + WS_RGW) + (size_t)mtx * 163840 + blk * 16384, 128, 32 * (s & 3), 64 * (s >> 2), 1.f, scr, lane); }
    }
    const int gt = blockIdx.x * 512 + tid, NGT = G * 512;
    { bf16* B1A = (bf16*)(ws + WS_B1A);
      for (int i = gt; i < 16 * 1024; i += NGT) { const int n = i >> 10, k = i & 1023; B1A[(size_t)(5632 + n) * D + k] = f2bf(w_in[(size_t)k * DIN + 6656 + n]); }
      for (int i = gt; i < 240 * 1024 / 8; i += NGT) *(u32x4*)(B1A + (size_t)5648 * D + (size_t)i * 8) = (u32x4){0u, 0u, 0u, 0u}; }
    { bf16* WH = (bf16*)(ws + WS_WRT); bf16* WL = WH + 80 * 1024;
      for (int i = gt; i < 80 * 1024; i += NGT) { const int n = i >> 10, k = i & 1023; float w = 0.f;
          if (n < 8) w = a.in[I_WRG][k * 8 + n]; else if (n < 72) w = a.in[I_WRE][k * 64 + (n - 8)];
          const bf16 h = f2bf(w); WH[i] = h; WL[i] = f2bf(w - bf2f(h)); } }
    { bf16* U = (bf16*)a.out;
      for (int m = gw; m < NTOK; m += NGW) rms_row_to_bf16(a.in[I_X] + (size_t)m * D, a.in[I_NORM1], U + (size_t)m * D, lane);
      bf16* MN = (bf16*)(ws + WS_MEMN);
      for (int m = gw; m < NB * NMEM; m += NGW) rms_row_to_bf16(a.in[I_MEM] + (size_t)m * D, a.in[I_MEMNW], MN + (size_t)m * D, lane); }
}

constexpr int R_XC = 0, R_A = 33792, R_XCB = 67584, R_RAW = 84992;
__device__ __forceinline__ void rg_unit(const Args& a, LAS unsigned char* lds, int b, int blk, int tid_in, int wave, int lane_in) {
    bf16* P1 = (bf16*)(a.ws + WS_P1);
    const int tid = tid_in, lane = lane_in; const int lr = lane & 15, q4 = lane >> 4;
    const int ch0 = blk * 128;
    LAS float* XC = (LAS float*)(lds + R_XC); LAS float* AA = (LAS float*)(lds + R_A);
    LAS bf16* XCB = (LAS bf16*)(lds + R_XCB); LAS bf16* RAW = (LAS bf16*)(lds + R_RAW);
    bf16x8 wfa[4], wfx[4];
    { const bf16* WAT = (const bf16*)(a.ws + WS_RGW) + (size_t)blk * 16384 + (size_t)(16 * wave + lr) * 128; const bf16* WXT = WAT + 163840;
#pragma unroll
      for (int s = 0; s < 4; ++s) { wfa[s] = *(const bf16x8*)(WAT + 32 * s + 8 * q4); wfx[s] = *(const bf16x8*)(WXT + 32 * s + 8 * q4); } }
    const int mych = ch0 + 16 * wave + lr;
    const float ba = a.in[I_BA][mych], bx = a.in[I_BX][mych];
    const float csp = 8.0f * softplusf_(-a.in[I_LAM][mych]);
    if (tid < 3 * 16) *(u32x4*)(RAW + tid * 8) = (u32x4){0u, 0u, 0u, 0u};
    float hstate = 0.f;
#pragma unroll 1
    for (int c = 0; c < SEQ / 64; ++c) {
        int tid = tid_in; asm volatile("" : "+v"(tid));
        const int lane = tid & 63, lr = lane & 15, q4 = lane >> 4;
        const int pr = tid >> 3, pp = tid & 7;
        const size_t row0 = (size_t)b * SEQ + (size_t)c * 64;
#pragma unroll
        for (int it = 0; it < 2; ++it) { const int idx = it * 512 + tid, r = idx >> 4, pc = idx & 15;
            *(u32x4*)(RAW + (3 + r) * 128 + pc * 8) = *(const u32x4*)(P1 + (row0 + r) * LDP + RXOFF + ch0 + pc * 8); }
        __syncthreads();
        { float acc[16];
          { const f32x4* bp = (const f32x4*)(a.in[I_RCB] + ch0 + 16 * pp);
#pragma unroll
            for (int j = 0; j < 4; ++j) { const f32x4 t = bp[j]; acc[4 * j] = t[0]; acc[4 * j + 1] = t[1]; acc[4 * j + 2] = t[2]; acc[4 * j + 3] = t[3]; } }
#pragma unroll
          for (int tap = 0; tap < 4; ++tap) {
              float x[16]; unpack8(*(const LAS u32x4*)(RAW + (pr + tap) * 128 + 16 * pp), x); unpack8(*(const LAS u32x4*)(RAW + (pr + tap) * 128 + 16 * pp + 8), x + 8);
              const f32x4* wp = (const f32x4*)(a.in[I_RCW] + tap * DRNN + ch0 + 16 * pp);
#pragma unroll
              for (int j = 0; j < 4; ++j) { const f32x4 t = wp[j]; acc[4 * j] += t[0] * x[4 * j]; acc[4 * j + 1] += t[1] * x[4 * j + 1]; acc[4 * j + 2] += t[2] * x[4 * j + 2]; acc[4 * j + 3] += t[3] * x[4 * j + 3]; } }
#pragma unroll
          for (int j = 0; j < 4; ++j) *(LAS f32x4*)(XC + pr * 132 + 16 * pp + 4 * j) = (f32x4){acc[4 * j], acc[4 * j + 1], acc[4 * j + 2], acc[4 * j + 3]};
          *(LAS u32x4*)(XCB + pr * 136 + 16 * pp) = pack8((f32x4){acc[0], acc[1], acc[2], acc[3]}, (f32x4){acc[4], acc[5], acc[6], acc[7]});
          *(LAS u32x4*)(XCB + pr * 136 + 16 * pp + 8) = pack8((f32x4){acc[8], acc[9], acc[10], acc[11]}, (f32x4){acc[12], acc[13], acc[14], acc[15]}); }
        __syncthreads();
        if (tid < 48) *(LAS u32x4*)(RAW + tid * 8) = *(const LAS u32x4*)(RAW + 64 * 128 + tid * 8);
#pragma unroll
        for (int it = 0; it < 4; ++it) {
            f32x4 dr = {0.f, 0.f, 0.f, 0.f}, di = {0.f, 0.f, 0.f, 0.f};
#pragma unroll
            for (int s = 0; s < 4; ++s) { const bf16x8 xf = *(const LAS bf16x8*)(XCB + (16 * it + lr) * 136 + 32 * s + 8 * q4); dr = MFMA(xf, wfa[s], dr); di = MFMA(xf, wfx[s], di); }
#pragma unroll
            for (int j = 0; j < 4; ++j) { const int tok = 16 * it + 4 * q4 + j; const int o = tok * 132 + 16 * wave + lr;
                const float rr = sigmoidf_(dr[j] + ba), ii = sigmoidf_(di[j] + bx); const float la = -csp * rr; const float av = __expf(la);
                const float mult = sqrtf(-expm1f(2.0f * la)); const float xv = XC[o];
                AA[o] = av; XC[o] = mult * ii * xv; }
        }
        __syncthreads();
        if (tid < 128) {
            const bf16* rgp = P1 + row0 * LDP + RGOFF + ch0 + tid; bf16* op = P1 + row0 * LDP + RXOFF + ch0 + tid;
#pragma unroll 8
            for (int t = 0; t < 64; ++t) { hstate = AA[t * 132 + tid] * hstate + XC[t * 132 + tid];
                const float g = bf2f(rgp[(size_t)t * LDP]); op[(size_t)t * LDP] = f2bf(gelu_tanh(g) * hstate); }
        }
        __syncthreads();
    }
}

#if DBG_STAGE == 3
#define CHK(stage, val) do { const float _v = (val); if (dbg_on && !(fabsf(_v) < 1e30f) && *DBGF == 0) *DBGF = (stage) + 16 * (c < 2 ? c : 2); } while (0)
#else
#define CHK(stage, val) do { } while (0)
#endif
constexpr int G_KN = 0, G_QS = 17408, G_VT = 34816, G_KNT = 53248, G_TB = 71680, G_TBG = 80896, G_PM = 90112, G_VEC = 99328, G_GT = 103424, G_RAW = 107520;
__device__ __forceinline__ bf16x8 frag_nat(const LAS bf16* base, int stride, int row, int k) { return *(const LAS bf16x8*)(base + row * stride + k); }
__device__ __forceinline__ bf16x8 frag_perm(const LAS bf16* base, int stride, int row, int k0, int q4) {
    const bf16x4 x = *(const LAS bf16x4*)(base + row * stride + k0 + 4 * q4); const bf16x4 y = *(const LAS bf16x4*)(base + row * stride + k0 + 16 + 4 * q4);
    return (bf16x8){x[0], x[1], x[2], x[3], y[0], y[1], y[2], y[3]};
}
__device__ __forceinline__ void gdn_unit(const Args& a, LAS unsigned char* lds, int b, int h, int tid_in, int wave, int lane_in) {
    bf16* P1 = (bf16*)(a.ws + WS_P1);
    const float* gbuf = (const float*)(a.ws + WS_G); const float* betabuf = (const float*)(a.ws + WS_BETA);
    const int tid = tid_in;
    LAS bf16* KN = (LAS bf16*)(lds + G_KN); LAS float* LM = (LAS float*)(lds + G_KN); LAS bf16* WW = (LAS bf16*)(lds + G_KN); LAS float* OST = (LAS float*)(lds + G_KN);
    LAS bf16* QS = (LAS bf16*)(lds + G_QS); LAS bf16* VT = (LAS bf16*)(lds + G_VT); LAS bf16* KNT = (LAS bf16*)(lds + G_KNT);
    LAS bf16* TB = (LAS bf16*)(lds + G_TB); LAS bf16* TBG = (LAS bf16*)(lds + G_TBG); LAS bf16* PM = (LAS bf16*)(lds + G_PM);
    LAS float* GC = (LAS float*)(lds + G_VEC); LAS float* BETA = GC + 64; LAS float* EG = GC + 128; LAS float* EGL = GC + 192;
    LAS float* GT = (LAS float*)(lds + G_GT); LAS bf16* RAW = (LAS bf16*)(lds + G_RAW);
    for (int i = tid; i < 3 * 48; i += 512) *(LAS u32x4*)(RAW + i * 8) = (u32x4){0u, 0u, 0u, 0u};
#if DBG_STAGE == 3
    volatile LAS int* DBGF = (volatile LAS int*)(lds + 159000); const bool dbg_on = true; if (tid == 0) *DBGF = 0;
#endif
    f32x4 S[8];
#pragma unroll
    for (int t = 0; t < 8; ++t) S[t] = (f32x4){0.f, 0.f, 0.f, 0.f};
    const float* dcw = a.in[I_DCW];
#pragma unroll 1
    for (int c = 0; c < SEQ / 64; ++c) {
        int tid = tid_in; asm volatile("" : "+v"(tid));
        const int lane = tid & 63, lr = lane & 15, q4 = lane >> 4;
        const int pr = tid >> 3, pp = tid & 7;
        const size_t row0 = (size_t)b * SEQ + (size_t)c * 64;
#pragma unroll
        for (int it = 0; it < 6; ++it) { const int idx = it * 512 + tid, r = idx / 48, pc = idx % 48, part = pc >> 4, piece = pc & 15;
            *(LAS u32x4*)(RAW + (3 + r) * 384 + part * 128 + piece * 8) = *(const u32x4*)(P1 + (row0 + r) * LDP + QOFF + part * 1024 + h * 128 + piece * 8); }
        if (wave == 0) {
            float v = -__expf(a.in[I_ALOG][h]) * softplusf_(gbuf[(row0 + lane) * 8 + h] + a.in[I_DTB][h]);
#pragma unroll
            for (int o = 1; o < 64; o <<= 1) { const float t = __shfl_up(v, o); if (lane >= o) v += t; }
            const float gl = __shfl(v, 63);
            GC[lane] = v; BETA[lane] = sigmoidf_(betabuf[(row0 + lane) * 8 + h]); EG[lane] = __expf(v); EGL[lane] = __expf(gl - v);
            CHK(1, v); CHK(1, BETA[lane]); CHK(1, EGL[lane]);
        }
        __syncthreads();
#pragma unroll
        for (int part = 0; part < 3; ++part) {
            float acc[16];
#pragma unroll
            for (int j = 0; j < 16; ++j) acc[j] = 0.f;
#pragma unroll
            for (int tap = 0; tap < 4; ++tap) {
                float x[16]; unpack8(*(const LAS u32x4*)(RAW + (pr + tap) * 384 + part * 128 + 16 * pp), x); unpack8(*(const LAS u32x4*)(RAW + (pr + tap) * 384 + part * 128 + 16 * pp + 8), x + 8);
                const f32x4* wp = (const f32x4*)(dcw + tap * 3072 + part * 1024 + h * 128 + 16 * pp);
#pragma unroll
                for (int j = 0; j < 4; ++j) { const f32x4 t = wp[j]; acc[4 * j] += t[0] * x[4 * j]; acc[4 * j + 1] += t[1] * x[4 * j + 1]; acc[4 * j + 2] += t[2] * x[4 * j + 2]; acc[4 * j + 3] += t[3] * x[4 * j + 3]; } }
            float ss = 0.f;
#pragma unroll
            for (int j = 0; j < 16; ++j) { CHK(2, acc[j]); acc[j] = siluf_(acc[j]); ss += acc[j] * acc[j]; }
            if (part < 2) {
                ss += __shfl_xor(ss, 1); ss += __shfl_xor(ss, 2); ss += __shfl_xor(ss, 4);
                const float sc = (1.0f / sqrtf(ss + EPS)) * (part == 0 ? 0.08838834764831845f : 1.0f);
#pragma unroll
                for (int j = 0; j < 16; ++j) acc[j] *= sc;
                CHK(3, sc);
            }
            if (part < 2) { LAS bf16* dst = (part == 0 ? QS : KN) + pr * 136 + 16 * pp;
                *(LAS u32x4*)dst = pack8((f32x4){acc[0], acc[1], acc[2], acc[3]}, (f32x4){acc[4], acc[5], acc[6], acc[7]});
                *(LAS u32x4*)(dst + 8) = pack8((f32x4){acc[8], acc[9], acc[10], acc[11]}, (f32x4){acc[12], acc[13], acc[14], acc[15]}); }
            if (part >= 1) { LAS bf16* dt = (part == 1 ? KNT : VT) + (16 * pp) * 72 + pr;
#pragma unroll
                for (int j = 0; j < 16; ++j) dt[j * 72] = f2bf(acc[j]); }
        }
        __syncthreads();
        for (int i = tid; i < 3 * 48; i += 512) *(LAS u32x4*)(RAW + i * 8) = *(const LAS u32x4*)(RAW + 64 * 384 + i * 8);
        f32x4 dkq[4];
#pragma unroll
        for (int i = 0; i < 4; ++i) { const int tt = wave * 4 + i, which = tt >> 4, it = (tt & 15) >> 2, jt = tt & 3;
            f32x4 d = {0.f, 0.f, 0.f, 0.f};
            if (it >= jt) {
                const LAS bf16* Am = which ? QS : KN;
#pragma unroll
                for (int s = 0; s < 4; ++s) d = MFMA(frag_nat(Am, 136, 16 * it + lr, 32 * s + 8 * q4), frag_nat(KN, 136, 16 * jt + lr, 32 * s + 8 * q4), d);
            }
            dkq[i] = d; CHK(4, d[0] + d[1] + d[2] + d[3]); }
        __syncthreads();
#pragma unroll
        for (int i = 0; i < 4; ++i) { const int tt = wave * 4 + i, which = tt >> 4, it = (tt & 15) >> 2, jt = tt & 3; const int jc = 16 * jt + lr; const float gj = GC[jc];
#pragma unroll
            for (int j = 0; j < 4; ++j) { const int ii = 16 * it + 4 * q4 + j; const float dec = __expf(fminf(GC[ii] - gj, 0.f));
                if (which == 0) LM[ii * 68 + jc] = (ii > jc) ? BETA[ii] * dkq[i][j] * dec : 0.f;
                else PM[ii * 72 + jc] = f2bf((ii >= jc) ? dkq[i][j] * dec : 0.f); } }
        __syncthreads();
        if (tid < 64) { const int d = tid >> 4, cc = tid & 15; float t[16];
#pragma unroll
            for (int i = 0; i < 16; ++i) { float s = 0.f;
#pragma unroll
                for (int j = 0; j < i; ++j) s += LM[(16 * d + i) * 68 + 16 * d + j] * t[j];
                t[i] = (i > cc) ? -s : (i == cc ? 1.f : 0.f); }
            LDS_WAIT();
#pragma unroll
            for (int i = 0; i < 16; ++i) LM[(16 * d + i) * 68 + 16 * d + cc] = t[i]; }
        __syncthreads();
#pragma unroll 1
        for (int bb = 1; bb < 4; ++bb) {
            const int ncol = 16 * bb;
            for (int o = tid; o < 16 * ncol; o += 512) { const int r = o / ncol, cc = o % ncol; float s = 0.f;
                for (int j = cc & ~15; j < ncol; ++j) s += LM[(16 * bb + r) * 68 + j] * LM[j * 68 + cc];
                GT[r * 49 + cc] = s; }
            __syncthreads();
            for (int o = tid; o < 16 * ncol; o += 512) { const int r = o / ncol, cc = o % ncol; float s = 0.f;
                for (int i2 = 0; i2 <= r; ++i2) s += LM[(16 * bb + r) * 68 + 16 * bb + i2] * GT[i2 * 49 + cc];
                LM[(16 * bb + r) * 68 + cc] = -s; }
            __syncthreads();
        }
        { const int i = tid >> 3, j0 = (tid & 7) * 8; f32x4 t0 = *(const LAS f32x4*)(LM + i * 68 + j0), t1 = *(const LAS f32x4*)(LM + i * 68 + j0 + 4);
          CHK(5, t0[0] + t0[1] + t0[2] + t0[3] + t1[0] + t1[1] + t1[2] + t1[3]);
          f32x4 b0, b1, e0, e1;
#pragma unroll
          for (int j = 0; j < 4; ++j) { b0[j] = t0[j] * BETA[j0 + j]; b1[j] = t1[j] * BETA[j0 + 4 + j]; e0[j] = b0[j] * EG[j0 + j]; e1[j] = b1[j] * EG[j0 + 4 + j]; }
          *(LAS u32x4*)(TB + i * 72 + j0) = pack8(b0, b1); *(LAS u32x4*)(TBG + i * 72 + j0) = pack8(e0, e1); }
        __syncthreads();
        f32x4 U[4];
#pragma unroll
        for (int it = 0; it < 4; ++it) { f32x4 d = {0.f, 0.f, 0.f, 0.f}, uu = {0.f, 0.f, 0.f, 0.f};
#pragma unroll
            for (int s = 0; s < 2; ++s) { d = MFMA(frag_nat(TBG, 72, 16 * it + lr, 32 * s + 8 * q4), frag_nat(KNT, 72, 16 * wave + lr, 32 * s + 8 * q4), d);
                uu = MFMA(frag_nat(TB, 72, 16 * it + lr, 32 * s + 8 * q4), frag_nat(VT, 72, 16 * wave + lr, 32 * s + 8 * q4), uu); }
            U[it] = uu; CHK(6, d[0] + d[1] + d[2] + d[3]); CHK(7, uu[0] + uu[1] + uu[2] + uu[3]);
#pragma unroll
            for (int j = 0; j < 4; ++j) WW[(16 * it + 4 * q4 + j) * 136 + 16 * wave + lr] = f2bf(d[j]); }
        __syncthreads();
        bf16x8 sf[4];
#pragma unroll
        for (int s = 0; s < 4; ++s) sf[s] = pack8v(S[2 * s], S[2 * s + 1]);
        f32x4 Vn[4], O[4];
#pragma unroll
        for (int it = 0; it < 4; ++it) { f32x4 ws_ = {0.f, 0.f, 0.f, 0.f}, qs_ = {0.f, 0.f, 0.f, 0.f};
#pragma unroll
            for (int s = 0; s < 4; ++s) { ws_ = MFMA(frag_perm(WW, 136, 16 * it + lr, 32 * s, q4), sf[s], ws_); qs_ = MFMA(frag_perm(QS, 136, 16 * it + lr, 32 * s, q4), sf[s], qs_); }
            Vn[it] = U[it] - ws_; CHK(8, ws_[0] + ws_[1] + ws_[2] + ws_[3]); CHK(9, qs_[0] + qs_[1] + qs_[2] + qs_[3]);
#pragma unroll
            for (int j = 0; j < 4; ++j) O[it][j] = qs_[j] * EG[16 * it + 4 * q4 + j]; }
        bf16x8 vf[2], vfs[2];
#pragma unroll
        for (int s = 0; s < 2; ++s) { vf[s] = pack8v(Vn[2 * s], Vn[2 * s + 1]); f32x4 x, y;
#pragma unroll
            for (int j = 0; j < 4; ++j) { x[j] = Vn[2 * s][j] * EGL[32 * s + 4 * q4 + j]; y[j] = Vn[2 * s + 1][j] * EGL[32 * s + 16 + 4 * q4 + j]; }
            vfs[s] = pack8v(x, y); }
#pragma unroll
        for (int it = 0; it < 4; ++it)
#pragma unroll
            for (int s = 0; s < 2; ++s) O[it] = MFMA(frag_perm(PM, 72, 16 * it + lr, 32 * s, q4), vf[s], O[it]);
#pragma unroll
        for (int it = 0; it < 4; ++it) CHK(10, O[it][0] + O[it][1] + O[it][2] + O[it][3]);
        { const float gl = EG[63];
#pragma unroll
          for (int t = 0; t < 8; ++t) { f32x4 d = S[t] * gl;
#pragma unroll
              for (int s = 0; s < 2; ++s) d = MFMA(frag_perm(KNT, 72, 16 * t + lr, 32 * s, q4), vfs[s], d);
              S[t] = d; CHK(11, d[0] + d[1] + d[2] + d[3]); } }
        __syncthreads();
#pragma unroll
        for (int it = 0; it < 4; ++it)
#pragma unroll
            for (int j = 0; j < 4; ++j) OST[(16 * it + 4 * q4 + j) * 132 + 16 * wave + lr] = O[it][j];
        __syncthreads();
        { float o[16]; float ss = 0.f;
#pragma unroll
          for (int j = 0; j < 4; ++j) { const f32x4 t = *(const LAS f32x4*)(OST + pr * 132 + 16 * pp + 4 * j); o[4 * j] = t[0]; o[4 * j + 1] = t[1]; o[4 * j + 2] = t[2]; o[4 * j + 3] = t[3]; ss += (t[0] * t[0] + t[1] * t[1]) + (t[2] * t[2] + t[3] * t[3]); }
          ss += __shfl_xor(ss, 1); ss += __shfl_xor(ss, 2); ss += __shfl_xor(ss, 4);
          const float rstd = 1.0f / sqrtf(ss * (1.f / HD) + EPS); CHK(12, ss); CHK(13, rstd);
          const f32x4* wp = (const f32x4*)(a.in[I_DNW] + 16 * pp);
#pragma unroll
          for (int j = 0; j < 4; ++j) { const f32x4 t = wp[j]; o[4 * j] *= rstd * t[0]; o[4 * j + 1] *= rstd * t[1]; o[4 * j + 2] *= rstd * t[2]; o[4 * j + 3] *= rstd * t[3]; }
          bf16* dst = P1 + (row0 + pr) * LDP + VOFF + h * 128 + 16 * pp;
          *(u32x4*)dst = pack8((f32x4){o[0], o[1], o[2], o[3]}, (f32x4){o[4], o[5], o[6], o[7]});
          *(u32x4*)(dst + 8) = pack8((f32x4){o[8], o[9], o[10], o[11]}, (f32x4){o[12], o[13], o[14], o[15]}); }
        __syncthreads();
    }
#if DBG_STAGE == 3

#endif
}

__device__ __forceinline__ void attn_unit(const Args& a, LAS unsigned char* lds, int b, int hh, int rb, int tid, int wave, int lane) {
    const bf16* QC = (const bf16*)(a.ws + WS_QC); const bf16* Kc = (const bf16*)(a.ws + WS_KV); const bf16* VTg = (const bf16*)(a.ws + WS_VT); bf16* AO = (bf16*)(a.ws + WS_AO);
    LAS bf16* KS = (LAS bf16*)lds;
    const int lr = lane & 15, q4 = lane >> 4;
    const size_t qrow = (size_t)b * SEQ + (size_t)rb * 128 + 16 * wave + lr;
#pragma unroll
    for (int it = 0; it < 16; ++it) { const int idx = it * 512 + tid, key = idx >> 5, pc = idx & 31;
        *(LAS u32x4*)(KS + key * 264 + pc * 8) = *(const u32x4*)(Kc + ((size_t)b * 256 + key) * 2048 + hh * 256 + pc * 8); }
    bf16x8 qf[8];
#pragma unroll
    for (int s = 0; s < 8; ++s) qf[s] = *(const bf16x8*)(QC + qrow * D + hh * 256 + 32 * s + 8 * q4);
    __syncthreads();
    f32x4 sc[16];
    float mx = -3.0e38f;
#pragma unroll
    for (int kt = 0; kt < 16; ++kt) { f32x4 d = {0.f, 0.f, 0.f, 0.f};
#pragma unroll
        for (int s = 0; s < 8; ++s) d = MFMA(frag_nat(KS, 264, 16 * kt + lr, 32 * s + 8 * q4), qf[s], d);
        sc[kt] = d; mx = fmaxf(mx, fmaxf(fmaxf(d[0], d[1]), fmaxf(d[2], d[3]))); }
    mx = fmaxf(mx, __shfl_xor(mx, 16)); mx = fmaxf(mx, __shfl_xor(mx, 32));
    float sum = 0.f;
#pragma unroll
    for (int kt = 0; kt < 16; ++kt)
#pragma unroll
        for (int j = 0; j < 4; ++j) { const float e = __expf(sc[kt][j] - mx); sc[kt][j] = e; sum += e; }
    sum += __shfl_xor(sum, 16); sum += __shfl_xor(sum, 32);
    const float inv = 1.0f / sum;
    bf16x8 pf[8];
#pragma unroll
    for (int s = 0; s < 8; ++s) pf[s] = pack8v(sc[2 * s] * inv, sc[2 * s + 1] * inv);
    __syncthreads();
#pragma unroll
    for (int it = 0; it < 16; ++it) { const int idx = it * 512 + tid, dv = idx >> 5, pc = idx & 31;
        *(LAS u32x4*)(KS + dv * 264 + pc * 8) = *(const u32x4*)(VTg + ((size_t)(b * 4 + hh) * 256 + dv) * 256 + pc * 8); }
    __syncthreads();
#pragma unroll 4
    for (int dt = 0; dt < 16; ++dt) { f32x4 d = {0.f, 0.f, 0.f, 0.f};
#pragma unroll
        for (int s = 0; s < 8; ++s) d = MFMA(frag_perm(KS, 264, 16 * dt + lr, 32 * s, q4), pf[s], d);
        u32x2 o; o.x = cvt_pk_bf16(d[0], d[1]); o.y = cvt_pk_bf16(d[2], d[3]);
        *(u32x2*)(AO + qrow * D + hh * 256 + 16 * dt + 4 * q4) = o; }
    __syncthreads();
}

__device__ __forceinline__ void router_rows(const Args& a, LAS unsigned char* lds, int row0, int wave, int lane) {
    const float* H = a.out; const float* w3 = a.in[I_NORM3];
    const bf16* WH = (const bf16*)(a.ws + WS_WRT); const bf16* WL = WH + 80 * 1024;
    float* rstd3 = (float*)(a.ws + WS_RSTD3); int* toke = (int*)(a.ws + WS_TOKE); float* tokw = (float*)(a.ws + WS_TOKW);
    unsigned* cnt = (unsigned*)(a.ws + WS_CTL) + CW_CNT;
    LAS float* LG = (LAS float*)(lds + wave * 6144);
    const int lr = lane & 15, q4 = lane >> 4;
    const float* hp = H + (size_t)(row0 + lr) * D + 8 * q4;
    float ss = 0.f;
#pragma unroll 8
    for (int kb = 0; kb < 32; ++kb) { const f32x4 x0 = *(const f32x4*)(hp + 32 * kb), x1 = *(const f32x4*)(hp + 32 * kb + 4);
        ss += (x0[0] * x0[0] + x0[1] * x0[1]) + (x0[2] * x0[2] + x0[3] * x0[3]) + (x1[0] * x1[0] + x1[1] * x1[1]) + (x1[2] * x1[2] + x1[3] * x1[3]); }
    ss += __shfl_xor(ss, 16); ss += __shfl_xor(ss, 32);
    const float rstd = 1.0f / sqrtf(ss * (1.f / D) + EPS);
    if (q4 == 0) rstd3[row0 + lr] = rstd;
    f32x4 acc[5];
#pragma unroll
    for (int ct = 0; ct < 5; ++ct) acc[ct] = (f32x4){0.f, 0.f, 0.f, 0.f};
#pragma unroll 2
    for (int kb = 0; kb < 32; ++kb) {
        const f32x4 x0 = *(const f32x4*)(hp + 32 * kb), x1 = *(const f32x4*)(hp + 32 * kb + 4);
        const f32x4 g0 = *(const f32x4*)(w3 + 32 * kb + 8 * q4), g1 = *(const f32x4*)(w3 + 32 * kb + 8 * q4 + 4);
        const f32x4 u0 = x0 * rstd * g0, u1 = x1 * rstd * g1;
        const u32x4 hi = pack8(u0, u1); float hf[8]; unpack8(hi, hf);
        const f32x4 l0 = {u0[0] - hf[0], u0[1] - hf[1], u0[2] - hf[2], u0[3] - hf[3]}, l1 = {u1[0] - hf[4], u1[1] - hf[5], u1[2] - hf[6], u1[3] - hf[7]};
        const bf16x8 ah = __builtin_bit_cast(bf16x8, hi), al = pack8v(l0, l1);
#pragma unroll
        for (int ct = 0; ct < 5; ++ct) { const size_t wo = (size_t)(16 * ct + lr) * 1024 + 32 * kb + 8 * q4;
            const bf16x8 bh = *(const bf16x8*)(WH + wo), bl = *(const bf16x8*)(WL + wo);
            acc[ct] = MFMA(ah, bh, acc[ct]); acc[ct] = MFMA(ah, bl, acc[ct]); acc[ct] = MFMA(al, bh, acc[ct]); }
    }
#pragma unroll
    for (int ct = 0; ct < 5; ++ct)
#pragma unroll
        for (int j = 0; j < 4; ++j) LG[(4 * q4 + j) * 81 + 16 * ct + lr] = acc[ct][j];
    LDS_WAIT(); asm volatile("" ::: "memory");
    if (lane < 16) {
        const LAS float* lg = LG + lane * 81; const float* bg = a.in[I_BRG]; const float* be = a.in[I_BRE];
        float gl[8]; int grp = 0; float gm = -3.0e38f;
#pragma unroll
        for (int j = 0; j < 8; ++j) { gl[j] = lg[j] + bg[j]; if (gl[j] > gm) { gm = gl[j]; grp = j; } }
        float gs = 0.f;
#pragma unroll
        for (int j = 0; j < 8; ++j) gs += __expf(gl[j] - gm);
        const float pg = 1.0f / gs;
        float el[8]; float m1 = -3.0e38f, m2 = -3.0e38f; int i1 = 0, i2 = 0;
#pragma unroll
        for (int j = 0; j < 8; ++j) { el[j] = lg[8 + grp * 8 + j] + be[grp * 8 + j];
            if (el[j] > m1) { m2 = m1; i2 = i1; m1 = el[j]; i1 = j; } else if (el[j] > m2) { m2 = el[j]; i2 = j; } }
        const float e2 = __expf(m2 - m1); const float t1 = 1.0f / (1.0f + e2), t2 = e2 / (1.0f + e2);
        const int tok = row0 + lane;
        toke[2 * tok] = grp * 8 + i1; toke[2 * tok + 1] = grp * 8 + i2; tokw[2 * tok] = pg * t1; tokw[2 * tok + 1] = pg * t2;
        atomicAdd(cnt + grp * 8 + i1, 1u); atomicAdd(cnt + grp * 8 + i2, 1u);
    }
    LDS_WAIT(); asm volatile("" ::: "memory");
}

__device__ __forceinline__ int build_moe_tables(const Args& a, LAS unsigned char* lds, int tid) {
    LAS int* OFF = (LAS int*)(lds + LDS_T2E + 1024); LAS unsigned char* T2E = lds + LDS_T2E;
    const unsigned* cnt = (const unsigned*)(a.ws + WS_CTL) + CW_CNT;
    if (tid == 0) { int o = 0; for (int e = 0; e < NEXP; ++e) { OFF[e] = o; const int nt = ((int)cnt[e] + 255) >> 8; for (int t = 0; t < nt; ++t) T2E[(o >> 8) + t] = (unsigned char)e; o += nt << 8; } OFF[NEXP] = o; }
    __syncthreads();
    return OFF[NEXP] >> 8;
}

__global__ void __launch_bounds__(512, 2) fwd(Args a) {
    extern __shared__ __attribute__((aligned(16))) unsigned char lds_raw[];
    LAS unsigned char* lds = (LAS unsigned char*)lds_raw;
    const int tid = threadIdx.x, lane = tid & 63, wave = __builtin_amdgcn_readfirstlane(tid >> 6);
    const int G = gridDim.x;
    unsigned char* ws = a.ws;
    volatile LAS unsigned* MISC = (volatile LAS unsigned*)(lds + LDS_MISC);
    if (tid < 16) MISC[tid] = 0u;
    __syncthreads();
    unsigned* ctl = (unsigned*)(ws + WS_CTL);
    XcdBarrier bar; bar.bar = ctl + CW_BAR; bar.x = 0; bar.st = MISC;
    if (MK_N_LAUNCHES == 1) bar = xcd_barrier_post(ctl + CW_BAR, MISC);
    const int lo = a.ph_lo, hi = a.ph_hi;
#ifndef PH_MASK
#define PH_MASK 0x7fff
#endif
#define IN(k) (((PH_MASK >> (k)) & 1) && lo <= (k) && (k) < hi)
#define SEAM(k) do { if (IN(k) && IN((k) + 1)) xcd_barrier(bar); } while (0)
    bf16* P1 = (bf16*)(ws + WS_P1);
    const pg8::Gemm g1024{D, D, D};

    if (IN(0)) { p0_prologue(a, lds, G, tid, wave, lane); } SEAM(0);
    if (IN(1)) {
#ifndef NO_G1A
        { pg8::DenseOrder S; S.init(NTOK / 256, N1A / 256, G, blockIdx.x, a.out, D, ws + WS_B1A, D);
          pg8::EpiPerm<F1a> E{{P1, (float*)(ws + WS_G), (float*)(ws + WS_BETA)}};
          pg8::gemm_phase(lds, g1024, S, E); }
#endif
#ifndef NO_GKV
        { pg8::DenseOrder S; S.init(NB * NMEM / 256, 2 * D / 256, G, blockIdx.x, ws + WS_MEMN, D, ws + WS_WKVT, D);
          pg8::EpiPerm<FBf> E{{(bf16*)(ws + WS_KV), 2 * D}};
          pg8::gemm_phase(lds, g1024, S, E); }
#endif
    } SEAM(1);
    if (IN(2)) {
        const int blk = blockIdx.x; const bool wide = (G >= 256);
        { const int first = wide ? (blk < 128 ? blk : 128) : blk, step = wide ? 128 : G;
#ifndef NO_GDN
          for (int u = first; u < 128; u += step) { gdn_unit(a, lds, u >> 3, u & 7, tid, wave, lane); __syncthreads(); }
#endif
        }
        { const int first = wide ? ((blk >= 128 && blk < 256) ? blk - 128 : 160) : blk, step = wide ? 128 : G;
#ifndef NO_RG
          for (int u = first; u < 160; u += step) { rg_unit(a, lds, u / 10, u % 10, tid, wave, lane); __syncthreads(); }
#endif
        }
    } SEAM(2);
    if (IN(3)) {
        pg8::DenseOrder S; S.init(NTOK / 256, N1B / 256, G, blockIdx.x, a.out, D, ws + WS_B1B, D);
        pg8::EpiPerm<F1b> E{{P1}};
        pg8::gemm_phase(lds, g1024, S, E);
    } SEAM(3);
    if (IN(4)) {
        { pg8::DenseOrder S; S.init(NTOK / 256, D / 256, G, blockIdx.x, P1 + RXOFF, LDP, ws + WS_WAT, DRNN);
          pg8::EpiPerm<F2a> E{{P1}}; pg8::gemm_phase(lds, pg8::Gemm{LDP, DRNN, DRNN}, S, E); }
        { pg8::DenseOrder S; S.init(NTOK / 256, D / 256, G, blockIdx.x, P1 + VOFF, LDP, ws + WS_WBT, D);
          pg8::EpiPerm<F2b> E{{P1}}; pg8::gemm_phase(lds, pg8::Gemm{LDP, D, D}, S, E); }
    } SEAM(4);
    if (IN(5)) {
        pg8::DenseOrder S; S.init(NTOK / 256, D / 256, G, blockIdx.x, P1 + QOFF, LDP, ws + WS_WOT, D);
        pg8::EpiPlain<FRes> E{{a.in[I_X], a.out}}; pg8::gemm_phase(lds, pg8::Gemm{LDP, D, D}, S, E);
    } SEAM(5);
    if (IN(6)) { bf16* U2 = (bf16*)(ws + WS_U2); for (int m = blockIdx.x * 8 + wave; m < NTOK; m += G * 8) rms_row_to_bf16(a.out + (size_t)m * D, a.in[I_NORM2], U2 + (size_t)m * D, lane);
        const bf16* KV = (const bf16*)(ws + WS_KV); bf16* VT = (bf16*)(ws + WS_VT); LAS bf16* T = (LAS bf16*)(lds + wave * 9216);
        for (int it = blockIdx.x * 8 + wave; it < NB * CAH * 16; it += G * 8) { const int bh = it >> 4, kb = (it >> 2) & 3, db = it & 3, b_ = bh >> 2, h_ = bh & 3;
            const bf16* src = KV + ((size_t)b_ * 256 + 64 * kb + lane) * 2048 + 1024 + h_ * 256 + 64 * db;
#pragma unroll
            for (int q = 0; q < 8; ++q) { const u32x4 w = *(const u32x4*)(src + 8 * q); const unsigned ww[4] = {w.x, w.y, w.z, w.w};
#pragma unroll
                for (int j = 0; j < 4; ++j) { T[(8 * q + 2 * j) * 72 + lane] = (bf16)(ww[j] & 0xffffu); T[(8 * q + 2 * j + 1) * 72 + lane] = (bf16)(ww[j] >> 16); } }
            LDS_WAIT(); asm volatile("" ::: "memory");
            bf16* dst = VT + ((size_t)bh * 256 + 64 * db + lane) * 256 + 64 * kb;
#pragma unroll
            for (int q = 0; q < 8; ++q) *(u32x4*)(dst + 8 * q) = *(const LAS u32x4*)(T + lane * 72 + 8 * q);
            LDS_WAIT(); asm volatile("" ::: "memory"); }
    } SEAM(6);
    if (IN(7)) {
        pg8::DenseOrder S; S.init(NTOK / 256, D / 256, G, blockIdx.x, ws + WS_U2, D, ws + WS_WCQT, D);
        pg8::EpiPerm<FBf> E{{(bf16*)(ws + WS_QC), D}}; pg8::gemm_phase(lds, g1024, S, E);
    } SEAM(7);
    if (IN(8)) {
        constexpr int NU = NB * CAH * 32; const int per = (NU + G - 1) / G;
        for (int i = 0; i < per; ++i) { const int id = blockIdx.x * per + i; if (id < NU) attn_unit(a, lds, id >> 7, (id >> 5) & 3, id & 31, tid, wave, lane); }
    } SEAM(8);
    if (IN(9)) {
        pg8::DenseOrder S; S.init(NTOK / 256, D / 256, G, blockIdx.x, ws + WS_AO, D, ws + WS_WCOT, D);
        pg8::EpiPlain<FRes> E{{a.out, a.out}}; pg8::gemm_phase(lds, g1024, S, E);
    } SEAM(9);
    if (IN(10)) { for (int r0 = (blockIdx.x * 8 + wave) * 16; r0 < NTOK; r0 += G * 8 * 16) router_rows(a, lds, r0, wave, lane); } SEAM(10);
    if (IN(11)) {
        build_moe_tables(a, lds, tid);
        const LAS int* OFF = (const LAS int*)(lds + LDS_T2E + 1024);
        unsigned* fill = ctl + CW_FILL; const int* toke = (const int*)(ws + WS_TOKE); int* s2tk = (int*)(ws + WS_S2TK);
        const float* rstd3 = (const float*)(ws + WS_RSTD3); bf16* XS = (bf16*)(ws + WS_XS);
        for (int m = blockIdx.x * 8 + wave; m < NTOK; m += G * 8) {
            int s0 = 0, s1 = 0;
            if (lane == 0) { const int e0 = toke[2 * m], e1 = toke[2 * m + 1]; s0 = OFF[e0] + (int)atomicAdd(fill + e0, 1u); s1 = OFF[e1] + (int)atomicAdd(fill + e1, 1u); s2tk[s0] = 2 * m; s2tk[s1] = 2 * m + 1; }
            s0 = __shfl(s0, 0); s1 = __shfl(s1, 0);
            const float rstd = rstd3[m]; const f32x4* xr = (const f32x4*)(a.out + (size_t)m * D) + lane; const f32x4* wr_ = (const f32x4*)a.in[I_NORM3] + lane;
            u32x2* o0 = (u32x2*)(XS + (size_t)s0 * D) + lane; u32x2* o1 = (u32x2*)(XS + (size_t)s1 * D) + lane;
#pragma unroll
            for (int j = 0; j < 4; ++j) { const f32x4 v = xr[64 * j] * rstd * wr_[64 * j]; u32x2 o; o.x = cvt_pk_bf16(v[0], v[1]); o.y = cvt_pk_bf16(v[2], v[3]); o0[64 * j] = o; o1[64 * j] = o; }
        }
    } SEAM(11);
    if (IN(12)) {
        const int nT = build_moe_tables(a, lds, tid);
        pg8::MoeOrder S; S.init(nT, 4, G, blockIdx.x, ws + WS_XS, D, ws + WS_WGU, D); S.t2e = lds + LDS_T2E; S.ebytes = (size_t)1024 * 1024 * 2;
        pg8::EpiPerm<FM1> E{{(bf16*)(ws + WS_HID)}}; pg8::gemm_phase(lds, g1024, S, E);
    } SEAM(12);
#if DBG_STAGE == 3
    if (IN(13)) {
        unsigned flags = 0;
        for (size_t m = blockIdx.x * 8 + wave; m < (size_t)NTOK; m += G * 8) { const bf16* rowp = P1 + m * LDP;
            for (int cidx = lane; cidx < LDP; cidx += 64) { const unsigned v = rowp[cidx]; if ((v & 0x7f80u) == 0x7f80u) flags |= (cidx < 1280 ? 1u : cidx < 2560 ? 8u : cidx < 4608 ? 4u : 2u); } }
        for (size_t i = (size_t)blockIdx.x * 512 + tid; i < (size_t)NTOK * D; i += (size_t)G * 512) { const float v = a.out[i]; if (!(fabsf(v) < 1e30f)) flags |= 16u; else if (fabsf(v) > 100.f) flags |= 32u; }
        if (flags) atomicOr((unsigned*)(ws + WS_CTL) + 16, flags);
    }
    if (0) {
#else
    if (IN(13)) {
#endif
        const int nT = build_moe_tables(a, lds, tid);
        pg8::MoeOrder S; S.init(nT, 4, G, blockIdx.x, ws + WS_HID, DEXP, ws + WS_WD, DEXP); S.t2e = lds + LDS_T2E; S.ebytes = (size_t)1024 * 512 * 2;
        pg8::EpiPerm<FM2> E{{(bf16*)(ws + WS_YE), (const int*)(ws + WS_S2TK), (const float*)(ws + WS_TOKW)}}; pg8::gemm_phase(lds, pg8::Gemm{DEXP, DEXP, DEXP}, S, E);
    } SEAM(13);
    if (IN(14)) {
        const bf16* YE = (const bf16*)(ws + WS_YE);
#if DBG_STAGE == 3
        { const int dvi = ((const int*)(ws + WS_CTL))[16]; const float dv = dvi ? (float)dvi : 50.f;
          for (int m = blockIdx.x * 8 + wave; m < NTOK; m += G * 8) { f32x4* xr = (f32x4*)(a.out + (size_t)m * D) + lane;
#pragma unroll
              for (int j = 0; j < 4; ++j) xr[64 * j] = (f32x4){dv, dv, dv, dv}; } }
        if (0)
#endif
        for (int m = blockIdx.x * 8 + wave; m < NTOK; m += G * 8) {
            f32x4* xr = (f32x4*)(a.out + (size_t)m * D) + lane; const f32x4* wr_ = (const f32x4*)a.in[I_NORMF] + lane;
            const f32x4* xin = (DBG_STAGE == 1) ? (const f32x4*)(a.in[I_X] + (size_t)m * D) + lane : (const f32x4*)xr;
            const u32x2* y0 = (const u32x2*)(YE + (size_t)(2 * m) * D) + lane; const u32x2* y1 = (const u32x2*)(YE + (size_t)(2 * m + 1) * D) + lane;
            f32x4 v[4]; float s = 0.f;
#pragma unroll
            for (int j = 0; j < 4; ++j) { f32x4 t = xin[64 * j];
                if (DBG_STAGE == 0) { const u32x2 p = y0[64 * j], q = y1[64 * j];
                    t[0] += bflo(p.x) + bflo(q.x); t[1] += bfhi(p.x) + bfhi(q.x); t[2] += bflo(p.y) + bflo(q.y); t[3] += bfhi(p.y) + bfhi(q.y); }
#ifdef DBG_SANITIZE
#pragma unroll
                for (int q = 0; q < 4; ++q) if (!(fabsf(t[q]) < 1e30f)) t[q] = 0.f;
#endif
                v[j] = t; s += (t[0] * t[0] + t[1] * t[1]) + (t[2] * t[2] + t[3] * t[3]); }
            const float rstd = 1.0f / sqrtf(wave_sum(s) * (1.f / D) + EPS);
#pragma unroll
            for (int j = 0; j < 4; ++j) xr[64 * j] = v[j] * rstd * wr_[64 * j];
        }
    }
#undef IN
#undef SEAM
}

constexpr int NPHASE = 15;
extern "C" void kernel_launch(void* const* d_in, const int* in_sizes, int n_in, void* d_out, int out_size, void* d_ws, size_t ws_size, hipStream_t stream) {
    static int grid = 0;
    if (grid == 0) {
        if (n_in != 32 || out_size != NTOK * D || ws_size < WS_END) { fprintf(stderr, "kernel_launch: unexpected shapes (n_in %d out %d ws %zu)\n", n_in, out_size, ws_size); grid = -1; return; }
        int dev = 0, cus = 0;
        if (hipGetDevice(&dev) != hipSuccess || hipDeviceGetAttribute(&cus, hipDeviceAttributeMultiprocessorCount, dev) != hipSuccess) { grid = -1; return; }
        if (hipFuncSetAttribute((const void*)fwd, hipFuncAttributeMaxDynamicSharedMemorySize, LDS_BYTES) != hipSuccess) { fprintf(stderr, "kernel_launch: hipFuncSetAttribute failed\n"); grid = -1; return; }
        int per_cu = 0;
        if (hipOccupancyMaxActiveBlocksPerMultiprocessor(&per_cu, (const void*)fwd, 512, LDS_BYTES) != hipSuccess || per_cu < 1) { fprintf(stderr, "kernel_launch: occupancy query says %d\n", per_cu); (void)hipGetLastError(); }
        grid = cus;
    }
    if (grid < 0) return;
    hipMemsetAsync((char*)d_ws + WS_CTL, 0, CTL_ZERO_BYTES, stream);
    hipMemsetAsync((char*)d_ws + WS_S2TK, 0xFF, S2TK_BYTES, stream);
    Args a{};
    for (int i = 0; i < 32; ++i) a.in[i] = (const float*)d_in[i];
    a.out = (float*)d_out; a.ws = (unsigned char*)d_ws;
    if (MK_N_LAUNCHES == 1) { a.ph_lo = 0; a.ph_hi = NPHASE; hipLaunchKernelGGL(fwd, dim3(grid), dim3(512), LDS_BYTES, stream, a); }
    else for (int p = 0; p < NPHASE; ++p) { a.ph_lo = p; a.ph_hi = p + 1; hipLaunchKernelGGL(fwd, dim3(grid), dim3(512), LDS_BYTES, stream, a); }
}
```

```cpp
#include <hip/hip_runtime.h>
#include <cstdio>
#include <cstdint>

#ifndef DBG_STAGE
#define DBG_STAGE 0
#endif
#define PROBE_A 2
#ifndef P2_PASSES
#define P2_PASSES 1
#endif
#ifndef REP_MASK
#define REP_MASK 0x0
#endif
#define REPEAT(k) _Pragma("unroll") for (int rep_ = 0; rep_ < 1 + ((REP_MASK >> (k)) & 1); ++rep_)
#define REPSYNC(k) do { if (rep_ < ((REP_MASK >> (k)) & 1)) xcd_barrier(bar); } while (0)
#define PROBE_B 100
#ifndef MK_N_LAUNCHES
#define MK_N_LAUNCHES 1
#endif

#define GAS __attribute__((address_space(1)))
#define LAS __attribute__((address_space(3)))
typedef unsigned short bf16;
typedef short bf16x8 __attribute__((ext_vector_type(8)));
typedef short bf16x4 __attribute__((ext_vector_type(4)));
typedef float f32x4 __attribute__((ext_vector_type(4)));
typedef float f32x2 __attribute__((ext_vector_type(2)));
typedef unsigned u32x4 __attribute__((ext_vector_type(4)));
typedef unsigned u32x2 __attribute__((ext_vector_type(2)));

constexpr int D = 1024, NB = 16, SEQ = 4096, NTOK = NB * SEQ;
constexpr int DRNN = 1280, NHD = 8, HD = 128, NMEM = 256, CAH = 4, CAD = 256;
constexpr int DIN = 8720;
constexpr int LDP = 5632;
constexpr int RXOFF = 0, RGOFF = 1280, QOFF = 2560, KOFF = 3584, VOFF = 4608;
constexpr int N1A = 5888, N1B = 3072;
constexpr int NEXP = 64, DEXP = 512;
constexpr int MAXTILES = 576;
constexpr float EPS = 1e-6f;

constexpr size_t MiB = 1u << 20;
constexpr size_t WS_CTL = 0;
constexpr size_t CTL_ZERO_BYTES = 256 * 1024;
constexpr size_t WS_S2TK = 1 * MiB;
constexpr size_t S2TK_BYTES = (size_t)MAXTILES * 256 * 4;
constexpr size_t WS_P1 = 4 * MiB;
constexpr size_t WS_WGU = 708 * MiB;
constexpr size_t WS_WD = 772 * MiB;
constexpr size_t WS_H2A = 804 * MiB;
constexpr size_t WS_H2B = 979 * MiB;
constexpr size_t WS_B1A = 900 * MiB;
constexpr size_t WS_B1B = 912 * MiB;
constexpr size_t WS_WAT = 918 * MiB;
constexpr size_t WS_WBT = 921 * MiB;
constexpr size_t WS_WOT = 923 * MiB;
constexpr size_t WS_WCQT = 925 * MiB;
constexpr size_t WS_WKVT = 927 * MiB;
constexpr size_t WS_WCOT = 931 * MiB;
constexpr size_t WS_G = 933 * MiB;
constexpr size_t WS_BETA = 935 * MiB;
constexpr size_t WS_KV = 937 * MiB;
constexpr size_t WS_VT = 953 * MiB;
constexpr size_t WS_MEMN = 961 * MiB;
constexpr size_t WS_WRT = 969 * MiB;
constexpr size_t WS_RSTD3 = 970 * MiB;
constexpr size_t WS_TOKE = 971 * MiB;
constexpr size_t WS_TOKW = 972 * MiB;
constexpr size_t WS_RGW = 973 * MiB;
constexpr size_t WS_TOKP = 974 * MiB;
constexpr size_t WS_SSQ = 975 * MiB;
constexpr size_t WS_END = 1011 * MiB;
constexpr size_t WS_U2 = WS_P1, WS_QC = WS_P1 + 128 * MiB, WS_AO = WS_P1 + 256 * MiB;
constexpr size_t WS_XS = WS_P1, WS_HID = WS_P1 + 288 * MiB, WS_YE = WS_P1 + 432 * MiB;
constexpr int CW_BAR = 4096;
constexpr int CW_CNT = 8192;
constexpr int CW_FILL = 8192 + 64;

constexpr int LDS_BYTES = 163840;
constexpr int LDS_MISC = LDS_BYTES - 64;
constexpr int LDS_T2E = 131072;

#define LDS_WAIT() asm volatile("s_waitcnt lgkmcnt(0)" ::: "memory")
#define LBAR() asm volatile("s_waitcnt lgkmcnt(0)\n\ts_barrier" ::: "memory")
#define VM_WAIT() asm volatile("s_waitcnt vmcnt(0)" ::: "memory")
#define MFMA(x, y, c) __builtin_amdgcn_mfma_f32_16x16x32_bf16((x), (y), (c), 0, 0, 0)
typedef __bf16 bf16v2 __attribute__((ext_vector_type(2)));
__device__ __forceinline__ unsigned cvt_pk_bf16(float lo, float hi) { const f32x2 v = {lo, hi}; const bf16v2 r = __builtin_convertvector(v, bf16v2); return __builtin_bit_cast(unsigned, r); }
__device__ __forceinline__ bf16 f2bf(float f) { return (bf16)(cvt_pk_bf16(f, 0.f) & 0xffffu); }
__device__ __forceinline__ float bf2f(unsigned b) { return __uint_as_float(b << 16); }
__device__ __forceinline__ float bflo(unsigned w) { return __uint_as_float(w << 16); }
__device__ __forceinline__ float bfhi(unsigned w) { return __uint_as_float(w & 0xffff0000u); }
__device__ __forceinline__ void unpack8(const u32x4 w, float* f) { f[0] = bflo(w.x); f[1] = bfhi(w.x); f[2] = bflo(w.y); f[3] = bfhi(w.y); f[4] = bflo(w.z); f[5] = bfhi(w.z); f[6] = bflo(w.w); f[7] = bfhi(w.w); }
__device__ __forceinline__ u32x4 pack8(const f32x4 a, const f32x4 b) { u32x4 w; w.x = cvt_pk_bf16(a[0], a[1]); w.y = cvt_pk_bf16(a[2], a[3]); w.z = cvt_pk_bf16(b[0], b[1]); w.w = cvt_pk_bf16(b[2], b[3]); return w; }
__device__ __forceinline__ bf16x8 pack8v(const f32x4 a, const f32x4 b) { const u32x4 w = pack8(a, b); return __builtin_bit_cast(bf16x8, w); }
__device__ __forceinline__ unsigned pk4_fp8(float a, float b, float c, float d) {
    a = fminf(fmaxf(a, -448.f), 448.f); b = fminf(fmaxf(b, -448.f), 448.f); c = fminf(fmaxf(c, -448.f), 448.f); d = fminf(fmaxf(d, -448.f), 448.f);
    int w = __builtin_amdgcn_cvt_pk_fp8_f32(a, b, 0, false); w = __builtin_amdgcn_cvt_pk_fp8_f32(c, d, w, true); return (unsigned)w; }
constexpr float F8_SA = 16.f, F8_SW = 64.f, F8_SH = 16.f;
constexpr float F8_SQW = 1024.f, F8_SAO = 64.f;
constexpr int LDP8 = 11264;
__device__ __forceinline__ float sigmoidf_(float x) { return __builtin_amdgcn_rcpf(1.0f + __expf(-x)); }
__device__ __forceinline__ float siluf_(float x) { return x * __builtin_amdgcn_rcpf(1.0f + __expf(-x)); }
__device__ __forceinline__ float softplusf_(float x) { return x > 20.f ? x : log1pf(__expf(x)); }
__device__ __forceinline__ float gelu_tanh(float x) { const float u = 1.5957691216057308f * (x + 0.044715f * x * x * x); return x * __builtin_amdgcn_rcpf(1.0f + __expf(-u)); }
__device__ __forceinline__ float wave_sum(float v) {
#pragma unroll
    for (int o = 1; o < 64; o <<= 1) v += __shfl_xor(v, o);
    return v;
}

__device__ __forceinline__ bf16* h2row(unsigned char* ws, size_t row) { return row < 49152 ? (bf16*)(ws + WS_H2A) + row * D : (bf16*)(ws + WS_H2B) + (row - 49152) * D; }

#define XB_TMO      128
#define XB_XCNT(j)  (256  + 64 * (j))
#define XB_XSUB(j)  (1280 + 64 * (j))
#define XB_XGEN(j)  (2304 + 64 * (j))
#define XB_TOP      3328
#define XB_TOPGEN   3392
#define XCD_BAR_WORDS 3456
#define XB_SPIN_CAP (1u << 18)
__device__ __forceinline__ unsigned xb_ld(unsigned* p)              { return __hip_atomic_load(p, __ATOMIC_RELAXED, __HIP_MEMORY_SCOPE_AGENT); }
__device__ __forceinline__ unsigned xb_add(unsigned* p, unsigned v) { return __hip_atomic_fetch_add(p, v, __ATOMIC_RELAXED, __HIP_MEMORY_SCOPE_AGENT); }
__device__ __forceinline__ unsigned xb_xcc_id() { return (unsigned)__builtin_amdgcn_s_getreg((3 << 11) | 20) & 0xFu; }
#define XB_SPIN(cond, bar) do { unsigned _sp = 0; while (cond) { __builtin_amdgcn_s_sleep(1); \
    if ((++_sp & 255u) == 0u) { if (xb_ld(&(bar)[XB_TMO])) break; if (_sp > XB_SPIN_CAP) { atomicAdd(&(bar)[XB_TMO], 1u); break; } } } } while (0)
struct XcdBarrier { unsigned* bar; unsigned x; volatile LAS unsigned* st; };
__device__ __forceinline__ XcdBarrier xcd_barrier_post(unsigned* bar, volatile LAS unsigned* st) {
    XcdBarrier b; b.bar = bar; b.x = xb_xcc_id(); b.st = st;
    if (threadIdx.x == 0) (void)xb_add(&bar[XB_XCNT(b.x)], 1u);
    return b;
}
__device__ __forceinline__ void xcd_barrier_complete(unsigned* bar, unsigned x, unsigned& nloc, unsigned& nx) {
    const unsigned G = gridDim.x * gridDim.y * gridDim.z;
    unsigned sum, cnt, mine, sp = 0u;
    for (;;) {
        sum = 0u; cnt = 0u; mine = 0u;
#pragma unroll
        for (unsigned j = 0; j < 16; ++j) { const unsigned c = xb_ld(&bar[XB_XCNT(j)]); sum += c; cnt += (c > 0u) ? 1u : 0u; mine = (j == x) ? c : mine; }
        if (sum == G) break;
        __builtin_amdgcn_s_sleep(1);
        if ((++sp & 255u) == 0u) { if (xb_ld(&bar[XB_TMO])) break; if (sp > XB_SPIN_CAP) { atomicAdd(&bar[XB_TMO], 1u); break; } }
    }
    nloc = mine > 0u ? mine : 1u; nx = cnt > 0u ? cnt : 1u;
}
__device__ __forceinline__ void xcd_barrier(const XcdBarrier& b) {
    asm volatile("s_waitcnt vmcnt(0)" ::: "memory");
    __syncthreads();
    if (threadIdx.x == 0) {
        unsigned* bar = b.bar;
        __builtin_amdgcn_s_waitcnt(0);
        unsigned nloc = b.st[0], nx = b.st[1];
        if (nloc == 0u) { xcd_barrier_complete(bar, b.x, nloc, nx); b.st[0] = nloc; b.st[1] = nx; }
        const unsigned old = xb_add(&bar[XB_XSUB(b.x)], 1u);
        const unsigned gen = old / nloc;
        if (old + 1u == (gen + 1u) * nloc) {
            __builtin_amdgcn_fence(__ATOMIC_RELEASE, "agent");
            asm volatile("s_waitcnt vmcnt(0)" ::: "memory");
            const unsigned og = xb_add(&bar[XB_TOP], 1u);
            const unsigned tg = og / nx;
            if (og + 1u == (tg + 1u) * nx) xb_add(&bar[XB_TOPGEN], 1u);
            else XB_SPIN(xb_ld(&bar[XB_TOPGEN]) == tg, bar);
            __builtin_amdgcn_fence(__ATOMIC_ACQUIRE, "agent");
            xb_add(&bar[XB_XGEN(b.x)], 1u);
            asm volatile("s_waitcnt vmcnt(0)" ::: "memory");
        } else {
            XB_SPIN(xb_ld(&bar[XB_XGEN(b.x)]) == gen, bar);
            __builtin_amdgcn_fence(__ATOMIC_ACQUIRE, "agent");
            asm volatile("s_waitcnt vmcnt(0)" ::: "memory");
        }
    }
    __syncthreads();
}

namespace pg8 {
typedef int v4i_t __attribute__((ext_vector_type(4)));
typedef int v8i_t __attribute__((ext_vector_type(8)));
constexpr int BM = 256, BK = 64, HALF = 128, HTB = HALF * BK * 2, STAGE_BYTES = 8 * HTB, NXCD = 8, WGM = 8;
__host__ __device__ __forceinline__ int lds_byte(int r, int c) { const int st = (r >> 4) * 2 + (c >> 5), rr = r & 15, cc = c & 31, ob = rr * 64 + cc * 2; return st * 1024 + (ob ^ (((ob >> 9) & 1) << 5)); }
__host__ __device__ __forceinline__ void stage_rc(int b, int& R, int& C) { const int st = b / 1024, sb = b % 1024, swz = sb ^ (((sb >> 9) & 1) << 5); R = (st >> 1) * 16 + swz / 64; C = (st & 1) * 32 + (swz % 64) / 2; }
__host__ __device__ __forceinline__ int perm32(int rho) { const int n = rho >> 4, i = rho & 15; return 8 * (i >> 2) + 4 * n + (i & 3); }
struct Unit { int pm, pn; };
struct Gemm { int lda, ldb, K; int ajump = 0; };

struct DenseOrder {
    int nM, nN, nwg, G, c; const char* A; const char* B; size_t atile, btile;
    __device__ void init(int nM_, int nN_, int G_, int c_, const void* A_, size_t lda, const void* B_, size_t ldb, int esz = 2) { nM = nM_; nN = nN_; nwg = nM * nN; G = G_; c = c_; A = (const char*)A_; B = (const char*)B_; atile = 256 * lda * esz; btile = 256 * ldb * esz; }
    __device__ bool next(int i, Unit& u) const {
        const long L = (long)i * G + c; if (L >= nwg) return false;
        int wgid = (int)L; { const int q = nwg / NXCD, r = nwg % NXCD, xcd = wgid % NXCD, off = wgid / NXCD; wgid = (xcd < r ? xcd * (q + 1) : r * (q + 1) + (xcd - r) * q) + off; }
        const int nig = WGM * nN, gid = wgid / nig, fm = gid * WGM, gsz = (nM - fm) < WGM ? (nM - fm) : WGM;
        u.pm = fm + ((wgid % nig) % gsz); u.pn = (wgid % nig) / gsz; return true;
    }
    __device__ __forceinline__ const char* aptr(const Unit& u) const { return A + (size_t)u.pm * atile; }
    __device__ __forceinline__ const char* bptr(const Unit& u) const { return B + (size_t)u.pn * btile; }
};
struct SplitOrder : DenseOrder {
    int nid;
    __device__ bool next(int i, Unit& u) const {
        const int id = c + (i % nid), round = i / nid;
        const long L = (long)round * G + id; if (L >= nwg) return false;
        int wgid = (int)L; { const int q = nwg / NXCD, r = nwg % NXCD, xcd = wgid % NXCD, off = wgid / NXCD; wgid = (xcd < r ? xcd * (q + 1) : r * (q + 1) + (xcd - r) * q) + off; }
        const int nig = WGM * nN, gid = wgid / nig, fm = gid * WGM, gsz = (nM - fm) < WGM ? (nM - fm) : WGM;
        u.pm = fm + ((wgid % nig) % gsz); u.pn = (wgid % nig) / gsz; return true;
    }
};
struct RangeOrder : DenseOrder {
    int start, count;
    __device__ bool next(int i, Unit& u) const {
        if (i >= count) return false;
        const int wgid = start + i; if (wgid >= nwg) return false;
        const int nig = WGM * nN, gid = wgid / nig, fm = gid * WGM, gsz = (nM - fm) < WGM ? (nM - fm) : WGM;
        u.pm = fm + ((wgid % nig) % gsz); u.pn = (wgid % nig) / gsz; return true;
    }
};
struct DenseOrder2 : DenseOrder {
    const char* B2; int nsplit;
    __device__ __forceinline__ const char* bptr(const Unit& u) const { return u.pn < nsplit ? B + (size_t)u.pn * btile : B2 + (size_t)(u.pn - nsplit) * btile; }
};
struct MoeOrder : DenseOrder {
    const LAS unsigned char* t2e; size_t ebytes;
    __device__ __forceinline__ const char* bptr(const Unit& u) const { const int e = __builtin_amdgcn_readfirstlane((int)t2e[u.pm]); return B + (size_t)e * ebytes + (size_t)u.pn * btile; }
};

template <class F> struct EpiPerm {
    static constexpr bool PERM = true; F f;
    __device__ __forceinline__ void operator()(const f32x4 (&acc)[2][2][4][2], const Unit& u, int wr, int wc, int fr, int fq) const {
#pragma unroll
        for (int ai = 0; ai < 2; ++ai)
#pragma unroll
            for (int m = 0; m < 4; ++m) f(u, ai * HALF + wr * 64 + m * 16 + fr, wc * 32 + 8 * fq, acc[ai][0][m][0], acc[ai][0][m][1], acc[ai][1][m][0], acc[ai][1][m][1]);
    }
};
template <class F> struct EpiPlain {
    static constexpr bool PERM = false; F f;
    __device__ __forceinline__ void operator()(const f32x4 (&acc)[2][2][4][2], const Unit& u, int wr, int wc, int fr, int fq) const {
#pragma unroll
        for (int ai = 0; ai < 2; ++ai)
#pragma unroll
            for (int m = 0; m < 4; ++m)
#pragma unroll
                for (int bj = 0; bj < 2; ++bj)
#pragma unroll
                    for (int n = 0; n < 2; ++n) f(u, ai * HALF + wr * 64 + m * 16 + fr, bj * HALF + wc * 32 + n * 16 + 4 * fq, acc[ai][bj][m][n]);
    }
};

template <class Epi, class Sched, bool FP8 = false, int MIDT = -1>
__device__ __forceinline__ void gemm_phase(LAS unsigned char* lds, const Gemm g, const Sched& S, const Epi& E) {
    const int tid = threadIdx.x, wid = __builtin_amdgcn_readfirstlane(tid >> 6), lane = tid & 63, wr = wid >> 2, wc = wid & 3, fr = lane & 15, fq = lane >> 4;
    constexpr unsigned ESZ = FP8 ? 1u : 2u;
    const int K = g.K, nt = FP8 ? K / 128 : K / BK;
    unsigned voffA[2], voffB[2];
#pragma unroll
    for (int i = 0; i < 2; ++i) { int R, C; stage_rc(tid * 16 + i * 8192, R, C); const int Rb = Epi::PERM ? ((R & ~31) + perm32(R & 31)) : R;
        voffA[i] = (unsigned)(R * g.lda) * ESZ + (unsigned)C * 2u; voffB[i] = (unsigned)(Rb * g.ldb) * ESZ + (unsigned)C * 2u; }
    const size_t kstep = (size_t)(BK * 2);
    const size_t hstepA = (size_t)HALF * g.lda * ESZ, hstepB = (size_t)HALF * g.ldb * ESZ;
    const unsigned ldsw = (unsigned)wid * 1024u;
    const int aoff = lds_byte(wr * 64 + fr, fq * 8), boff = lds_byte(wc * 32 + fr, fq * 8);
#define PG8_SA(b, h) (((b) * 2 + (h)) * HTB)
#define PG8_SB(b, h) ((4 + (b) * 2 + (h)) * HTB)
#define PG8_STAGE(bufoff, gbase, voff) do { _Pragma("unroll") for (int _i = 0; _i < 2; ++_i) \
        __builtin_amdgcn_global_load_lds((const unsigned*)((const char*)(gbase) + (voff)[_i]), (LAS unsigned*)(lds + (bufoff) + ldsw + _i * 8192), 16, 0, 0); } while (0)
#define PG8_LDA(dst, b, h) do { _Pragma("unroll") for (int m = 0; m < 4; ++m) _Pragma("unroll") for (int k = 0; k < 2; ++k) dst[m][k] = *(const LAS v4i_t*)(lds + PG8_SA(b, h) + aoff + m * 2048 + k * 1024); } while (0)
#define PG8_LDB(dst, b, h) do { _Pragma("unroll") for (int n = 0; n < 2; ++n) _Pragma("unroll") for (int k = 0; k < 2; ++k) dst[n][k] = *(const LAS v4i_t*)(lds + PG8_SB(b, h) + boff + n * 2048 + k * 1024); } while (0)
#define PG8_CAT(q) __builtin_shufflevector((q)[0], (q)[1], 0, 1, 2, 3, 4, 5, 6, 7)
#define PG8_MMA(ai, bj, At, Bt) do { __builtin_amdgcn_s_setprio(1); _Pragma("unroll") for (int m = 0; m < 4; ++m) _Pragma("unroll") for (int n = 0; n < 2; ++n) { \
        if constexpr (FP8) asm volatile("v_mfma_f32_16x16x128_f8f6f4 %0, %1, %2, %0" : "+v"(acc[ai][bj][m][n]) : "v"(PG8_CAT(Bt[n])), "v"(PG8_CAT(At[m])));     \
        else { _Pragma("unroll") for (int k = 0; k < 2; ++k) acc[ai][bj][m][n] = __builtin_amdgcn_mfma_f32_16x16x32_bf16(__builtin_bit_cast(bf16x8, Bt[n][k]), __builtin_bit_cast(bf16x8, At[m][k]), acc[ai][bj][m][n], 0, 0, 0); } } \
        __builtin_amdgcn_s_setprio(0); } while (0)
#define PG8_WAIT_V(n) asm volatile("s_waitcnt vmcnt(" #n ")" ::: "memory")
#define PG8_WAIT_L(n) asm volatile("s_waitcnt lgkmcnt(" #n ")" ::: "memory")
#define PG8_BAR __builtin_amdgcn_s_barrier()
#define PG8_SCHED __builtin_amdgcn_sched_barrier(0)
    Unit cur, nxt; int ui = 0;
    if (!S.next(0, cur)) return;
    f32x4 acc[2][2][4][2];
#pragma unroll
    for (int a = 0; a < 2; ++a)
#pragma unroll
        for (int b = 0; b < 2; ++b)
#pragma unroll
            for (int m = 0; m < 4; ++m)
#pragma unroll
                for (int n = 0; n < 2; ++n) acc[a][b][m][n] = (f32x4){0.f, 0.f, 0.f, 0.f};
    v4i_t At[4][2], B0[2][2], B1[2][2];
    const char* cA = S.aptr(cur); const char* cB = S.bptr(cur);
    PG8_STAGE(PG8_SB(0, 0), cB, voffB); PG8_STAGE(PG8_SB(0, 1), cB + hstepB, voffB); PG8_STAGE(PG8_SA(0, 0), cA, voffA); PG8_STAGE(PG8_SA(0, 1), cA + hstepA, voffA);
    if (wr == 1) PG8_BAR;
    PG8_WAIT_V(2); PG8_BAR;
    PG8_STAGE(PG8_SB(1, 0), cB + kstep, voffB); PG8_STAGE(PG8_SA(1, 0), cA + kstep, voffA); PG8_STAGE(PG8_SB(1, 1), cB + hstepB + kstep, voffB);
    PG8_WAIT_V(6); PG8_BAR;
    for (;;) {
        const bool has_next = S.next(ui + 1, nxt);
        const char* nA = has_next ? S.aptr(nxt) : cA; const char* nB = has_next ? S.bptr(nxt) : cB;
#pragma unroll 1
        for (int t = 0; t < nt; t += 2) {
            const bool last = (t == nt - 2);
            if constexpr (MIDT >= 0) { if (t == MIDT) { int t2 = threadIdx.x; asm volatile("" : "+v"(t2)); const int w2 = __builtin_amdgcn_readfirstlane(t2 >> 6), l2 = t2 & 63; E.mid(acc, cur, w2 >> 2, w2 & 3, l2 & 15, l2 >> 4); } }
            const size_t j1 = (MIDT >= 0 && t + 1 >= MIDT) ? (size_t)g.ajump : 0, j2 = (MIDT >= 0 && t + 2 >= MIDT) ? (size_t)g.ajump : 0;
            const char* a1 = cA + (size_t)(t + 1) * kstep + j1;
            const char* a2 = last ? nA : cA + (size_t)(t + 2) * kstep + j2; const char* b2 = last ? nB : cB + (size_t)(t + 2) * kstep;
            const char* a3 = a2 + kstep; const char* b3 = b2 + kstep;
            PG8_LDB(B0, 0, 0); PG8_LDB(B1, 0, 1); PG8_SCHED; PG8_LDA(At, 0, 0); PG8_STAGE(PG8_SA(1, 1), a1 + hstepA, voffA);
            PG8_WAIT_V(8); PG8_WAIT_L(0); PG8_BAR; PG8_MMA(0, 0, At, B0); PG8_MMA(0, 1, At, B1); PG8_BAR; PG8_SCHED;
            PG8_LDA(At, 0, 1); PG8_STAGE(PG8_SB(0, 0), b2, voffB); PG8_STAGE(PG8_SB(0, 1), b2 + hstepB, voffB); PG8_STAGE(PG8_SA(0, 0), a2, voffA);
            PG8_WAIT_V(8); PG8_WAIT_L(0); PG8_BAR; PG8_MMA(1, 0, At, B0); PG8_MMA(1, 1, At, B1); PG8_BAR; PG8_SCHED;
            PG8_LDB(B0, 1, 0); PG8_LDB(B1, 1, 1); PG8_SCHED; PG8_LDA(At, 1, 0); PG8_STAGE(PG8_SA(0, 1), a2 + hstepA, voffA);
            PG8_WAIT_V(8); PG8_WAIT_L(0); PG8_BAR; PG8_MMA(0, 0, At, B0); PG8_MMA(0, 1, At, B1); PG8_BAR; PG8_SCHED;
            PG8_LDA(At, 1, 1); PG8_STAGE(PG8_SB(1, 0), b3, voffB); PG8_STAGE(PG8_SB(1, 1), b3 + hstepB, voffB); PG8_STAGE(PG8_SA(1, 0), a3, voffA);
            PG8_WAIT_V(8); PG8_WAIT_L(0); PG8_BAR; PG8_MMA(1, 0, At, B0); PG8_MMA(1, 1, At, B1); PG8_BAR; PG8_SCHED;
        }
        if constexpr (FP8) asm volatile("s_nop 15\n\ts_nop 15\n\ts_nop 15" ::: "memory");
        if (wr == 0) PG8_BAR;
        { int t2 = threadIdx.x; asm volatile("" : "+v"(t2));
          const int w2 = __builtin_amdgcn_readfirstlane(t2 >> 6), l2 = t2 & 63; E(acc, cur, w2 >> 2, w2 & 3, l2 & 15, l2 >> 4); }
        if (!has_next) break;
#pragma unroll
        for (int a = 0; a < 2; ++a)
#pragma unroll
            for (int b = 0; b < 2; ++b)
#pragma unroll
                for (int m = 0; m < 4; ++m)
#pragma unroll
                    for (int n = 0; n < 2; ++n) acc[a][b][m][n] = (f32x4){0.f, 0.f, 0.f, 0.f};
        cur = nxt; cA = nA; cB = nB; ++ui;
        if (wr == 1) PG8_BAR;
    }
    PG8_WAIT_V(0);
    PG8_BAR;
#undef PG8_SA
#undef PG8_SB
#undef PG8_STAGE
#undef PG8_LDA
#undef PG8_LDB
#undef PG8_MMA
#undef PG8_WAIT_V
#undef PG8_WAIT_L
#undef PG8_BAR
#undef PG8_SCHED
}
}
using pg8::Unit;

__device__ __forceinline__ void st8(bf16* p, const f32x4 a, const f32x4 b) { *(u32x4*)p = pack8(a, b); }
struct F1a {
    bf16* P1; float* gbuf; float* betabuf; unsigned char* ws;
    static __device__ __forceinline__ f32x4 silu4(const f32x4 v) { return (f32x4){siluf_(v[0]), siluf_(v[1]), siluf_(v[2]), siluf_(v[3])}; }
    __device__ __forceinline__ void operator()(const Unit& u, int r, int c, const f32x4 a0, const f32x4 a1, const f32x4 b0, const f32x4 b1) const {
        const size_t row = (size_t)u.pm * 256 + r;
        if (u.pn < 22) { bf16* p = P1 + row * LDP + u.pn * 256 + c; st8(p, a0, a1); st8(p + 128, b0, b1); }
        else if (u.pn >= 23) { bf16* p = h2row(ws, row) + (u.pn - 23) * 256 + c; st8(p, silu4(a0), silu4(a1)); st8(p + 128, silu4(b0), silu4(b1)); }
        else if (c == 0) { *(f32x4*)(gbuf + row * 8) = a0; *(f32x4*)(gbuf + row * 8 + 4) = a1; }
        else if (c == 8) { *(f32x4*)(betabuf + row * 8) = a0; *(f32x4*)(betabuf + row * 8 + 4) = a1; }
    }
};
struct F1b {
    bf16* P1;
    __device__ __forceinline__ void zmul(bf16* p, const f32x4 a, const f32x4 b) const {
        const u32x4 w = *(const u32x4*)p; float o[8]; unpack8(w, o); f32x4 x, y;
#pragma unroll
        for (int j = 0; j < 4; ++j) { x[j] = o[j] * siluf_(a[j]); y[j] = o[4 + j] * siluf_(b[j]); }
        st8(p, x, y);
    }
    __device__ __forceinline__ void operator()(const Unit& u, int r, int c, const f32x4 a0, const f32x4 a1, const f32x4 b0, const f32x4 b1) const {
        bf16* p = P1 + ((size_t)u.pm * 256 + r) * LDP + VOFF + u.pn * 256 + c; zmul(p, a0, a1); zmul(p + 128, b0, b1);
    }
};
struct FGate {
    unsigned char* SG;
    __device__ __forceinline__ unsigned q4(const f32x4 v) const { unsigned r = 0;
#pragma unroll
        for (int j = 0; j < 4; ++j) r |= (unsigned)(sigmoidf_(v[j] * (1.f / (F8_SA * F8_SW))) * 255.f + 0.5f) << (8 * j);
        return r; }
    __device__ __forceinline__ void operator()(const Unit& u, int r, int c, const f32x4 a0, const f32x4 a1, const f32x4 b0, const f32x4 b1) const {
        unsigned char* p = SG + ((size_t)u.pm * 256 + r) * 2048 + u.pn * 256 + c;
        u32x2 x; x.x = q4(a0); x.y = q4(a1); *(u32x2*)p = x; u32x2 y; y.x = q4(b0); y.y = q4(b1); *(u32x2*)(p + 128) = y;
    }
};
struct EpiMix {
    static constexpr bool PERM = true;
    bf16* P1; const unsigned char* SG;
    static __device__ __forceinline__ f32x4 b4(unsigned w) { return (f32x4){(float)(w & 255u), (float)((w >> 8) & 255u), (float)((w >> 16) & 255u), (float)(w >> 24)}; }
    static __device__ __forceinline__ f32x4 max1(const f32x4 v) { return (f32x4){fmaxf(v[0], 1.f), fmaxf(v[1], 1.f), fmaxf(v[2], 1.f), fmaxf(v[3], 1.f)}; }
    static __device__ __forceinline__ f32x4 rcp4(const f32x4 v) { return (f32x4){__builtin_amdgcn_rcpf(v[0]), __builtin_amdgcn_rcpf(v[1]), __builtin_amdgcn_rcpf(v[2]), __builtin_amdgcn_rcpf(v[3])}; }
    __device__ __forceinline__ void mid(f32x4 (&acc)[2][2][4][2], const Unit& u, int wr, int wc, int fr, int fq) const {
#pragma unroll
        for (int ai = 0; ai < 2; ++ai)
#pragma unroll
            for (int m = 0; m < 4; ++m) { const size_t row = (size_t)u.pm * 256 + ai * 128 + wr * 64 + m * 16 + fr; const unsigned char* sg = SG + row * 2048 + u.pn * 256 + wc * 32 + 8 * fq;
#pragma unroll
                for (int bj = 0; bj < 2; ++bj) { const u32x2 wa = *(const u32x2*)(sg + 128 * bj), wb = *(const u32x2*)(sg + 1024 + 128 * bj);
                    acc[ai][bj][m][0] *= b4(wa.x) * rcp4(max1(b4(wb.x))); acc[ai][bj][m][1] *= b4(wa.y) * rcp4(max1(b4(wb.y))); } }
    }
    __device__ __forceinline__ void operator()(const f32x4 (&acc)[2][2][4][2], const Unit& u, int wr, int wc, int fr, int fq) const {
#pragma unroll
        for (int ai = 0; ai < 2; ++ai)
#pragma unroll
            for (int m = 0; m < 4; ++m) { const size_t row = (size_t)u.pm * 256 + ai * 128 + wr * 64 + m * 16 + fr; const int c = u.pn * 256 + wc * 32 + 8 * fq; const unsigned char* sg = SG + row * 2048 + 1024 + c;
#pragma unroll
                for (int bj = 0; bj < 2; ++bj) { const u32x2 wb = *(const u32x2*)(sg + 128 * bj);
                    st8(P1 + row * LDP + QOFF + c + 128 * bj, acc[ai][bj][m][0] * (max1(b4(wb.x)) * (1.f / 255.f)), acc[ai][bj][m][1] * (max1(b4(wb.y)) * (1.f / 255.f))); } }
    }
};
struct F2a {
    bf16* P1; const unsigned char* SG;
    __device__ __forceinline__ void one(bf16* rowp, const unsigned char* sg, int col, const f32x4 a, const f32x4 b) const {
        const u32x2 w = *(const u32x2*)(sg + col); f32x4 x, y;
#pragma unroll
        for (int j = 0; j < 4; ++j) { x[j] = a[j] * ((float)((w.x >> (8 * j)) & 255u) * (1.f / 255.f)); y[j] = b[j] * ((float)((w.y >> (8 * j)) & 255u) * (1.f / 255.f)); }
        st8(rowp + QOFF + col, x, y);
    }
    __device__ __forceinline__ void operator()(const Unit& u, int r, int c, const f32x4 a0, const f32x4 a1, const f32x4 b0, const f32x4 b1) const {
        const size_t row = (size_t)u.pm * 256 + r; bf16* rowp = P1 + row * LDP; const unsigned char* sg = SG + row * 2048; one(rowp, sg, u.pn * 256 + c, a0, a1); one(rowp, sg, u.pn * 256 + 128 + c, b0, b1);
    }
};
struct F2b {
    bf16* P1; const unsigned char* SG;
    __device__ __forceinline__ void one(bf16* rowp, const unsigned char* sg, int col, const f32x4 a, const f32x4 b) const {
        const u32x2 w = *(const u32x2*)(sg + 1024 + col);
        const u32x4 mw = *(const u32x4*)(rowp + QOFF + col); float ma[8]; unpack8(mw, ma); f32x4 x, y;
#pragma unroll
        for (int j = 0; j < 4; ++j) { x[j] = ma[j] + a[j] * ((float)((w.x >> (8 * j)) & 255u) * (1.f / 255.f)); y[j] = ma[4 + j] + b[j] * ((float)((w.y >> (8 * j)) & 255u) * (1.f / 255.f)); }
        st8(rowp + QOFF + col, x, y);
    }
    __device__ __forceinline__ void operator()(const Unit& u, int r, int c, const f32x4 a0, const f32x4 a1, const f32x4 b0, const f32x4 b1) const {
        const size_t row = (size_t)u.pm * 256 + r; bf16* rowp = P1 + row * LDP; const unsigned char* sg = SG + row * 2048; one(rowp, sg, u.pn * 256 + c, a0, a1); one(rowp, sg, u.pn * 256 + 128 + c, b0, b1);
    }
};
struct FH2 {
    const bf16* H1; unsigned char* ws;
    __device__ __forceinline__ void operator()(const Unit& u, int r, int c, const f32x4 v) const {
        const size_t row = (size_t)u.pm * 256 + r; const int col = u.pn * 256 + c;
        const u32x2 w = *(const u32x2*)(H1 + row * D + col); const f32x4 h = (f32x4){bflo(w.x), bfhi(w.x), bflo(w.y), bfhi(w.y)} + v * (1.f / (F8_SAO * F8_SW));
        u32x2 o; o.x = cvt_pk_bf16(h[0], h[1]); o.y = cvt_pk_bf16(h[2], h[3]); *(u32x2*)(h2row(ws, row) + col) = o;
    }
};
struct FRes {
    const float* base; float* out;
    __device__ __forceinline__ void operator()(const Unit& u, int r, int c, const f32x4 v) const {
        const size_t o = ((size_t)u.pm * 256 + r) * D + u.pn * 256 + c; *(f32x4*)(out + o) = *(const f32x4*)(base + o) + v;
    }
};
struct EpiH1 {
    static constexpr bool PERM = false;
    const float* x; bf16* HB; int ldh; float* SSQ; unsigned char* H8;
    __device__ __forceinline__ void operator()(const f32x4 (&acc)[2][2][4][2], const Unit& u, int wr, int wc, int fr, int fq) const {
#pragma unroll
        for (int ai = 0; ai < 2; ++ai)
#pragma unroll
            for (int m = 0; m < 4; ++m) { const size_t row = (size_t)u.pm * 256 + ai * 128 + wr * 64 + m * 16 + fr; float ss = 0.f;
#pragma unroll
                for (int bj = 0; bj < 2; ++bj)
#pragma unroll
                    for (int n = 0; n < 2; ++n) { const int col = u.pn * 256 + bj * 128 + wc * 32 + n * 16 + 4 * fq; const size_t o = row * D + col;
                        const f32x4 h = *(const f32x4*)(x + o) + acc[ai][bj][m][n];
                        u32x2 p; p.x = cvt_pk_bf16(h[0], h[1]); p.y = cvt_pk_bf16(h[2], h[3]); *(u32x2*)(HB + row * ldh + col) = p;
                        *(unsigned*)(H8 + row * LDP8 + col) = pk4_fp8(h[0] * F8_SA, h[1] * F8_SA, h[2] * F8_SA, h[3] * F8_SA);
                        ss += (h[0] * h[0] + h[1] * h[1]) + (h[2] * h[2] + h[3] * h[3]); }
                ss += __shfl_xor(ss, 16); ss += __shfl_xor(ss, 32);
                if (fq == 0) SSQ[row * 16 + u.pn * 4 + wc] = ss; }
    }
};
struct FQc {
    bf16* O; const float* SSQ;
    __device__ __forceinline__ void operator()(const Unit& u, int r, int c, const f32x4 a0, const f32x4 a1, const f32x4 b0, const f32x4 b1) const {
        const size_t row = (size_t)u.pm * 256 + r; const f32x4* sp = (const f32x4*)(SSQ + row * 16);
        const f32x4 s0 = sp[0], s1 = sp[1], s2 = sp[2], s3 = sp[3];
        const float ss = ((s0[0] + s0[1]) + (s0[2] + s0[3])) + ((s1[0] + s1[1]) + (s1[2] + s1[3])) + ((s2[0] + s2[1]) + (s2[2] + s2[3])) + ((s3[0] + s3[1]) + (s3[2] + s3[3]));
        const float rstd = (1.0f / (F8_SA * F8_SQW)) / sqrtf(ss * (1.f / D) + EPS);
        bf16* p = O + row * LDP + u.pn * 256 + c; st8(p, a0 * rstd, a1 * rstd); st8(p + 128, b0 * rstd, b1 * rstd);
    }
};
struct FBf {
    bf16* O; int ldc;
    __device__ __forceinline__ void operator()(const Unit& u, int r, int c, const f32x4 a0, const f32x4 a1, const f32x4 b0, const f32x4 b1) const {
        bf16* p = O + ((size_t)u.pm * 256 + r) * ldc + u.pn * 256 + c; st8(p, a0, a1); st8(p + 128, b0, b1);
    }
};
struct FM1 {
    unsigned char* HID;
    __device__ __forceinline__ void operator()(const Unit& u, int r, int c, const f32x4 a0, const f32x4 a1, const f32x4 b0, const f32x4 b1) const {
        constexpr float ds = 1.f / (F8_SA * F8_SW); f32x4 x, y;
#pragma unroll
        for (int j = 0; j < 4; ++j) { x[j] = siluf_(a0[j] * ds) * (b0[j] * (ds * F8_SH)); y[j] = siluf_(a1[j] * ds) * (b1[j] * (ds * F8_SH)); }
        u32x2 o; o.x = pk4_fp8(x[0], x[1], x[2], x[3]); o.y = pk4_fp8(y[0], y[1], y[2], y[3]);
        *(u32x2*)(HID + ((size_t)u.pm * 256 + r) * DEXP + u.pn * 128 + c) = o;
    }
};
struct FM2 {
    bf16* YE; const int* s2tk; const float* tokw;
    __device__ __forceinline__ void operator()(const Unit& u, int r, int c, const f32x4 a0, const f32x4 a1, const f32x4 b0, const f32x4 b1) const {
        const int tk = s2tk[u.pm * 256 + r]; if (tk < 0) return;
        const float w = tokw[tk] * (1.f / (F8_SH * F8_SW)); bf16* p = YE + (size_t)tk * D + u.pn * 256 + c; st8(p, a0 * w, a1 * w); st8(p + 128, b0 * w, b1 * w);
    }
};

struct Args { const float* in[32]; float* out; unsigned char* ws; int ph_lo, ph_hi; };
enum { I_X = 0, I_MEM, I_NORM1, I_WIN, I_RCW, I_RCB, I_WA, I_BA, I_WX, I_BX, I_LAM, I_WBA, I_DCW, I_ALOG, I_DTB, I_DNW, I_WBB, I_WOUT, I_NORM2, I_MEMNW, I_WCQ, I_WCKV, I_WCO,
       I_NORM3, I_WRG, I_BRG, I_WRE, I_BRE, I_WEG, I_WEU, I_WED, I_NORMF };

__device__ __forceinline__ void tr_item(const float* W, int ldw, int col0, bf16* WT, int ldt, int row0, int k0, float scale, LAS float* scr, int lane, const float* ksc = nullptr) {
#pragma unroll 8
    for (int i = 0; i < 32; ++i) { const int kk = 2 * i + (lane >> 5); scr[kk * 33 + (lane & 31)] = W[(size_t)(k0 + kk) * ldw + col0 + (lane & 31)] * (ksc ? scale * ksc[k0 + kk] : scale); }
    LDS_WAIT(); asm volatile("" ::: "memory");
    const int c = lane & 7;
#pragma unroll
    for (int j = 0; j < 4; ++j) { const int n = (lane >> 3) + 8 * j; const LAS float* s = scr + (8 * c) * 33 + n;
        u32x4 o; o.x = cvt_pk_bf16(s[0 * 33], s[1 * 33]); o.y = cvt_pk_bf16(s[2 * 33], s[3 * 33]); o.z = cvt_pk_bf16(s[4 * 33], s[5 * 33]); o.w = cvt_pk_bf16(s[6 * 33], s[7 * 33]);
        *(u32x4*)(WT + (size_t)(row0 + n) * ldt + k0 + 8 * c) = o; }
    LDS_WAIT(); asm volatile("" ::: "memory");
}
__device__ __forceinline__ void tr_item8(const float* W, int ldw, int col0, unsigned char* WT, int ldt, int row0, int k0, float scale, LAS float* scr, int lane, const float* ksc = nullptr) {
#pragma unroll 8
    for (int i = 0; i < 32; ++i) { const int kk = 2 * i + (lane >> 5); scr[kk * 33 + (lane & 31)] = W[(size_t)(k0 + kk) * ldw + col0 + (lane & 31)] * (ksc ? scale * ksc[k0 + kk] : scale); }
    LDS_WAIT(); asm volatile("" ::: "memory");
    const int c = lane & 7;
#pragma unroll
    for (int j = 0; j < 4; ++j) { const int n = (lane >> 3) + 8 * j; const LAS float* sp = scr + (8 * c) * 33 + n;
        u32x2 o; o.x = pk4_fp8(sp[0 * 33], sp[1 * 33], sp[2 * 33], sp[3 * 33]); o.y = pk4_fp8(sp[4 * 33], sp[5 * 33], sp[6 * 33], sp[7 * 33]);
        *(u32x2*)(WT + (size_t)(row0 + n) * ldt + k0 + 8 * c) = o; }
    LDS_WAIT(); asm volatile("" ::: "memory");
}
__device__ __forceinline__ void rms_row_to_bf16(const float* xrow, const float* w, bf16* orow, int lane, unsigned char* orow8 = nullptr) {
    const f32x4* xr = (const f32x4*)xrow + lane; const f32x4* wr_ = (const f32x4*)w + lane;
    f32x4 v[4]; float s = 0.f;
#pragma unroll
    for (int j = 0; j < 4; ++j) { v[j] = xr[64 * j]; s += (v[j][0] * v[j][0] + v[j][1] * v[j][1]) + (v[j][2] * v[j][2] + v[j][3] * v[j][3]); }
    const float rstd = 1.0f / sqrtf(wave_sum(s) * (1.f / D) + EPS);
    u32x2* o8 = (u32x2*)orow + lane;
#pragma unroll
    for (int j = 0; j < 4; ++j) { const f32x4 g = wr_[64 * j]; const f32x4 y = v[j] * rstd * g; u32x2 o; o.x = cvt_pk_bf16(y[0], y[1]); o.y = cvt_pk_bf16(y[2], y[3]); o8[64 * j] = o;
        if (orow8) ((unsigned*)orow8)[lane + 64 * j] = pk4_fp8(y[0] * F8_SA, y[1] * F8_SA, y[2] * F8_SA, y[3] * F8_SA); }
}
__device__ __forceinline__ void p0_prologue(const Args& a, LAS unsigned char* lds, int G, int tid, int wave, int lane) {
    unsigned char* ws = a.ws;
    LAS float* scr = (LAS float*)(lds + wave * 16384);
    const int gw = blockIdx.x * 8 + wave, NGW = G * 8;
    constexpr int I0 = 16 * 176, I1 = 512, I4 = 20 * 32, I5 = 512, I8 = 16 * 64, IE = 64 * 256, IRG = 2 * 10 * 8;
    constexpr int NITEMS = I0 + 3 * I1 + I4 + 4 * I5 + I8 + IRG;
    const float* w_in = a.in[I_WIN];
    for (int it = gw; it < NITEMS; it += NGW) {
        int r = it;
        if (r < I0) { tr_item(w_in, DIN, 32 * (r % 176), (bf16*)(ws + WS_B1A), D, 32 * (r % 176), 64 * (r / 176), 1.f, scr, lane); continue; } r -= I0;
        if (r < I1) { tr_item(w_in, DIN, 5632 + 32 * (r % 32), (bf16*)(ws + WS_B1B), D, 32 * (r % 32), 64 * (r / 32), 1.f, scr, lane); continue; } r -= I1;
        if (r < I1) { tr_item8(w_in, DIN, 6672 + 32 * (r % 32), ws + WS_B1B + 2 * MiB, D, 32 * (r % 32), 64 * (r / 32), F8_SW, scr, lane); continue; } r -= I1;
        if (r < I1) { tr_item8(w_in, DIN, 7696 + 32 * (r % 32), ws + WS_B1B + 2 * MiB, D, 1024 + 32 * (r % 32), 64 * (r / 32), F8_SW, scr, lane); continue; } r -= I1;
        if (r < I4) { tr_item(a.in[I_WBA], D, 32 * (r % 32), (bf16*)(ws + WS_WAT), DRNN + D, 32 * (r % 32), 64 * (r / 32), 1.f, scr, lane); continue; } r -= I4;
        if (r < I5) { tr_item(a.in[I_WBB], D, 32 * (r % 32), (bf16*)(ws + WS_WAT) + DRNN, DRNN + D, 32 * (r % 32), 64 * (r / 32), 1.f, scr, lane); continue; } r -= I5;
        if (r < I5) { tr_item(a.in[I_WOUT], D, 32 * (r % 32), (bf16*)(ws + WS_WOT), D, 32 * (r % 32), 64 * (r / 32), 1.f, scr, lane); continue; } r -= I5;
        if (r < I5) { tr_item8(a.in[I_WCQ], D, 32 * (r % 32), ws + WS_WCQT, D, 32 * (r % 32), 64 * (r / 32), 0.0625f * F8_SQW, scr, lane, a.in[I_NORM2]); continue; } r -= I5;
        if (r < I5) { tr_item8(a.in[I_WCO], D, 32 * (r % 32), ws + WS_WCOT, D, 32 * (r % 32), 64 * (r / 32), F8_SW, scr, lane); continue; } r -= I5;
        if (r < I8) { tr_item(a.in[I_WCKV], 2 * D, 32 * (r % 64), (bf16*)(ws + WS_WKVT), D, 32 * (r % 64), 64 * (r / 64), 1.f, scr, lane); continue; } r -= I8;
        { const int mtx = r / 80, q = r % 80, blk = q >> 3, s = q & 7;
            tr_item(a.in[mtx ? I_WX : I_WA] + blk * 16384, 128, 32 * (s & 3), (bf16*)(ws + WS_RGW) + (size_t)mtx * 163840 + blk * 16384, 128, 32 * (s & 3), 64 * (s >> 2), 1.f, scr, lane); }
    }
    const int gt = blockIdx.x * 512 + tid, NGT = G * 512;
    { bf16* B1A = (bf16*)(ws + WS_B1A);
      for (int i = gt; i < 16 * 1024; i += NGT) { const int n = i >> 10, k = i & 1023; B1A[(size_t)(5632 + n) * D + k] = f2bf(w_in[(size_t)k * DIN + 6656 + n]); }
      for (int i = gt; i < 240 * 1024 / 8; i += NGT) *(u32x4*)(B1A + (size_t)5648 * D + (size_t)i * 8) = (u32x4){0u, 0u, 0u, 0u}; }
    { bf16* WH = (bf16*)(ws + WS_WRT); bf16* WL = WH + 80 * 1024;
      for (int i = gt; i < 80 * 1024; i += NGT) { const int n = i >> 10, k = i & 1023; float w = 0.f;
          if (n < 8) w = a.in[I_WRG][k * 8 + n]; else if (n < 72) w = a.in[I_WRE][k * 64 + (n - 8)];
          const bf16 h = f2bf(w); WH[i] = h; WL[i] = f2bf(w - bf2f(h)); } }
    { bf16* U = (bf16*)a.out;
      for (int m = gw; m < NTOK; m += NGW) rms_row_to_bf16(a.in[I_X] + (size_t)m * D, a.in[I_NORM1], U + (size_t)m * D, lane, (unsigned char*)a.out + 128 * MiB + (size_t)m * D);
      bf16* MN = (bf16*)(ws + WS_MEMN);
      for (int m = gw; m < NB * NMEM; m += NGW) rms_row_to_bf16(a.in[I_MEM] + (size_t)m * D, a.in[I_MEMNW], MN + (size_t)m * D, lane); }
}

__device__ __forceinline__ void expert_convert(const Args& a, LAS unsigned char* lds, int gw, int NGW, int wave, int lane) {
    unsigned char* ws = a.ws; LAS float* scr = (LAS float*)(lds + wave * 16384);
    constexpr int IE = 64 * 256;
    for (int it = gw; it < 3 * IE; it += NGW) {
        int r = it;
        if (r < IE) { const int e = r >> 8, q = r & 255, n0 = 32 * (q & 15);
            tr_item8(a.in[I_WEG] + (size_t)e * D * DEXP, DEXP, n0, ws + WS_WGU + (size_t)e * 1024 * 1024, D, (n0 >> 7) * 256 + (n0 & 127), 64 * (q >> 4), F8_SW, scr, lane); continue; } r -= IE;
        if (r < IE) { const int e = r >> 8, q = r & 255, n0 = 32 * (q & 15);
            tr_item8(a.in[I_WEU] + (size_t)e * D * DEXP, DEXP, n0, ws + WS_WGU + (size_t)e * 1024 * 1024, D, (n0 >> 7) * 256 + 128 + (n0 & 127), 64 * (q >> 4), F8_SW, scr, lane); continue; } r -= IE;
        { const int e = r >> 8, q = r & 255;
            tr_item8(a.in[I_WED] + (size_t)e * DEXP * D, D, 32 * (q & 31), ws + WS_WD + (size_t)e * 1024 * 512, DEXP, 32 * (q & 31), 64 * (q >> 5), F8_SW, scr, lane); }
    }
}

constexpr int R_XC = 0, R_A = 33792, R_XCB = 67584, R_RAW = 84992, R_RGB = 102144, R_SEG = 134912, R_HC = 139008;
__device__ __forceinline__ float neg_expm1_small(float x) {
    if (x < -0.25f) return 1.f - __expf(x);
    return -x * (1.f + x * 0.5f * (1.f + x * (1.f / 3.f) * (1.f + x * 0.25f * (1.f + x * 0.2f * (1.f + x * (1.f / 6.f))))));
}
__device__ __forceinline__ void rg_unit(const Args& a, LAS unsigned char* lds, int b, int blk, int tid_in, int wave, int lane_in, bool dry) {
    bf16* P1 = (bf16*)(a.ws + WS_P1);
    const int tid0 = tid_in, lane0 = lane_in;
    const int ch0 = blk * 128;
    LAS float* XC = (LAS float*)(lds + R_XC); LAS float* AA = (LAS float*)(lds + R_A);
    LAS bf16* XCB = (LAS bf16*)(lds + R_XCB); LAS bf16* RAW = (LAS bf16*)(lds + R_RAW); LAS bf16* RGB = (LAS bf16*)(lds + R_RGB);
    LAS float* SEG = (LAS float*)(lds + R_SEG); LAS float* HC = (LAS float*)(lds + R_HC);
    bf16x8 wfa[4], wfx[4];
    { const int lr = lane0 & 15, q4 = lane0 >> 4;
      const bf16* WAT = (const bf16*)(a.ws + WS_RGW) + (size_t)blk * 16384 + (size_t)(16 * wave + lr) * 128; const bf16* WXT = WAT + 163840;
#pragma unroll
      for (int s = 0; s < 4; ++s) { wfa[s] = *(const bf16x8*)(WAT + 32 * s + 8 * q4); wfx[s] = *(const bf16x8*)(WXT + 32 * s + 8 * q4); } }
    const int mych = ch0 + 16 * wave + (lane0 & 15);
    const float ba = a.in[I_BA][mych], bx = a.in[I_BX][mych];
    const float csp = 8.0f * softplusf_(-a.in[I_LAM][mych]);
    f32x4 cw[4], cb;
    { const int cq = tid0 & 31;
#pragma unroll
      for (int tap = 0; tap < 4; ++tap) cw[tap] = *(const f32x4*)(a.in[I_RCW] + tap * DRNN + ch0 + 4 * cq);
      cb = *(const f32x4*)(a.in[I_RCB] + ch0 + 4 * cq); }
    { const size_t row0 = (size_t)b * SEQ;
#pragma unroll
      for (int it = 0; it < 2; ++it) { const int idx = it * 512 + tid0, r = idx >> 4, pc = idx & 15;
          *(LAS u32x4*)(RAW + (3 + r) * 128 + pc * 8) = *(const u32x4*)(P1 + (row0 + r) * LDP + RXOFF + ch0 + pc * 8);
          *(LAS u32x4*)(RGB + r * 128 + pc * 8) = *(const u32x4*)(P1 + (row0 + r) * LDP + RGOFF + ch0 + pc * 8); }
      if (tid0 < 48) *(LAS u32x4*)(RAW + tid0 * 8) = (u32x4){0u, 0u, 0u, 0u};
      if (tid0 < 128) HC[tid0] = 0.f; }
    LBAR();
#pragma unroll 1
    for (int c = 0; c < SEQ / 64; ++c) {
        int tid = tid0; asm volatile("" : "+v"(tid));
        const int lane = tid & 63, lr = lane & 15, q4 = lane >> 4;
        const size_t row0 = (size_t)b * SEQ + (size_t)c * 64;
        const int par = c & 1;
        u32x4 pre[4];
        { const bool more = (c + 1 < SEQ / 64);
#pragma unroll
          for (int it = 0; it < 2; ++it) { const int idx = it * 512 + tid, r = idx >> 4, pc = idx & 15; const size_t rr = more ? row0 + 64 + r : row0 + r;
              pre[2 * it] = *(const u32x4*)(P1 + rr * LDP + RXOFF + ch0 + pc * 8); pre[2 * it + 1] = *(const u32x4*)(P1 + rr * LDP + RGOFF + ch0 + pc * 8); } }
        { const int cq = tid & 31, rgp = tid >> 5;
          f32x4 xr[7];
#pragma unroll
          for (int i = 0; i < 7; ++i) { const u32x2 w = *(const LAS u32x2*)(RAW + (4 * rgp + i) * 128 + 4 * cq); xr[i] = (f32x4){bflo(w.x), bfhi(w.x), bflo(w.y), bfhi(w.y)}; }
#pragma unroll
          for (int r = 0; r < 4; ++r) { f32x4 o = cb;
#pragma unroll
              for (int tap = 0; tap < 4; ++tap) o += cw[tap] * xr[r + tap];
              *(LAS f32x4*)(XC + (4 * rgp + r) * 132 + 4 * cq) = o;
              u32x2 pk; pk.x = cvt_pk_bf16(o[0], o[1]); pk.y = cvt_pk_bf16(o[2], o[3]); *(LAS u32x2*)(XCB + (4 * rgp + r) * 136 + 4 * cq) = pk; } }
        LBAR();
        if (tid < 48) *(LAS u32x4*)(RAW + tid * 8) = *(const LAS u32x4*)(RAW + 64 * 128 + tid * 8);
#pragma unroll
        for (int it = 0; it < 4; ++it) {
            f32x4 dr = {0.f, 0.f, 0.f, 0.f}, di = {0.f, 0.f, 0.f, 0.f};
#pragma unroll
            for (int s = 0; s < 4; ++s) { const bf16x8 xf = *(const LAS bf16x8*)(XCB + (16 * it + lr) * 136 + 32 * s + 8 * q4); dr = MFMA(xf, wfa[s], dr); di = MFMA(xf, wfx[s], di); }
#pragma unroll
            for (int j = 0; j < 4; ++j) { const int tok = 16 * it + 4 * q4 + j; const int o = tok * 132 + 16 * wave + lr;
                const float rr = sigmoidf_(dr[j] + ba), ii = sigmoidf_(di[j] + bx); const float la = -csp * rr; const float av = __expf(la);
                const float mult = __builtin_amdgcn_sqrtf(fmaxf(1.0f - av * av, 0.f)); const float xv = XC[o];
                AA[o] = av; XC[o] = mult * ii * xv; }
        }
        LBAR();
        const int sch = tid & 127, seg = tid >> 7;
        float hl[16], pa[16];
        { float h = 0.f, p = 1.f;
#pragma unroll
          for (int t = 0; t < 16; ++t) { const float av = AA[(16 * seg + t) * 132 + sch], bv = XC[(16 * seg + t) * 132 + sch]; h = av * h + bv; p *= av; hl[t] = h; pa[t] = p; }
          SEG[(seg * 128 + sch) * 2] = p; SEG[(seg * 128 + sch) * 2 + 1] = h; }
        LBAR();
        { float cin = HC[par * 128 + sch];
          for (int s = 0; s < seg; ++s) cin = SEG[(s * 128 + sch) * 2] * cin + SEG[(s * 128 + sch) * 2 + 1];
          bf16* op = P1 + (row0 + 16 * seg) * LDP + RXOFF + ch0 + sch; const LAS bf16* rgp_ = RGB + par * 8192 + (16 * seg) * 128 + sch;
          float hlast = 0.f;
#pragma unroll
          for (int t = 0; t < 16; ++t) { const float h = hl[t] + pa[t] * cin; hlast = h; const float g = bf2f(rgp_[t * 128]);
              if (!dry) op[(size_t)t * LDP] = f2bf(gelu_tanh(g) * h); }
          if (seg == 3) HC[(par ^ 1) * 128 + sch] = hlast; }
#pragma unroll
        for (int it = 0; it < 2; ++it) { const int idx = it * 512 + tid, r = idx >> 4, pc = idx & 15;
            *(LAS u32x4*)(RAW + (3 + r) * 128 + pc * 8) = pre[2 * it]; *(LAS u32x4*)(RGB + (par ^ 1) * 8192 + r * 128 + pc * 8) = pre[2 * it + 1]; }
        LBAR();
    }
}

#if DBG_STAGE == 3
#define CHK(stage, val) do { const float _v = (val); if (dbg_on && !(fabsf(_v) < 1e30f) && *DBGF == 0) *DBGF = (stage) + 16 * (c < 2 ? c : 2); } while (0)
#else
#define CHK(stage, val) do { } while (0)
#endif
constexpr int G_KN = 0, G_QS = 17408, G_VS = 34816, G_LM = 52224, G_TB = 71680, G_TBG = 80896, G_PM = 90112, G_VEC = 99328, G_GT = 103424, G_RAW = 107520;
__device__ __forceinline__ bf16x8 frag_nat(const LAS bf16* base, int stride, int row, int k) { return *(const LAS bf16x8*)(base + row * stride + k); }
__device__ __forceinline__ bf16x8 frag_perm(const LAS bf16* base, int stride, int row, int k0, int q4) {
    const bf16x4 x = *(const volatile LAS bf16x4*)(base + row * stride + k0 + 4 * q4); const bf16x4 y = *(const volatile LAS bf16x4*)(base + row * stride + k0 + 16 + 4 * q4);
    return (bf16x8){x[0], x[1], x[2], x[3], y[0], y[1], y[2], y[3]};
}
__device__ __forceinline__ bf16x4 tr4(const LAS bf16* p) { return __builtin_amdgcn_ds_read_tr16_b64_v4i16((LAS bf16x4*)p); }
__device__ __forceinline__ bf16x8 trfrag_nat(const LAS bf16* base, int stride, int j0, int ch0, int lr, int q4) {
    const LAS bf16* p = base + (j0 + 8 * q4 + (lr >> 2)) * stride + ch0 + 4 * (lr & 3); const bf16x4 x = tr4(p), y = tr4(p + 4 * stride);
    return (bf16x8){x[0], x[1], x[2], x[3], y[0], y[1], y[2], y[3]};
}
__device__ __forceinline__ bf16x8 trfrag_perm(const LAS bf16* base, int stride, int j0, int ch0, int lr, int q4) {
    const LAS bf16* p = base + (j0 + 4 * q4 + (lr >> 2)) * stride + ch0 + 4 * (lr & 3); const bf16x4 x = tr4(p), y = tr4(p + 16 * stride);
    return (bf16x8){x[0], x[1], x[2], x[3], y[0], y[1], y[2], y[3]};
}
__device__ __forceinline__ void gdn_unit(const Args& a, LAS unsigned char* lds, int b, int h, int tid_in, int wave, int lane_in, bool dry) {
    bf16* P1 = (bf16*)(a.ws + WS_P1);
    const float* gbuf = (const float*)(a.ws + WS_G); const float* betabuf = (const float*)(a.ws + WS_BETA);
    const int tid = tid_in;
    LAS bf16* KN = (LAS bf16*)(lds + G_KN); LAS bf16* TL = (LAS bf16*)(lds + G_LM); LAS float* LD = (LAS float*)(lds + G_LM + 9216); LAS bf16* WW = (LAS bf16*)(lds + G_LM);   LAS float* OST = (LAS float*)(lds + G_KN);
    LAS bf16* QS = (LAS bf16*)(lds + G_QS); LAS bf16* VS = (LAS bf16*)(lds + G_VS);
    LAS bf16* TB = (LAS bf16*)(lds + G_TB); LAS bf16* TBG = (LAS bf16*)(lds + G_TBG); LAS bf16* PM = (LAS bf16*)(lds + G_PM);
    LAS float* VEC = (LAS float*)(lds + G_VEC); LAS float* RK = VEC + 512; LAS float* RQ = VEC + 576; LAS float* DNW = VEC + 640;
    if (tid < 128) DNW[tid] = a.in[I_DNW][tid];
    LAS float* GT = (LAS float*)(lds + G_GT); LAS bf16* RAW = (LAS bf16*)(lds + G_RAW);
    for (int i = tid; i < 3 * 48; i += 512) *(LAS u32x4*)(RAW + i * 8) = (u32x4){0u, 0u, 0u, 0u};
#if DBG_STAGE == 3
    volatile LAS int* DBGF = (volatile LAS int*)(lds + 162100); const bool dbg_on = true; if (tid == 0) *DBGF = 0;
#endif
    f32x4 S[8];
#pragma unroll
    for (int t = 0; t < 8; ++t) S[t] = (f32x4){0.f, 0.f, 0.f, 0.f};
    f32x4 cw[3][4];
#pragma unroll
    for (int part = 0; part < 3; ++part)
#pragma unroll
        for (int tap = 0; tap < 4; ++tap) cw[part][tap] = *(const f32x4*)(a.in[I_DCW] + tap * 3072 + part * 1024 + h * 128 + 4 * (tid & 31)) * 1.4426950408889634f;
    const float neg_a = -__expf(a.in[I_ALOG][h]), dtb = a.in[I_DTB][h];
    { const size_t row0 = (size_t)b * SEQ;
#pragma unroll
      for (int it = 0; it < 6; ++it) { const int idx = it * 512 + tid, r = idx / 48, pc = idx % 48, part = pc >> 4, piece = pc & 15;
          *(LAS u32x4*)(RAW + (3 + r) * 384 + part * 128 + piece * 8) = *(const u32x4*)(P1 + (row0 + r) * LDP + QOFF + part * 1024 + h * 128 + piece * 8); }
      if (wave == 0) { const int lane = lane_in; float v = neg_a * softplusf_(gbuf[(row0 + lane) * 8 + h] + dtb);
#pragma unroll
          for (int o = 1; o < 64; o <<= 1) { const float t = __shfl_up(v, o); if (lane >= o) v += t; }
          const float gl = __shfl(v, 63);
          VEC[lane] = v; VEC[64 + lane] = sigmoidf_(betabuf[(row0 + lane) * 8 + h]); VEC[128 + lane] = __expf(v); VEC[192 + lane] = __expf(gl - v); }
      LBAR(); }
#pragma unroll 1
    for (int c = 0; c < SEQ / 64; ++c) {
        int tid = tid_in; asm volatile("" : "+v"(tid));
        const int lane = tid & 63, lr = lane & 15, q4 = lane >> 4;
        const int pr = tid >> 3, pp = tid & 7;
        const size_t row0 = (size_t)b * SEQ + (size_t)c * 64;
        LAS float* GC = VEC + 256 * (c & 1); LAS float* BETA = GC + 64; LAS float* EG = GC + 128; LAS float* EGL = GC + 192;
        float pre_g = 0.f, pre_b = 0.f;
        if (wave == 1) { const size_t rown = (c + 1 < SEQ / 64) ? row0 + 64 : row0; pre_g = gbuf[(rown + lane) * 8 + h]; pre_b = betabuf[(rown + lane) * 8 + h]; }
        { const int cq = tid & 31, rg = tid >> 5;
#pragma unroll
          for (int part = 0; part < 3; ++part) {
              f32x4 x[7];
#pragma unroll
              for (int t = 0; t < 7; ++t) { const u32x2 w = *(const LAS u32x2*)(RAW + (4 * rg + t) * 384 + part * 128 + 4 * cq); x[t] = (f32x4){bflo(w.x), bfhi(w.x), bflo(w.y), bfhi(w.y)}; }
              LAS bf16* dst = (part == 0 ? QS : part == 1 ? KN : VS) + (4 * rg) * 136 + 4 * cq;
#pragma unroll
              for (int r = 0; r < 4; ++r) { f32x4 acc = cw[part][0] * x[r];
#pragma unroll
                  for (int tap = 1; tap < 4; ++tap) acc += cw[part][tap] * x[r + tap];
#pragma unroll
                  for (int e = 0; e < 4; ++e) { CHK(2, acc[e]); acc[e] = acc[e] * __builtin_amdgcn_rcpf(1.0f + __builtin_amdgcn_exp2f(-acc[e])); }
                  *(LAS u32x2*)(dst + r * 136) = (u32x2){cvt_pk_bf16(acc[0], acc[1]), cvt_pk_bf16(acc[2], acc[3])}; } } }
        LBAR();
        for (int i = tid; i < 3 * 48; i += 512) *(LAS u32x4*)(RAW + i * 8) = *(const LAS u32x4*)(RAW + 64 * 384 + i * 8);
        f32x4 dkq[4];
#pragma unroll
        for (int i = 0; i < 4; ++i) { const int tt = wave * 4 + i, which = tt >> 4, it = (tt & 15) >> 2, jt = tt & 3;
            f32x4 d = {0.f, 0.f, 0.f, 0.f};
            if (it >= jt) {
                const LAS bf16* Am = which ? QS : KN;
#pragma unroll
                for (int s = 0; s < 4; ++s) d = MFMA(frag_nat(Am, 136, 16 * it + lr, 32 * s + 8 * q4), frag_nat(KN, 136, 16 * jt + lr, 32 * s + 8 * q4), d);
            }
            dkq[i] = d; CHK(4, d[0] + d[1] + d[2] + d[3]); }
        {
          const int it = wave & 3; f32x4 d;
          if (wave < 4) d = (it == 0) ? dkq[0] : (it == 1) ? dkq[1] : (it == 2) ? dkq[2] : dkq[3];
          else { d = (f32x4){0.f, 0.f, 0.f, 0.f};
#pragma unroll
              for (int s = 0; s < 4; ++s) { const bf16x8 f = frag_nat(QS, 136, 16 * it + lr, 32 * s + 8 * q4); d = MFMA(f, f, d); } }
          const int j = lr & 3; const float v = (j == 0) ? d[0] : (j == 1) ? d[1] : (j == 2) ? d[2] : d[3];
          if (q4 == (lr >> 2)) { const float r = __builtin_amdgcn_rsqf(v + EPS * 2.0813689810056077f); if (wave < 4) RK[16 * it + lr] = r; else RQ[16 * it + lr] = r * 0.08838834764831845f; } }
        LBAR();
        if (wave < 4) {
#pragma unroll
            for (int i = 0; i < 4; ++i) { const int it = wave, jt = i; const int jc = 16 * jt + lr; const float gj = GC[jc];
                const f32x4 gi = *(const LAS f32x4*)(GC + 16 * it + 4 * q4), bi = *(const LAS f32x4*)(BETA + 16 * it + 4 * q4) * *(const LAS f32x4*)(RK + 16 * it + 4 * q4) * RK[jc]; f32x4 lv;
#pragma unroll
                for (int j = 0; j < 4; ++j) { const int ii = 16 * it + 4 * q4 + j; lv[j] = (ii > jc) ? bi[j] * dkq[i][j] * __expf(fminf(gi[j] - gj, 0.f)) : 0.f; }
                if (i == wave) {
#pragma unroll
                    for (int j = 0; j < 4; ++j) LD[wave * 320 + (4 * q4 + j) * 20 + lr] = lv[j]; }
                else {
#pragma unroll
                    for (int j = 0; j < 4; ++j) TL[(16 * it + 4 * q4 + j) * 72 + jc] = f2bf(lv[j]); } } }
        LBAR();
        if (wave >= 4) {
#pragma unroll
            for (int i = 0; i < 4; ++i) { const int tt = wave * 4 + i, it = (tt & 15) >> 2, jt = tt & 3; const int jc = 16 * jt + lr; const float gj = GC[jc];
                const f32x4 rq = *(const LAS f32x4*)(RQ + 16 * it + 4 * q4) * RK[jc];
#pragma unroll
                for (int j = 0; j < 4; ++j) { const int ii = 16 * it + 4 * q4 + j; const float dec = __expf(fminf(GC[ii] - gj, 0.f));
                    PM[ii * 72 + jc] = f2bf((ii >= jc) ? dkq[i][j] * dec * rq[j] : 0.f); } } }
        u32x4 pre[6];
        { const size_t rown = (c + 1 < SEQ / 64) ? row0 + 64 : row0;
#pragma unroll
          for (int it = 0; it < 6; ++it) { const int r = tid >> 3, pc = (tid & 7) + 8 * it, part = pc >> 4, piece = pc & 15;
              pre[it] = *(const u32x4*)(P1 + (rown + r) * LDP + QOFF + part * 1024 + h * 128 + piece * 8); }
 }
        f32x4 O[4];
#define QS_BLOCK() do { bf16x8 sfq[4]; \
            _Pragma("unroll") for (int s = 0; s < 4; ++s) sfq[s] = pack8v(S[2 * s], S[2 * s + 1]); \
            _Pragma("unroll") for (int it = 0; it < 4; ++it) { f32x4 qs_ = {0.f, 0.f, 0.f, 0.f}; \
                _Pragma("unroll") for (int s = 0; s < 4; ++s) qs_ = MFMA(frag_perm(QS, 136, 16 * it + lr, 32 * s, q4), sfq[s], qs_); \
                const f32x4 sc = *(const LAS f32x4*)(EG + 16 * it + 4 * q4) * *(const LAS f32x4*)(RQ + 16 * it + 4 * q4); O[it] = qs_ * sc; } } while (0)
        if (wave == 1) { LAS float* GN = VEC + 256 * ((c + 1) & 1); float v = neg_a * softplusf_(pre_g + dtb);
#pragma unroll
            for (int o = 1; o < 64; o <<= 1) { const float t = __shfl_up(v, o); if (lane >= o) v += t; }
            const float gl = __shfl(v, 63);
            GN[lane] = v; GN[64 + lane] = sigmoidf_(pre_b); GN[128 + lane] = __expf(v); GN[192 + lane] = __expf(gl - v); }
        if (wave >= 1) QS_BLOCK();
        if (tid < 64) { const int d = tid >> 4, cc = tid & 15; float t[16];
#pragma unroll
            for (int i = 0; i < 16; ++i) { float s = 0.f;
#pragma unroll
                for (int q = 0; q < 4; ++q) if (4 * q < i) { const f32x4 l = *(const LAS f32x4*)(LD + d * 320 + i * 20 + 4 * q);
#pragma unroll
                    for (int e = 0; e < 4; ++e) if (4 * q + e < i) s += l[e] * t[4 * q + e]; }
                t[i] = (i > cc) ? -s : (i == cc ? 1.f : 0.f); }
#pragma unroll
            for (int i = 0; i < 16; ++i) TL[(16 * d + i) * 72 + 16 * d + cc] = f2bf(t[i]); }
        LBAR();
        if (wave == 0) QS_BLOCK();
        if (wave == 2 || wave == 3) { const int lo = 32 * (wave - 2), hi = lo + 16; const f32x4 z4 = {0.f, 0.f, 0.f, 0.f};
            bf16x8 a1 = frag_nat(TL, 72, hi + lr, lo + 8 * q4); if (q4 >= 2) a1 = (bf16x8){0, 0, 0, 0, 0, 0, 0, 0};
            const f32x4 x = MFMA(a1, trfrag_nat(TL, 72, lo, lo, lr, q4), z4);
            const bf16x4 a2l = *(const LAS bf16x4*)(TL + (hi + lr) * 72 + hi + 4 * q4);
            const bf16x8 a2 = {a2l[0], a2l[1], a2l[2], a2l[3], 0, 0, 0, 0};
            const u32x4 bw = {cvt_pk_bf16(x[0], x[1]), cvt_pk_bf16(x[2], x[3]), 0u, 0u};
            const f32x4 r = MFMA(a2, __builtin_bit_cast(bf16x8, bw), z4);
#pragma unroll
            for (int j = 0; j < 4; ++j) TL[(hi + 4 * q4 + j) * 72 + lo + lr] = f2bf(-r[j]); }
        LBAR();
#pragma unroll
        for (int it = 0; it < 6; ++it) { const int r = tid >> 3, pc = (tid & 7) + 8 * it, part = pc >> 4, piece = pc & 15;
            *(LAS u32x4*)(RAW + (3 + r) * 384 + part * 128 + piece * 8) = pre[it]; }
        if (wave >= 4) { const int I = (wave - 4) >> 1, J = (wave - 4) & 1; const f32x4 z4 = {0.f, 0.f, 0.f, 0.f};
            const bf16x8 bt = trfrag_nat(TL, 72, 0, 16 * J, lr, q4);
            const f32x4 y0 = MFMA(frag_nat(TL, 72, 32 + lr, 8 * q4), bt, z4), y1 = MFMA(frag_nat(TL, 72, 48 + lr, 8 * q4), bt, z4);
            const f32x4 r = MFMA(frag_perm(TL, 72, 32 + 16 * I + lr, 32, q4), pack8v(y0, y1), z4);
            const int col = 16 * J + lr; const float bc = BETA[col], ec = bc * (EG[col] * RK[col]);
#pragma unroll
            for (int j = 0; j < 4; ++j) { const int row = 32 + 16 * I + 4 * q4 + j; TB[row * 72 + col] = f2bf(-r[j] * bc); TBG[row * 72 + col] = f2bf(-r[j] * ec); } }
        else {
#pragma unroll
            for (int n = 0; n < 2; ++n) { const int task = tid + 256 * n, i = task >> 3, j0 = (task & 7) * 8;
                if (n == 0 || j0 >= 32) { float t[8]; unpack8(*(const LAS u32x4*)(TL + i * 72 + j0), t);
                    f32x4 b0, b1, e0, e1;
#pragma unroll
                    for (int j = 0; j < 4; ++j) { b0[j] = t[j] * BETA[j0 + j]; b1[j] = t[4 + j] * BETA[j0 + 4 + j]; e0[j] = b0[j] * (EG[j0 + j] * RK[j0 + j]); e1[j] = b1[j] * (EG[j0 + 4 + j] * RK[j0 + 4 + j]); }
                    *(LAS u32x4*)(TB + i * 72 + j0) = pack8(b0, b1); *(LAS u32x4*)(TBG + i * 72 + j0) = pack8(e0, e1); } } }
        LBAR();
        f32x4 U[4];
        bf16x8 kf[2], vtf[2];
#pragma unroll
        for (int s = 0; s < 2; ++s) { kf[s] = trfrag_nat(KN, 136, 32 * s, 16 * wave, lr, q4); vtf[s] = trfrag_nat(VS, 136, 32 * s, 16 * wave, lr, q4); }
#pragma unroll
        for (int it = 0; it < 4; ++it) { f32x4 d = {0.f, 0.f, 0.f, 0.f}, uu = {0.f, 0.f, 0.f, 0.f};
#pragma unroll
            for (int s = 0; s < 2; ++s) { d = MFMA(frag_nat(TBG, 72, 16 * it + lr, 32 * s + 8 * q4), kf[s], d);
                uu = MFMA(frag_nat(TB, 72, 16 * it + lr, 32 * s + 8 * q4), vtf[s], uu); }
            U[it] = uu; CHK(6, d[0] + d[1] + d[2] + d[3]); CHK(7, uu[0] + uu[1] + uu[2] + uu[3]);
#pragma unroll
            for (int j = 0; j < 4; ++j) WW[(16 * it + 4 * q4 + j) * 136 + 16 * wave + lr] = f2bf(d[j]); }
        LBAR();
        const u32x4 zs0 = *(const u32x4*)(h2row(a.ws, row0 + pr) + h * 128 + 16 * pp), zs1 = *(const u32x4*)(h2row(a.ws, row0 + pr) + h * 128 + 16 * pp + 8);
        bf16x8 sf[4];
#pragma unroll
        for (int s = 0; s < 4; ++s) sf[s] = pack8v(S[2 * s], S[2 * s + 1]);
        f32x4 Vn[4];
#pragma unroll
        for (int it = 0; it < 4; ++it) { f32x4 ws_ = {0.f, 0.f, 0.f, 0.f};
#pragma unroll
            for (int s = 0; s < 4; ++s) ws_ = MFMA(frag_perm(WW, 136, 16 * it + lr, 32 * s, q4), sf[s], ws_);
            Vn[it] = U[it] - ws_; CHK(8, ws_[0] + ws_[1] + ws_[2] + ws_[3]); }
        bf16x8 vf[2], vfs[2];
#pragma unroll
        for (int s = 0; s < 2; ++s) { vf[s] = pack8v(Vn[2 * s], Vn[2 * s + 1]); f32x4 x, y;
#pragma unroll
            for (int j = 0; j < 4; ++j) { x[j] = Vn[2 * s][j] * (EGL[32 * s + 4 * q4 + j] * RK[32 * s + 4 * q4 + j]); y[j] = Vn[2 * s + 1][j] * (EGL[32 * s + 16 + 4 * q4 + j] * RK[32 * s + 16 + 4 * q4 + j]); }
            vfs[s] = pack8v(x, y); }
#pragma unroll
        for (int it = 0; it < 4; ++it)
#pragma unroll
            for (int s = 0; s < 2; ++s) O[it] = MFMA(frag_perm(PM, 72, 16 * it + lr, 32 * s, q4), vf[s], O[it]);
#pragma unroll
        for (int it = 0; it < 4; ++it) CHK(10, O[it][0] + O[it][1] + O[it][2] + O[it][3]);
        { const float gl = EG[63];
#pragma unroll
          for (int t = 0; t < 8; ++t) { f32x4 d = S[t] * gl;
#pragma unroll
              for (int s = 0; s < 2; ++s) d = MFMA(trfrag_perm(KN, 136, 32 * s, 16 * t, lr, q4), vfs[s], d);
              S[t] = d; CHK(11, d[0] + d[1] + d[2] + d[3]); } }
        LBAR();
#pragma unroll
        for (int it = 0; it < 4; ++it)
#pragma unroll
            for (int j = 0; j < 4; ++j) OST[(16 * it + 4 * q4 + j) * 132 + 16 * wave + lr] = O[it][j];
        LBAR();
        { float o[16]; float ss = 0.f;
#pragma unroll
          for (int j = 0; j < 4; ++j) { const f32x4 t = *(const LAS f32x4*)(OST + pr * 132 + 16 * pp + 4 * j); o[4 * j] = t[0]; o[4 * j + 1] = t[1]; o[4 * j + 2] = t[2]; o[4 * j + 3] = t[3]; ss += (t[0] * t[0] + t[1] * t[1]) + (t[2] * t[2] + t[3] * t[3]); }
          ss += __shfl_xor(ss, 1); ss += __shfl_xor(ss, 2); ss += __shfl_xor(ss, 4);
          const float rstd = __builtin_amdgcn_rsqf(ss * (1.f / HD) + EPS * 2.0813689810056077f); CHK(12, ss); CHK(13, rstd);
          const LAS f32x4* wp = (const LAS f32x4*)(DNW + 16 * pp);
#pragma unroll
          for (int j = 0; j < 4; ++j) { const f32x4 t = wp[j]; o[4 * j] *= rstd * t[0]; o[4 * j + 1] *= rstd * t[1]; o[4 * j + 2] *= rstd * t[2]; o[4 * j + 3] *= rstd * t[3]; }
          { float z[16]; unpack8(zs0, z); unpack8(zs1, z + 8);
#pragma unroll
            for (int j = 0; j < 16; ++j) o[j] *= z[j]; }
          bf16* dst = P1 + (row0 + pr) * LDP + VOFF + h * 128 + 16 * pp;
          if (!dry) { *(u32x4*)dst = pack8((f32x4){o[0], o[1], o[2], o[3]}, (f32x4){o[4], o[5], o[6], o[7]});
          *(u32x4*)(dst + 8) = pack8((f32x4){o[8], o[9], o[10], o[11]}, (f32x4){o[12], o[13], o[14], o[15]}); } }
        LBAR();
    }
#if DBG_STAGE == 3

#endif
}

__device__ __forceinline__ void attn_unit(const Args& a, LAS unsigned char* lds, int b, int hh, int rb, int tid, int wave, int lane) {
    const bf16* QC = (const bf16*)(a.ws + WS_P1) + RGOFF; const bf16* Kc = (const bf16*)(a.ws + WS_KV); const bf16* VTg = (const bf16*)(a.ws + WS_VT); unsigned char* AO8 = a.ws + WS_P1 + 2 * KOFF;
    LAS bf16* KS = (LAS bf16*)lds;
    const int lr = lane & 15, q4 = lane >> 4;
    const size_t qrow0 = (size_t)b * SEQ + (size_t)rb * 256 + 32 * wave + lr;
#pragma unroll
    for (int it = 0; it < 16; ++it) { const int idx = it * 512 + tid, key = idx >> 5, pc = idx & 31;
        *(LAS u32x4*)(KS + key * 264 + pc * 8) = *(const u32x4*)(Kc + ((size_t)b * 256 + key) * 2048 + hh * 256 + pc * 8); }
    bf16x8 qf[2][8];
#pragma unroll
    for (int t = 0; t < 2; ++t)
#pragma unroll
        for (int s = 0; s < 8; ++s) qf[t][s] = *(const bf16x8*)(QC + (qrow0 + 16 * t) * LDP + hh * 256 + 64 * (s >> 1) + 16 * q4 + 8 * (s & 1));
    __syncthreads();
    bf16x8 pf[2][8]; float sum0 = 0.f, sum1 = 0.f;
#pragma unroll
    for (int s2 = 0; s2 < 8; ++s2) { f32x4 e[2][2];
#pragma unroll
        for (int hk = 0; hk < 2; ++hk) { const int kt = 2 * s2 + hk; f32x4 d0 = {0.f, 0.f, 0.f, 0.f}, d1 = {0.f, 0.f, 0.f, 0.f};
#pragma unroll
            for (int s = 0; s < 8; ++s) { const bf16x8 kf = frag_nat(KS, 264, 16 * kt + lr, 64 * (s >> 1) + 16 * q4 + 8 * (s & 1)); d0 = MFMA(kf, qf[0][s], d0); d1 = MFMA(kf, qf[1][s], d1); }
#pragma unroll
            for (int j = 0; j < 4; ++j) { const float e0 = __builtin_amdgcn_exp2f(__builtin_amdgcn_fmed3f(d0[j] * 1.4426950408889634f, -126.f, 115.f)), e1 = __builtin_amdgcn_exp2f(__builtin_amdgcn_fmed3f(d1[j] * 1.4426950408889634f, -126.f, 115.f)); e[0][hk][j] = e0; e[1][hk][j] = e1; sum0 += e0; sum1 += e1; } }
        pf[0][s2] = pack8v(e[0][0], e[0][1]); pf[1][s2] = pack8v(e[1][0], e[1][1]);
        __builtin_amdgcn_sched_barrier(0); }
    sum0 += __shfl_xor(sum0, 16); sum0 += __shfl_xor(sum0, 32); sum1 += __shfl_xor(sum1, 16); sum1 += __shfl_xor(sum1, 32);
    const float inv0 = __builtin_amdgcn_rcpf(sum0), inv1 = __builtin_amdgcn_rcpf(sum1);
    __syncthreads();
#pragma unroll
    for (int it = 0; it < 16; ++it) { const int idx = it * 512 + tid, dv = idx >> 5, pc = idx & 31;
        *(LAS u32x4*)(KS + dv * 264 + pc * 8) = *(const u32x4*)(VTg + ((size_t)(b * 4 + hh) * 256 + dv) * 256 + pc * 8); }
    __syncthreads();
#pragma unroll 4
    for (int dt = 0; dt < 16; ++dt) { f32x4 d0 = {0.f, 0.f, 0.f, 0.f}, d1 = {0.f, 0.f, 0.f, 0.f};
#pragma unroll
        for (int s = 0; s < 8; ++s) { const bf16x8 vf = frag_perm(KS, 264, 16 * dt + lr, 32 * s, q4); d0 = MFMA(vf, pf[0][s], d0); d1 = MFMA(vf, pf[1][s], d1); }
        d0 *= inv0; d1 *= inv1;
        d0 *= F8_SAO; d1 *= F8_SAO;
        *(unsigned*)(AO8 + qrow0 * LDP8 + hh * 256 + 16 * dt + 4 * q4) = pk4_fp8(d0[0], d0[1], d0[2], d0[3]);
        *(unsigned*)(AO8 + (qrow0 + 16) * LDP8 + hh * 256 + 16 * dt + 4 * q4) = pk4_fp8(d1[0], d1[1], d1[2], d1[3]);
        __builtin_amdgcn_sched_barrier(0); }
    __syncthreads();
}

constexpr int RT_LG = 0, RT_CNT = 49152, RT_WH = 53248, RT_WL = 95488;
__device__ __forceinline__ void router_iter(const Args& a, LAS unsigned char* lds, int row0, bool live, int tid, int wave, int lane, unsigned* cnt) {
    const float* w3 = a.in[I_NORM3];
    const bf16* WH = (const bf16*)(a.ws + WS_WRT); const bf16* WL = WH + 80 * 1024;
    float* rstd3 = (float*)(a.ws + WS_RSTD3); int* toke = (int*)(a.ws + WS_TOKE); float* tokw = (float*)(a.ws + WS_TOKW); int* tokp = (int*)(a.ws + WS_TOKP);
    LAS float* LG = (LAS float*)(lds + RT_LG + wave * 6144); LAS int* LCNT = (LAS int*)(lds + RT_CNT); LAS int* LBASE = LCNT + 64;
    LAS bf16* WHs = (LAS bf16*)(lds + RT_WH); LAS bf16* WLs = (LAS bf16*)(lds + RT_WL);
    const int lr = lane & 15, q4 = lane >> 4;
    const bf16* hp = h2row(a.ws, (size_t)((live ? row0 : 0) + lr)) + 8 * q4;
    if (tid < 64) LCNT[tid] = 0;
    float ss = 0.f;
#pragma unroll 8
    for (int kb = 0; kb < 32; ++kb) { float xf[8]; unpack8(*(const u32x4*)(hp + 32 * kb), xf); const f32x4 x0 = {xf[0], xf[1], xf[2], xf[3]}, x1 = {xf[4], xf[5], xf[6], xf[7]};
        ss += (x0[0] * x0[0] + x0[1] * x0[1]) + (x0[2] * x0[2] + x0[3] * x0[3]) + (x1[0] * x1[0] + x1[1] * x1[1]) + (x1[2] * x1[2] + x1[3] * x1[3]); }
    ss += __shfl_xor(ss, 16); ss += __shfl_xor(ss, 32);
    const float rstd = 1.0f / sqrtf(ss * (1.f / D) + EPS);
    if (live && q4 == 0) rstd3[row0 + lr] = rstd;
    f32x4 acc[5];
#pragma unroll
    for (int ct = 0; ct < 5; ++ct) acc[ct] = (f32x4){0.f, 0.f, 0.f, 0.f};
#pragma unroll 1
    for (int kq = 0; kq < 4; ++kq) {
        __syncthreads();
#pragma unroll
        for (int i = 0; i < 10; ++i) { const int idx = i * 512 + tid, arr = idx / 2560, rem = idx % 2560, row = rem >> 5, pc = rem & 31;
            *(LAS u32x4*)((arr ? WLs : WHs) + row * 264 + pc * 8) = *(const u32x4*)((arr ? WL : WH) + row * 1024 + kq * 256 + pc * 8); }
        __syncthreads();
#pragma unroll 2
        for (int kb2 = 0; kb2 < 8; ++kb2) { const int kb = kq * 8 + kb2;
            float xf[8]; unpack8(*(const u32x4*)(hp + 32 * kb), xf); const f32x4 x0 = {xf[0], xf[1], xf[2], xf[3]}, x1 = {xf[4], xf[5], xf[6], xf[7]};
            const f32x4 g0 = *(const f32x4*)(w3 + 32 * kb + 8 * q4), g1 = *(const f32x4*)(w3 + 32 * kb + 8 * q4 + 4);
            const f32x4 u0 = x0 * rstd * g0, u1 = x1 * rstd * g1;
            const u32x4 hi = pack8(u0, u1); float hf[8]; unpack8(hi, hf);
            const f32x4 l0 = {u0[0] - hf[0], u0[1] - hf[1], u0[2] - hf[2], u0[3] - hf[3]}, l1 = {u1[0] - hf[4], u1[1] - hf[5], u1[2] - hf[6], u1[3] - hf[7]};
            const bf16x8 ah = __builtin_bit_cast(bf16x8, hi), al = pack8v(l0, l1);
#pragma unroll
            for (int ct = 0; ct < 5; ++ct) { const bf16x8 bh = frag_nat(WHs, 264, 16 * ct + lr, 32 * kb2 + 8 * q4), bl = frag_nat(WLs, 264, 16 * ct + lr, 32 * kb2 + 8 * q4);
                acc[ct] = MFMA(ah, bh, acc[ct]); acc[ct] = MFMA(ah, bl, acc[ct]); acc[ct] = MFMA(al, bh, acc[ct]); }
        }
    }
#pragma unroll
    for (int ct = 0; ct < 5; ++ct)
#pragma unroll
        for (int j = 0; j < 4; ++j) LG[(4 * q4 + j) * 81 + 16 * ct + lr] = acc[ct][j];
    LDS_WAIT(); asm volatile("" ::: "memory");
    int e0 = 0, e1 = 0, k0 = 0, k1 = 0;
    if (live && lane < 16) {
        const LAS float* lg = LG + lane * 81; const float* bg = a.in[I_BRG]; const float* be = a.in[I_BRE];
        float gl[8]; int grp = 0; float gm = -3.0e38f;
#pragma unroll
        for (int j = 0; j < 8; ++j) { gl[j] = lg[j] + bg[j]; if (gl[j] > gm) { gm = gl[j]; grp = j; } }
        float gs = 0.f;
#pragma unroll
        for (int j = 0; j < 8; ++j) gs += __expf(gl[j] - gm);
        const float pg = 1.0f / gs;
        float el[8]; float m1 = -3.0e38f, m2 = -3.0e38f; int i1 = 0, i2 = 0;
#pragma unroll
        for (int j = 0; j < 8; ++j) { el[j] = lg[8 + grp * 8 + j] + be[grp * 8 + j];
            if (el[j] > m1) { m2 = m1; i2 = i1; m1 = el[j]; i1 = j; } else if (el[j] > m2) { m2 = el[j]; i2 = j; } }
        const float e2 = __expf(m2 - m1); const float t1 = 1.0f / (1.0f + e2), t2 = e2 / (1.0f + e2);
        const int tok = row0 + lane;
        e0 = grp * 8 + i1; e1 = grp * 8 + i2;
        toke[2 * tok] = e0; toke[2 * tok + 1] = e1; tokw[2 * tok] = pg * t1; tokw[2 * tok + 1] = pg * t2;
        k0 = atomicAdd((int*)(LCNT + e0), 1); k1 = atomicAdd((int*)(LCNT + e1), 1);
    }
    __syncthreads();
    if (tid < 64) { const int c = LCNT[tid]; LBASE[tid] = c ? (int)atomicAdd(cnt + tid, (unsigned)c) : 0; }
    __syncthreads();
    if (live && lane < 16) { const int tok = row0 + lane; tokp[2 * tok] = LBASE[e0] + k0; tokp[2 * tok + 1] = LBASE[e1] + k1; }
}

__device__ __forceinline__ int build_moe_tables(const Args& a, LAS unsigned char* lds, int tid) {
    LAS int* OFF = (LAS int*)(lds + LDS_T2E + 1024); LAS unsigned char* T2E = lds + LDS_T2E;
    const unsigned* cnt = (const unsigned*)(a.ws + WS_CTL) + CW_CNT;
    if (tid < 64) {
        const int nt = ((int)cnt[tid] + 255) >> 8; int v = nt;
#pragma unroll
        for (int o = 1; o < 64; o <<= 1) { const int t = __shfl_up(v, o); if (tid >= o) v += t; }
        const int start = v - nt;
        OFF[tid] = start << 8; if (tid == 63) OFF[NEXP] = v << 8;
        for (int t = 0; t < nt; ++t) T2E[start + t] = (unsigned char)tid;
    }
    __syncthreads();
    return OFF[NEXP] >> 8;
}

__global__ void __launch_bounds__(512, 2) fwd(Args a) {
    extern __shared__ __attribute__((aligned(16))) unsigned char lds_raw[];
    LAS unsigned char* lds = (LAS unsigned char*)lds_raw;
    const int tid = threadIdx.x, lane = tid & 63, wave = __builtin_amdgcn_readfirstlane(tid >> 6);
    const int G = gridDim.x;
    unsigned char* ws = a.ws;
    volatile LAS unsigned* MISC = (volatile LAS unsigned*)(lds + LDS_MISC);
    if (tid < 16) MISC[tid] = 0u;
    __syncthreads();
    unsigned* ctl = (unsigned*)(ws + WS_CTL);
    XcdBarrier bar; bar.bar = ctl + CW_BAR; bar.x = 0; bar.st = MISC;
    if (MK_N_LAUNCHES == 1) bar = xcd_barrier_post(ctl + CW_BAR, MISC);
    const int lo = a.ph_lo, hi = a.ph_hi;
#if DBG_STAGE == 5
    if (blockIdx.x == 0 && tid == 0) ((unsigned long long*)(ctl + 64))[0] = wall_clock64();
#endif
#ifndef PH_MASK
#define PH_MASK 0x7fff
#endif
#define IN(k) (((PH_MASK >> (k)) & 1) && lo <= (k) && (k) < hi)
#if DBG_STAGE == 5
#define SEAM(k) do { if (IN(k) && IN((k) + 1)) xcd_barrier(bar); if (blockIdx.x == 0 && tid == 0) ((unsigned long long*)(ctl + 64))[(k) + 1] = wall_clock64(); } while (0)
#else
#define SEAM(k) do { if (IN(k) && IN((k) + 1)) xcd_barrier(bar); } while (0)
#endif
    bf16* P1 = (bf16*)(ws + WS_P1);
    const pg8::Gemm g1024{D, D, D};

    if (IN(0)) REPEAT(0) { p0_prologue(a, lds, G, tid, wave, lane); REPSYNC(0); } SEAM(0);
    if (IN(1)) REPEAT(1) {
#ifndef NO_G1A
        { pg8::DenseOrder2 S; S.init(NTOK / 256, N1A / 256 + 4, G, blockIdx.x, a.out, D, ws + WS_B1A, D); S.B2 = (const char*)(ws + WS_B1B); S.nsplit = N1A / 256;
          pg8::EpiPerm<F1a> E{{P1, (float*)(ws + WS_G), (float*)(ws + WS_BETA), ws}};
          pg8::gemm_phase(lds, g1024, S, E); }
#endif
        REPSYNC(1);
    } SEAM(1);
    if (IN(2)) {
        const int blk = blockIdx.x; const bool wide = (G >= 256); const bool dry = false;
        { const int first = wide ? (blk < 128 ? blk : 128) : blk, step = wide ? 128 : G;
          for (int u = first; u < 128; u += step) { gdn_unit(a, lds, u >> 3, u & 7, tid, wave, lane, dry); __syncthreads(); } }
        { const int first = wide ? ((blk >= 128 && blk < 256) ? blk - 128 : 160) : blk, step = wide ? 128 : G;
          for (int u = first; u < 160; u += step) { rg_unit(a, lds, u / 10, u % 10, tid, wave, lane, dry); __syncthreads(); } }
        const int Gp = wide ? G - 128 : G, cp = wide ? blk - 128 : blk;
        if (!wide || blk >= 128) {
            pg8::DenseOrder S; S.init(NB * NMEM / 256, 2 * D / 256, Gp, cp, ws + WS_MEMN, D, ws + WS_WKVT, D);
            pg8::EpiPerm<FBf> E{{(bf16*)(ws + WS_KV), 2 * D}};
            pg8::gemm_phase(lds, g1024, S, E); }
        {
          constexpr int GATE_A = 18, GATE_B = 10, GATE_G = 0; static_assert(96 * GATE_A + 32 * GATE_B + 128 * GATE_G == 2048, "gate GEMM split");
          pg8::RangeOrder S; S.init(NTOK / 256, 2 * D / 256, 1, 0, (unsigned char*)a.out + 128 * MiB, D, ws + WS_B1B + 2 * MiB, D, 1);
          if (wide) { S.start = blk >= 160 ? GATE_A * (blk - 160) : blk >= 128 ? 96 * GATE_A + GATE_B * (blk - 128) : 96 * GATE_A + 32 * GATE_B + GATE_G * blk; S.count = blk >= 160 ? GATE_A : blk >= 128 ? GATE_B : GATE_G; }
          else { const int per = (2048 + G - 1) / G; S.start = blk * per; S.count = per; }
          pg8::EpiPerm<FGate> E{{(unsigned char*)a.out}};
          pg8::gemm_phase<pg8::EpiPerm<FGate>, pg8::RangeOrder, true>(lds, g1024, S, E); }
        __syncthreads();
        if (!wide) expert_convert(a, lds, cp * 8 + wave, Gp * 8, wave, lane);
        else if (blk >= 160) expert_convert(a, lds, (blk - 160) * 8 + wave, 96 * 8, wave, lane);
#if DBG_STAGE == 5
        if (tid == 0) ((unsigned long long*)(ctl + 1024))[blockIdx.x] = wall_clock64();
#endif
    } SEAM(2);
    if (IN(3)) {
        {
          const bf16* KV = (const bf16*)(ws + WS_KV); bf16* VT = (bf16*)(ws + WS_VT); LAS bf16* T = (LAS bf16*)(lds + wave * 9216);
          for (int it = blockIdx.x * 8 + wave; it < NB * CAH * 16; it += G * 8) { const int bh = it >> 4, kb = (it >> 2) & 3, db = it & 3, b_ = bh >> 2, h_ = bh & 3;
              const bf16* src = KV + ((size_t)b_ * 256 + 64 * kb + lane) * 2048 + 1024 + h_ * 256 + 64 * db;
#pragma unroll
              for (int q = 0; q < 8; ++q) { const u32x4 w = *(const u32x4*)(src + 8 * q); const unsigned ww[4] = {w.x, w.y, w.z, w.w};
#pragma unroll
                  for (int j = 0; j < 4; ++j) { T[(8 * q + 2 * j) * 72 + lane] = (bf16)(ww[j] & 0xffffu); T[(8 * q + 2 * j + 1) * 72 + lane] = (bf16)(ww[j] >> 16); } }
              LDS_WAIT(); asm volatile("" ::: "memory");
              bf16* dst = VT + ((size_t)bh * 256 + 64 * db + lane) * 256 + 64 * kb;
#pragma unroll
              for (int q = 0; q < 8; ++q) *(u32x4*)(dst + 8 * q) = *(const LAS u32x4*)(T + lane * 72 + 8 * q);
              LDS_WAIT(); asm volatile("" ::: "memory"); }
          __syncthreads(); }
    }
    if (IN(4)) {
        pg8::DenseOrder S; S.init(NTOK / 256, D / 256, G, blockIdx.x, P1 + RXOFF, LDP, ws + WS_WAT, DRNN + D);
        EpiMix E{P1, (const unsigned char*)a.out};
        pg8::gemm_phase<EpiMix, pg8::DenseOrder, false, DRNN / 64>(lds, pg8::Gemm{LDP, DRNN + D, DRNN + D, (VOFF - RXOFF - DRNN) * 2}, S, E);
    } SEAM(4);
    if (IN(5)) {
        pg8::DenseOrder S; S.init(NTOK / 256, D / 256, G, blockIdx.x, P1 + QOFF, LDP, ws + WS_WOT, D);
        EpiH1 E{a.in[I_X], (bf16*)a.out, D, (float*)(ws + WS_SSQ), ws + WS_P1}; pg8::gemm_phase(lds, pg8::Gemm{LDP, D, D}, S, E);
    } SEAM(5);
    if (IN(7)) {
        pg8::DenseOrder S; S.init(NTOK / 256, D / 256, G, blockIdx.x, ws + WS_P1, LDP8, ws + WS_WCQT, D, 1);
        pg8::EpiPerm<FQc> E{{P1 + RGOFF, (const float*)(ws + WS_SSQ)}}; pg8::gemm_phase<pg8::EpiPerm<FQc>, pg8::DenseOrder, true>(lds, pg8::Gemm{LDP8, D, D}, S, E);
    } SEAM(7);
    if (IN(8)) REPEAT(8) {
        constexpr int NU = NB * CAH * 16; const int per = (NU + G - 1) / G;
        for (int i = 0; i < per; ++i) { const int id = blockIdx.x * per + i; if (id < NU) attn_unit(a, lds, id >> 6, (id >> 4) & 3, id & 15, tid, wave, lane); }
        REPSYNC(8);
    } SEAM(8);
    if (IN(9)) {
        pg8::DenseOrder S; S.init(NTOK / 256, D / 256, G, blockIdx.x, ws + WS_P1 + 2 * KOFF, LDP8, ws + WS_WCOT, D, 1);
        pg8::EpiPlain<FH2> E{{(const bf16*)a.out, ws}}; pg8::gemm_phase<pg8::EpiPlain<FH2>, pg8::DenseOrder, true>(lds, pg8::Gemm{LDP8, D, D}, S, E);
    } SEAM(9);
    if (IN(10)) {
        unsigned* cnt = ctl + CW_CNT;
        const int niter = (NTOK + G * 128 - 1) / (G * 128);
        for (int it = 0; it < niter; ++it) { const int r0 = (blockIdx.x * 8 + wave) * 16 + it * G * 128; router_iter(a, lds, r0, r0 < NTOK, tid, wave, lane, cnt); __syncthreads(); }
    } SEAM(10);
    if (IN(11)) {
        build_moe_tables(a, lds, tid);
        const LAS int* OFF = (const LAS int*)(lds + LDS_T2E + 1024);
        const int* toke = (const int*)(ws + WS_TOKE); const int* tokp = (const int*)(ws + WS_TOKP); int* s2tk = (int*)(ws + WS_S2TK);
        const float* rstd3 = (const float*)(ws + WS_RSTD3); unsigned char* XS = ws + WS_XS;
        for (int m = blockIdx.x * 8 + wave; m < NTOK; m += G * 8) {
            int s0 = 0, s1 = 0;
            if (lane == 0) { s0 = OFF[toke[2 * m]] + tokp[2 * m]; s1 = OFF[toke[2 * m + 1]] + tokp[2 * m + 1]; s2tk[s0] = 2 * m; s2tk[s1] = 2 * m + 1; }
            s0 = __shfl(s0, 0); s1 = __shfl(s1, 0);
            const float rstd = rstd3[m]; const u32x2* xr = (const u32x2*)h2row(ws, (size_t)m) + lane; const f32x4* wr_ = (const f32x4*)a.in[I_NORM3] + lane;
            unsigned* o0 = (unsigned*)(XS + (size_t)s0 * D) + lane; unsigned* o1 = (unsigned*)(XS + (size_t)s1 * D) + lane;
#pragma unroll
            for (int j = 0; j < 4; ++j) { const u32x2 hw = xr[64 * j]; const f32x4 v = (f32x4){bflo(hw.x), bfhi(hw.x), bflo(hw.y), bfhi(hw.y)} * (rstd * F8_SA) * wr_[64 * j]; const unsigned o = pk4_fp8(v[0], v[1], v[2], v[3]); o0[64 * j] = o; o1[64 * j] = o; }
        }
    } SEAM(11);
    if (IN(12)) {
        const int nT = build_moe_tables(a, lds, tid);
        pg8::MoeOrder S; S.init(nT, 4, G, blockIdx.x, ws + WS_XS, D, ws + WS_WGU, D, 1); S.t2e = lds + LDS_T2E; S.ebytes = (size_t)1024 * 1024;
        pg8::EpiPerm<FM1> E{{ws + WS_HID}}; pg8::gemm_phase<pg8::EpiPerm<FM1>, pg8::MoeOrder, true>(lds, g1024, S, E);
    } SEAM(12);
#if DBG_STAGE == 3
    if (IN(13)) {
        unsigned flags = 0;
        for (size_t m = blockIdx.x * 8 + wave; m < (size_t)NTOK; m += G * 8) { const bf16* rowp = P1 + m * LDP;
            for (int cidx = lane; cidx < LDP; cidx += 64) { const unsigned v = rowp[cidx]; if ((v & 0x7f80u) == 0x7f80u) flags |= (cidx < 1280 ? 1u : cidx < 2560 ? 8u : cidx < 4608 ? 4u : 2u); } }
        for (size_t i = (size_t)blockIdx.x * 512 + tid; i < (size_t)NTOK * D; i += (size_t)G * 512) { const float v = a.out[i]; if (!(fabsf(v) < 1e30f)) flags |= 16u; else if (fabsf(v) > 100.f) flags |= 32u; }
        if (flags) atomicOr((unsigned*)(ws + WS_CTL) + 16, flags);
    }
    if (0) {
#else
    if (IN(13)) {
#endif
        const int nT = build_moe_tables(a, lds, tid);
        pg8::MoeOrder S; S.init(nT, 4, G, blockIdx.x, ws + WS_HID, DEXP, ws + WS_WD, DEXP, 1); S.t2e = lds + LDS_T2E; S.ebytes = (size_t)1024 * 512;
        pg8::EpiPerm<FM2> E{{(bf16*)(ws + WS_YE), (const int*)(ws + WS_S2TK), (const float*)(ws + WS_TOKW)}}; pg8::gemm_phase<pg8::EpiPerm<FM2>, pg8::MoeOrder, true>(lds, pg8::Gemm{DEXP, DEXP, DEXP}, S, E);
    } SEAM(13);
    if (IN(14)) {
        const bf16* YE = (const bf16*)(ws + WS_YE);
#if DBG_STAGE == 6
        {
          typedef int v8i_ __attribute__((ext_vector_type(8)));
          f32x4 d1 = {0.f, 0.f, 0.f, 0.f}, d2 = {0.f, 0.f, 0.f, 0.f};
          { v8i_ A, B; float two = 2.f, onehalf = 1.5f; asm volatile("" : "+v"(two), "+v"(onehalf));
            const int pa = (int)pk4_fp8(two, two, two, two), pb = (int)pk4_fp8(onehalf, onehalf, onehalf, onehalf);
#pragma unroll
            for (int q = 0; q < 8; ++q) { A[q] = pa; B[q] = pb; }
            d1 = __builtin_amdgcn_mfma_scale_f32_16x16x128_f8f6f4(A, B, d1, 0, 0, 0, 0, 0, 0); }
          for (int g0 = 0; g0 < 4; ++g0) for (int e0 = 0; e0 < 32; ++e0) { v8i_ A, B;
#pragma unroll
              for (int q = 0; q < 8; ++q) { const bool hit = ((lane >> 4) == g0) && (q == (e0 >> 2)); A[q] = hit ? (0x40 << (8 * (e0 & 3))) : 0; B[q] = hit ? (0x3c << (8 * (e0 & 3))) : 0; }
              asm volatile("v_mfma_f32_16x16x128_f8f6f4 %0, %1, %2, %0\n\ts_nop 15\n\ts_nop 15\n\ts_nop 15" : "+v"(d2) : "v"(A), "v"(B)); }
          const float dv = 4.f + ((d1[0] == 384.f && d1[3] == 384.f) ? 1.f : 0.f) + ((d2[0] == 384.f && d2[3] == 384.f) ? 2.f : 0.f);
          for (int m = blockIdx.x * 8 + wave; m < NTOK; m += G * 8) { f32x4* xr = (f32x4*)(a.out + (size_t)m * D) + lane;
#pragma unroll
              for (int j = 0; j < 4; ++j) xr[64 * j] = (f32x4){dv, dv, dv, dv}; } }
        if (0)
#endif
#if DBG_STAGE == 5
        { const unsigned long long* st = (const unsigned long long*)(ctl + 64); const unsigned long long* pb = (const unsigned long long*)(ctl + 1024);
          unsigned long long gmax = 0, rmax = 0; for (int i = 0; i < 128; ++i) { if (pb[i] > gmax) gmax = pb[i]; if (pb[128 + i] > rmax) rmax = pb[128 + i]; }
          float tv[2]; const int sel[2] = {PROBE_A, PROBE_B};
          for (int q = 0; q < 2; ++q) { const int p = sel[q]; unsigned long long d;
              if (p == 100) d = gmax - st[2]; else if (p == 101) d = rmax - st[2]; else if (p >= 200) d = st[(p - 200) % 20 + 1] - st[(p - 200) / 20]; else d = st[p + 1] - st[p];
              tv[q] = (float)d * 0.01f; }
          const float v1 = 1.5f * (rintf(2.f * log2f(fmaxf(tv[0], 1.f))) * 0.5f), v2 = 30.f + 2.0f * (rintf(2.f * log2f(fmaxf(tv[1], 1.f))) * 0.5f);
          for (int m = blockIdx.x * 8 + wave; m < NTOK; m += G * 8) { f32x4* xr = (f32x4*)(a.out + (size_t)m * D) + lane;
#pragma unroll
              for (int j = 0; j < 4; ++j) xr[64 * j] = (f32x4){v1, v1, v1, v1};
              if (m == 0 && lane == 0) a.out[0] = v2; } }
        if (0)
#endif
#if DBG_STAGE == 3
        { const int dvi = ((const int*)(ws + WS_CTL))[16]; const float dv = dvi ? (float)dvi : 50.f;
          for (int m = blockIdx.x * 8 + wave; m < NTOK; m += G * 8) { f32x4* xr = (f32x4*)(a.out + (size_t)m * D) + lane;
#pragma unroll
              for (int j = 0; j < 4; ++j) xr[64 * j] = (f32x4){dv, dv, dv, dv}; } }
        if (0)
#endif
        for (int m = blockIdx.x * 8 + wave; m < NTOK; m += G * 8) {
            f32x4* xr = (f32x4*)(a.out + (size_t)m * D) + lane; const f32x4* wr_ = (const f32x4*)a.in[I_NORMF] + lane;
            const f32x4* xin = (DBG_STAGE == 1) ? (const f32x4*)(a.in[I_X] + (size_t)m * D) + lane : (const f32x4*)xr;
            const u32x2* y0 = (const u32x2*)(YE + (size_t)(2 * m) * D) + lane; const u32x2* y1 = (const u32x2*)(YE + (size_t)(2 * m + 1) * D) + lane;
            f32x4 v[4]; float s = 0.f;
            const u32x2* h2p = (const u32x2*)h2row(ws, (size_t)m) + lane;
#pragma unroll
            for (int j = 0; j < 4; ++j) { f32x4 t; if (DBG_STAGE == 0) { const u32x2 hw = h2p[64 * j]; t = (f32x4){bflo(hw.x), bfhi(hw.x), bflo(hw.y), bfhi(hw.y)}; } else t = xin[64 * j];
                if (DBG_STAGE == 0) { const u32x2 p = y0[64 * j], q = y1[64 * j];
                    t[0] += bflo(p.x) + bflo(q.x); t[1] += bfhi(p.x) + bfhi(q.x); t[2] += bflo(p.y) + bflo(q.y); t[3] += bfhi(p.y) + bfhi(q.y); }
#ifdef DBG_SANITIZE
#pragma unroll
                for (int q = 0; q < 4; ++q) if (!(fabsf(t[q]) < 1e30f)) t[q] = 0.f;
#endif
                v[j] = t; s += (t[0] * t[0] + t[1] * t[1]) + (t[2] * t[2] + t[3] * t[3]); }
            const float rstd = 1.0f / sqrtf(wave_sum(s) * (1.f / D) + EPS);
#pragma unroll
            for (int j = 0; j < 4; ++j) xr[64 * j] = v[j] * rstd * wr_[64 * j];
        }
    }
#undef IN
#undef SEAM
}

constexpr int NPHASE = 15;
extern "C" void kernel_launch(void* const* d_in, const int* in_sizes, int n_in, void* d_out, int out_size, void* d_ws, size_t ws_size, hipStream_t stream) {
    static int grid = 0;
    if (grid == 0) {
        if (n_in != 32 || out_size != NTOK * D || ws_size < WS_END) { fprintf(stderr, "kernel_launch: unexpected shapes (n_in %d out %d ws %zu)\n", n_in, out_size, ws_size); grid = -1; return; }
        int dev = 0, cus = 0;
        if (hipGetDevice(&dev) != hipSuccess || hipDeviceGetAttribute(&cus, hipDeviceAttributeMultiprocessorCount, dev) != hipSuccess) { grid = -1; return; }
        if (hipFuncSetAttribute((const void*)fwd, hipFuncAttributeMaxDynamicSharedMemorySize, LDS_BYTES) != hipSuccess) { fprintf(stderr, "kernel_launch: hipFuncSetAttribute failed\n"); grid = -1; return; }
        int per_cu = 0;
        if (hipOccupancyMaxActiveBlocksPerMultiprocessor(&per_cu, (const void*)fwd, 512, LDS_BYTES) != hipSuccess || per_cu < 1) { fprintf(stderr, "kernel_launch: occupancy query says %d\n", per_cu); (void)hipGetLastError(); }
        grid = cus;
    }
    if (grid < 0) return;
    hipMemsetAsync((char*)d_ws + WS_CTL, 0, CTL_ZERO_BYTES, stream);
    hipMemsetAsync((char*)d_ws + WS_S2TK, 0xFF, S2TK_BYTES, stream);
    Args a{};
    for (int i = 0; i < 32; ++i) a.in[i] = (const float*)d_in[i];
    a.out = (float*)d_out; a.ws = (unsigned char*)d_ws;
    if (MK_N_LAUNCHES == 1) { a.ph_lo = 0; a.ph_hi = NPHASE; hipLaunchKernelGGL(fwd, dim3(grid), dim3(512), LDS_BYTES, stream, a); }
    else for (int p = 0; p < NPHASE; ++p) { a.ph_lo = p; a.ph_hi = p + 1; hipLaunchKernelGGL(fwd, dim3(grid), dim3(512), LDS_BYTES, stream, a); }
}
```

```cpp
#include <hip/hip_runtime.h>
#include <cstdio>
#include <cstdint>

#ifndef DBG_STAGE
#define DBG_STAGE 0
#endif
#define PROBE_A 2
#ifndef P2_PASSES
#define P2_PASSES 1
#endif
#ifndef REP_MASK
#define REP_MASK 0x0
#endif
#define REPEAT(k) _Pragma("unroll") for (int rep_ = 0; rep_ < 1 + ((REP_MASK >> (k)) & 1); ++rep_)
#define REPSYNC(k) do { if (rep_ < ((REP_MASK >> (k)) & 1)) xcd_barrier(bar); } while (0)
#define PROBE_B 100
#ifndef MK_N_LAUNCHES
#define MK_N_LAUNCHES 1
#endif

#define GAS __attribute__((address_space(1)))
#define LAS __attribute__((address_space(3)))
typedef unsigned short bf16;
typedef short bf16x8 __attribute__((ext_vector_type(8)));
typedef short bf16x4 __attribute__((ext_vector_type(4)));
typedef float f32x4 __attribute__((ext_vector_type(4)));
typedef float f32x2 __attribute__((ext_vector_type(2)));
typedef unsigned u32x4 __attribute__((ext_vector_type(4)));
typedef unsigned u32x2 __attribute__((ext_vector_type(2)));

constexpr int D = 1024, NB = 16, SEQ = 4096, NTOK = NB * SEQ;
constexpr int DRNN = 1280, NHD = 8, HD = 128, NMEM = 256, CAH = 4, CAD = 256;
constexpr int DIN = 8720;
constexpr int LDP = 5632;
constexpr int RXOFF = 0, RGOFF = 1280, QOFF = 2560, KOFF = 3584, VOFF = 4608;
constexpr int N1A = 5888, N1B = 3072;
constexpr int NEXP = 64, DEXP = 512;
constexpr int MAXTILES = 576;
constexpr float EPS = 1e-6f;

constexpr size_t MiB = 1u << 20;
constexpr size_t WS_CTL = 0;
constexpr size_t CTL_ZERO_BYTES = 256 * 1024;
constexpr size_t WS_S2TK = 1 * MiB;
constexpr size_t S2TK_BYTES = (size_t)MAXTILES * 256 * 4;
constexpr size_t WS_P1 = 4 * MiB;
constexpr size_t WS_WGU = 708 * MiB;
constexpr size_t WS_WD = 772 * MiB;
constexpr size_t WS_H2A = 804 * MiB;
constexpr size_t WS_H2B = 979 * MiB;
constexpr size_t WS_B1A = 900 * MiB;
constexpr size_t WS_B1B = 912 * MiB;
constexpr size_t WS_WAT = 918 * MiB;
constexpr size_t WS_WBT = 921 * MiB;
constexpr size_t WS_WOT = 923 * MiB;
constexpr size_t WS_WCQT = 925 * MiB;
constexpr size_t WS_WKVT = 927 * MiB;
constexpr size_t WS_WCOT = 931 * MiB;
constexpr size_t WS_G = 933 * MiB;
constexpr size_t WS_BETA = 935 * MiB;
constexpr size_t WS_KV = 937 * MiB;
constexpr size_t WS_VT = 953 * MiB;
constexpr size_t WS_MEMN = 961 * MiB;
constexpr size_t WS_WRT = 969 * MiB;
constexpr size_t WS_RSTD3 = 970 * MiB;
constexpr size_t WS_TOKE = 971 * MiB;
constexpr size_t WS_TOKW = 972 * MiB;
constexpr size_t WS_RGW = 973 * MiB;
constexpr size_t WS_TOKP = 974 * MiB;
constexpr size_t WS_SSQ = 975 * MiB;
constexpr size_t WS_END = 1011 * MiB;
constexpr size_t WS_U2 = WS_P1, WS_QC = WS_P1 + 128 * MiB, WS_AO = WS_P1 + 256 * MiB;
constexpr size_t WS_XS = WS_P1, WS_HID = WS_P1 + 288 * MiB, WS_YE = WS_P1 + 432 * MiB;
constexpr int CW_BAR = 4096;
constexpr int CW_CNT = 8192;
constexpr int CW_FILL = 8192 + 64;

constexpr int LDS_BYTES = 163840;
constexpr int LDS_MISC = LDS_BYTES - 64;
constexpr int LDS_T2E = 131072;

#define LDS_WAIT() asm volatile("s_waitcnt lgkmcnt(0)" ::: "memory")
#define LBAR() asm volatile("s_waitcnt lgkmcnt(0)\n\ts_barrier" ::: "memory")
#define VM_WAIT() asm volatile("s_waitcnt vmcnt(0)" ::: "memory")
#define MFMA(x, y, c) __builtin_amdgcn_mfma_f32_16x16x32_bf16((x), (y), (c), 0, 0, 0)
typedef __bf16 bf16v2 __attribute__((ext_vector_type(2)));
__device__ __forceinline__ unsigned cvt_pk_bf16(float lo, float hi) { const f32x2 v = {lo, hi}; const bf16v2 r = __builtin_convertvector(v, bf16v2); return __builtin_bit_cast(unsigned, r); }
__device__ __forceinline__ bf16 f2bf(float f) { return (bf16)(cvt_pk_bf16(f, 0.f) & 0xffffu); }
__device__ __forceinline__ float bf2f(unsigned b) { return __uint_as_float(b << 16); }
__device__ __forceinline__ float bflo(unsigned w) { return __uint_as_float(w << 16); }
__device__ __forceinline__ float bfhi(unsigned w) { return __uint_as_float(w & 0xffff0000u); }
__device__ __forceinline__ void unpack8(const u32x4 w, float* f) { f[0] = bflo(w.x); f[1] = bfhi(w.x); f[2] = bflo(w.y); f[3] = bfhi(w.y); f[4] = bflo(w.z); f[5] = bfhi(w.z); f[6] = bflo(w.w); f[7] = bfhi(w.w); }
__device__ __forceinline__ u32x4 pack8(const f32x4 a, const f32x4 b) { u32x4 w; w.x = cvt_pk_bf16(a[0], a[1]); w.y = cvt_pk_bf16(a[2], a[3]); w.z = cvt_pk_bf16(b[0], b[1]); w.w = cvt_pk_bf16(b[2], b[3]); return w; }
__device__ __forceinline__ bf16x8 pack8v(const f32x4 a, const f32x4 b) { const u32x4 w = pack8(a, b); return __builtin_bit_cast(bf16x8, w); }
__device__ __forceinline__ unsigned pk4_fp8(float a, float b, float c, float d) {
    a = fminf(fmaxf(a, -448.f), 448.f); b = fminf(fmaxf(b, -448.f), 448.f); c = fminf(fmaxf(c, -448.f), 448.f); d = fminf(fmaxf(d, -448.f), 448.f);
    int w = __builtin_amdgcn_cvt_pk_fp8_f32(a, b, 0, false); w = __builtin_amdgcn_cvt_pk_fp8_f32(c, d, w, true); return (unsigned)w; }
constexpr float F8_SA = 16.f, F8_SW = 64.f, F8_SH = 16.f;
constexpr float F8_SQW = 1024.f, F8_SAO = 64.f;
constexpr int LDP8 = 11264;
__device__ __forceinline__ float sigmoidf_(float x) { return __builtin_amdgcn_rcpf(1.0f + __expf(-x)); }
__device__ __forceinline__ float siluf_(float x) { return x * __builtin_amdgcn_rcpf(1.0f + __expf(-x)); }
__device__ __forceinline__ float softplusf_(float x) { return x > 20.f ? x : log1pf(__expf(x)); }
__device__ __forceinline__ float gelu_tanh(float x) { const float u = 1.5957691216057308f * (x + 0.044715f * x * x * x); return x * __builtin_amdgcn_rcpf(1.0f + __expf(-u)); }
__device__ __forceinline__ float wave_sum(float v) {
#pragma unroll
    for (int o = 1; o < 64; o <<= 1) v += __shfl_xor(v, o);
    return v;
}

__device__ __forceinline__ bf16* h2row(unsigned char* ws, size_t row) { return row < 49152 ? (bf16*)(ws + WS_H2A) + row * D : (bf16*)(ws + WS_H2B) + (row - 49152) * D; }

#define XB_TMO      128
#define XB_XCNT(j)  (256  + 64 * (j))
#define XB_XSUB(j)  (1280 + 64 * (j))
#define XB_XGEN(j)  (2304 + 64 * (j))
#define XB_TOP      3328
#define XB_TOPGEN   3392
#define XCD_BAR_WORDS 3456
#define XB_SPIN_CAP (1u << 18)
__device__ __forceinline__ unsigned xb_ld(unsigned* p)              { return __hip_atomic_load(p, __ATOMIC_RELAXED, __HIP_MEMORY_SCOPE_AGENT); }
__device__ __forceinline__ unsigned xb_add(unsigned* p, unsigned v) { return __hip_atomic_fetch_add(p, v, __ATOMIC_RELAXED, __HIP_MEMORY_SCOPE_AGENT); }
__device__ __forceinline__ unsigned xb_xcc_id() { return (unsigned)__builtin_amdgcn_s_getreg((3 << 11) | 20) & 0xFu; }
#define XB_SPIN(cond, bar) do { unsigned _sp = 0; while (cond) { __builtin_amdgcn_s_sleep(1); \
    if ((++_sp & 255u) == 0u) { if (xb_ld(&(bar)[XB_TMO])) break; if (_sp > XB_SPIN_CAP) { atomicAdd(&(bar)[XB_TMO], 1u); break; } } } } while (0)
struct XcdBarrier { unsigned* bar; unsigned x; volatile LAS unsigned* st; };
__device__ __forceinline__ XcdBarrier xcd_barrier_post(unsigned* bar, volatile LAS unsigned* st) {
    XcdBarrier b; b.bar = bar; b.x = xb_xcc_id(); b.st = st;
    if (threadIdx.x == 0) (void)xb_add(&bar[XB_XCNT(b.x)], 1u);
    return b;
}
__device__ __forceinline__ void xcd_barrier_complete(unsigned* bar, unsigned x, unsigned& nloc, unsigned& nx) {
    const unsigned G = gridDim.x * gridDim.y * gridDim.z;
    unsigned sum, cnt, mine, sp = 0u;
    for (;;) {
        sum = 0u; cnt = 0u; mine = 0u;
#pragma unroll
        for (unsigned j = 0; j < 16; ++j) { const unsigned c = xb_ld(&bar[XB_XCNT(j)]); sum += c; cnt += (c > 0u) ? 1u : 0u; mine = (j == x) ? c : mine; }
        if (sum == G) break;
        __builtin_amdgcn_s_sleep(1);
        if ((++sp & 255u) == 0u) { if (xb_ld(&bar[XB_TMO])) break; if (sp > XB_SPIN_CAP) { atomicAdd(&bar[XB_TMO], 1u); break; } }
    }
    nloc = mine > 0u ? mine : 1u; nx = cnt > 0u ? cnt : 1u;
}
__device__ __forceinline__ void xcd_barrier(const XcdBarrier& b) {
    asm volatile("s_waitcnt vmcnt(0)" ::: "memory");
    __syncthreads();
    if (threadIdx.x == 0) {
        unsigned* bar = b.bar;
        __builtin_amdgcn_s_waitcnt(0);
        unsigned nloc = b.st[0], nx = b.st[1];
        if (nloc == 0u) { xcd_barrier_complete(bar, b.x, nloc, nx); b.st[0] = nloc; b.st[1] = nx; }
        const unsigned old = xb_add(&bar[XB_XSUB(b.x)], 1u);
        const unsigned gen = old / nloc;
        if (old + 1u == (gen + 1u) * nloc) {
            __builtin_amdgcn_fence(__ATOMIC_RELEASE, "agent");
            asm volatile("s_waitcnt vmcnt(0)" ::: "memory");
            const unsigned og = xb_add(&bar[XB_TOP], 1u);
            const unsigned tg = og / nx;
            if (og + 1u == (tg + 1u) * nx) xb_add(&bar[XB_TOPGEN], 1u);
            else XB_SPIN(xb_ld(&bar[XB_TOPGEN]) == tg, bar);
            __builtin_amdgcn_fence(__ATOMIC_ACQUIRE, "agent");
            xb_add(&bar[XB_XGEN(b.x)], 1u);
            asm volatile("s_waitcnt vmcnt(0)" ::: "memory");
        } else {
            XB_SPIN(xb_ld(&bar[XB_XGEN(b.x)]) == gen, bar);
            __builtin_amdgcn_fence(__ATOMIC_ACQUIRE, "agent");
            asm volatile("s_waitcnt vmcnt(0)" ::: "memory");
        }
    }
    __syncthreads();
}

namespace pg8 {
typedef int v4i_t __attribute__((ext_vector_type(4)));
typedef int v8i_t __attribute__((ext_vector_type(8)));
constexpr int BM = 256, BK = 64, HALF = 128, HTB = HALF * BK * 2, STAGE_BYTES = 8 * HTB, NXCD = 8, WGM = 8;
__host__ __device__ __forceinline__ int lds_byte(int r, int c) { const int st = (r >> 4) * 2 + (c >> 5), rr = r & 15, cc = c & 31, ob = rr * 64 + cc * 2; return st * 1024 + (ob ^ (((ob >> 9) & 1) << 5)); }
__host__ __device__ __forceinline__ void stage_rc(int b, int& R, int& C) { const int st = b / 1024, sb = b % 1024, swz = sb ^ (((sb >> 9) & 1) << 5); R = (st >> 1) * 16 + swz / 64; C = (st & 1) * 32 + (swz % 64) / 2; }
__host__ __device__ __forceinline__ int perm32(int rho) { const int n = rho >> 4, i = rho & 15; return 8 * (i >> 2) + 4 * n + (i & 3); }
struct Unit { int pm, pn; };
struct Gemm { int lda, ldb, K; };

struct DenseOrder {
    int nM, nN, nwg, G, c; const char* A; const char* B; size_t atile, btile;
    __device__ void init(int nM_, int nN_, int G_, int c_, const void* A_, size_t lda, const void* B_, size_t ldb, int esz = 2) { nM = nM_; nN = nN_; nwg = nM * nN; G = G_; c = c_; A = (const char*)A_; B = (const char*)B_; atile = 256 * lda * esz; btile = 256 * ldb * esz; }
    __device__ bool next(int i, Unit& u) const {
        const long L = (long)i * G + c; if (L >= nwg) return false;
        int wgid = (int)L; { const int q = nwg / NXCD, r = nwg % NXCD, xcd = wgid % NXCD, off = wgid / NXCD; wgid = (xcd < r ? xcd * (q + 1) : r * (q + 1) + (xcd - r) * q) + off; }
        const int nig = WGM * nN, gid = wgid / nig, fm = gid * WGM, gsz = (nM - fm) < WGM ? (nM - fm) : WGM;
        u.pm = fm + ((wgid % nig) % gsz); u.pn = (wgid % nig) / gsz; return true;
    }
    __device__ __forceinline__ const char* aptr(const Unit& u) const { return A + (size_t)u.pm * atile; }
    __device__ __forceinline__ const char* bptr(const Unit& u) const { return B + (size_t)u.pn * btile; }
};
struct SplitOrder : DenseOrder {
    int nid;
    __device__ bool next(int i, Unit& u) const {
        const int id = c + (i % nid), round = i / nid;
        const long L = (long)round * G + id; if (L >= nwg) return false;
        int wgid = (int)L; { const int q = nwg / NXCD, r = nwg % NXCD, xcd = wgid % NXCD, off = wgid / NXCD; wgid = (xcd < r ? xcd * (q + 1) : r * (q + 1) + (xcd - r) * q) + off; }
        const int nig = WGM * nN, gid = wgid / nig, fm = gid * WGM, gsz = (nM - fm) < WGM ? (nM - fm) : WGM;
        u.pm = fm + ((wgid % nig) % gsz); u.pn = (wgid % nig) / gsz; return true;
    }
};
struct RangeOrder : DenseOrder {
    int start, count;
    __device__ bool next(int i, Unit& u) const {
        if (i >= count) return false;
        const int wgid = start + i; if (wgid >= nwg) return false;
        const int nig = WGM * nN, gid = wgid / nig, fm = gid * WGM, gsz = (nM - fm) < WGM ? (nM - fm) : WGM;
        u.pm = fm + ((wgid % nig) % gsz); u.pn = (wgid % nig) / gsz; return true;
    }
};
struct DenseOrder2 : DenseOrder {
    const char* B2; int nsplit;
    __device__ __forceinline__ const char* bptr(const Unit& u) const { return u.pn < nsplit ? B + (size_t)u.pn * btile : B2 + (size_t)(u.pn - nsplit) * btile; }
};
struct MoeOrder : DenseOrder {
    const LAS unsigned char* t2e; size_t ebytes;
    __device__ __forceinline__ const char* bptr(const Unit& u) const { const int e = __builtin_amdgcn_readfirstlane((int)t2e[u.pm]); return B + (size_t)e * ebytes + (size_t)u.pn * btile; }
};

template <class F> struct EpiPerm {
    static constexpr bool PERM = true; F f;
    __device__ __forceinline__ void operator()(const f32x4 (&acc)[2][2][4][2], const Unit& u, int wr, int wc, int fr, int fq) const {
#pragma unroll
        for (int ai = 0; ai < 2; ++ai)
#pragma unroll
            for (int m = 0; m < 4; ++m) f(u, ai * HALF + wr * 64 + m * 16 + fr, wc * 32 + 8 * fq, acc[ai][0][m][0], acc[ai][0][m][1], acc[ai][1][m][0], acc[ai][1][m][1]);
    }
};
template <class F> struct EpiPerm2 {
    static constexpr bool PERM = true; F f;
    __device__ __forceinline__ void operator()(const f32x4 (&acc)[2][2][4][2], const Unit& u, int wr, int wc, int fr, int fq) const {
#pragma unroll
        for (int ai = 0; ai < 2; ++ai) { typename F::L l[4];
#pragma unroll
            for (int m = 0; m < 4; ++m) l[m] = f.load(u, ai * HALF + wr * 64 + m * 16 + fr, wc * 32 + 8 * fq);
#pragma unroll
            for (int m = 0; m < 4; ++m) f.store(u, ai * HALF + wr * 64 + m * 16 + fr, wc * 32 + 8 * fq, l[m], acc[ai][0][m][0], acc[ai][0][m][1], acc[ai][1][m][0], acc[ai][1][m][1]); }
    }
};
template <class F> struct EpiPlain {
    static constexpr bool PERM = false; F f;
    __device__ __forceinline__ void operator()(const f32x4 (&acc)[2][2][4][2], const Unit& u, int wr, int wc, int fr, int fq) const {
#pragma unroll
        for (int ai = 0; ai < 2; ++ai)
#pragma unroll
            for (int m = 0; m < 4; ++m)
#pragma unroll
                for (int bj = 0; bj < 2; ++bj)
#pragma unroll
                    for (int n = 0; n < 2; ++n) f(u, ai * HALF + wr * 64 + m * 16 + fr, bj * HALF + wc * 32 + n * 16 + 4 * fq, acc[ai][bj][m][n]);
    }
};

template <class Epi, class Sched, bool FP8 = false>
__device__ __forceinline__ void gemm_phase(LAS unsigned char* lds, const Gemm g, const Sched& S, const Epi& E) {
    const int tid = threadIdx.x, wid = __builtin_amdgcn_readfirstlane(tid >> 6), lane = tid & 63, wr = wid >> 2, wc = wid & 3, fr = lane & 15, fq = lane >> 4;
    constexpr unsigned ESZ = FP8 ? 1u : 2u;
    const int K = g.K, nt = FP8 ? K / 128 : K / BK;
    unsigned voffA[2], voffB[2];
#pragma unroll
    for (int i = 0; i < 2; ++i) { int R, C; stage_rc(tid * 16 + i * 8192, R, C); const int Rb = Epi::PERM ? ((R & ~31) + perm32(R & 31)) : R;
        voffA[i] = (unsigned)(R * g.lda) * ESZ + (unsigned)C * 2u; voffB[i] = (unsigned)(Rb * g.ldb) * ESZ + (unsigned)C * 2u; }
    const size_t kstep = (size_t)(BK * 2);
    const size_t hstepA = (size_t)HALF * g.lda * ESZ, hstepB = (size_t)HALF * g.ldb * ESZ;
    const unsigned ldsw = (unsigned)wid * 1024u;
    const int aoff = lds_byte(wr * 64 + fr, fq * 8), boff = lds_byte(wc * 32 + fr, fq * 8);
#define PG8_SA(b, h) (((b) * 2 + (h)) * HTB)
#define PG8_SB(b, h) ((4 + (b) * 2 + (h)) * HTB)
#define PG8_STAGE(bufoff, gbase, voff) do { _Pragma("unroll") for (int _i = 0; _i < 2; ++_i) \
        __builtin_amdgcn_global_load_lds((const unsigned*)((const char*)(gbase) + (voff)[_i]), (LAS unsigned*)(lds + (bufoff) + ldsw + _i * 8192), 16, 0, 0); } while (0)
#define PG8_LDA(dst, b, h) do { _Pragma("unroll") for (int m = 0; m < 4; ++m) _Pragma("unroll") for (int k = 0; k < 2; ++k) dst[m][k] = *(const LAS v4i_t*)(lds + PG8_SA(b, h) + aoff + m * 2048 + k * 1024); } while (0)
#define PG8_LDB(dst, b, h) do { _Pragma("unroll") for (int n = 0; n < 2; ++n) _Pragma("unroll") for (int k = 0; k < 2; ++k) dst[n][k] = *(const LAS v4i_t*)(lds + PG8_SB(b, h) + boff + n * 2048 + k * 1024); } while (0)
#define PG8_CAT(q) __builtin_shufflevector((q)[0], (q)[1], 0, 1, 2, 3, 4, 5, 6, 7)
#define PG8_MMA(ai, bj, At, Bt) do { __builtin_amdgcn_s_setprio(1); _Pragma("unroll") for (int m = 0; m < 4; ++m) _Pragma("unroll") for (int n = 0; n < 2; ++n) { \
        if constexpr (FP8) asm volatile("v_mfma_f32_16x16x128_f8f6f4 %0, %1, %2, %0" : "+v"(acc[ai][bj][m][n]) : "v"(PG8_CAT(Bt[n])), "v"(PG8_CAT(At[m])));     \
        else { _Pragma("unroll") for (int k = 0; k < 2; ++k) acc[ai][bj][m][n] = __builtin_amdgcn_mfma_f32_16x16x32_bf16(__builtin_bit_cast(bf16x8, Bt[n][k]), __builtin_bit_cast(bf16x8, At[m][k]), acc[ai][bj][m][n], 0, 0, 0); } } \
        __builtin_amdgcn_s_setprio(0); } while (0)
#define PG8_WAIT_V(n) asm volatile("s_waitcnt vmcnt(" #n ")" ::: "memory")
#define PG8_WAIT_L(n) asm volatile("s_waitcnt lgkmcnt(" #n ")" ::: "memory")
#define PG8_BAR __builtin_amdgcn_s_barrier()
#define PG8_SCHED __builtin_amdgcn_sched_barrier(0)
    Unit cur, nxt; int ui = 0;
    if (!S.next(0, cur)) return;
    f32x4 acc[2][2][4][2];
#pragma unroll
    for (int a = 0; a < 2; ++a)
#pragma unroll
        for (int b = 0; b < 2; ++b)
#pragma unroll
            for (int m = 0; m < 4; ++m)
#pragma unroll
                for (int n = 0; n < 2; ++n) acc[a][b][m][n] = (f32x4){0.f, 0.f, 0.f, 0.f};
    v4i_t At[4][2], B0[2][2], B1[2][2];
    const char* cA = S.aptr(cur); const char* cB = S.bptr(cur);
    PG8_STAGE(PG8_SB(0, 0), cB, voffB); PG8_STAGE(PG8_SB(0, 1), cB + hstepB, voffB); PG8_STAGE(PG8_SA(0, 0), cA, voffA); PG8_STAGE(PG8_SA(0, 1), cA + hstepA, voffA);
    if (wr == 1) PG8_BAR;
    PG8_WAIT_V(2); PG8_BAR;
    PG8_STAGE(PG8_SB(1, 0), cB + kstep, voffB); PG8_STAGE(PG8_SA(1, 0), cA + kstep, voffA); PG8_STAGE(PG8_SB(1, 1), cB + hstepB + kstep, voffB);
    PG8_WAIT_V(6); PG8_BAR;
    for (;;) {
        const bool has_next = S.next(ui + 1, nxt);
        const char* nA = has_next ? S.aptr(nxt) : cA; const char* nB = has_next ? S.bptr(nxt) : cB;
#pragma unroll 1
        for (int t = 0; t < nt; t += 2) {
            const bool last = (t == nt - 2);
            const char* a1 = cA + (size_t)(t + 1) * kstep;
            const char* a2 = last ? nA : cA + (size_t)(t + 2) * kstep; const char* b2 = last ? nB : cB + (size_t)(t + 2) * kstep;
            const char* a3 = a2 + kstep; const char* b3 = b2 + kstep;
            PG8_LDB(B0, 0, 0); PG8_LDB(B1, 0, 1); PG8_SCHED; PG8_LDA(At, 0, 0); PG8_STAGE(PG8_SA(1, 1), a1 + hstepA, voffA);
            PG8_WAIT_V(8); PG8_WAIT_L(0); PG8_BAR; PG8_MMA(0, 0, At, B0); PG8_MMA(0, 1, At, B1); PG8_BAR; PG8_SCHED;
            PG8_LDA(At, 0, 1); PG8_STAGE(PG8_SB(0, 0), b2, voffB); PG8_STAGE(PG8_SB(0, 1), b2 + hstepB, voffB); PG8_STAGE(PG8_SA(0, 0), a2, voffA);
            PG8_WAIT_V(8); PG8_WAIT_L(0); PG8_BAR; PG8_MMA(1, 0, At, B0); PG8_MMA(1, 1, At, B1); PG8_BAR; PG8_SCHED;
            PG8_LDB(B0, 1, 0); PG8_LDB(B1, 1, 1); PG8_SCHED; PG8_LDA(At, 1, 0); PG8_STAGE(PG8_SA(0, 1), a2 + hstepA, voffA);
            PG8_WAIT_V(8); PG8_WAIT_L(0); PG8_BAR; PG8_MMA(0, 0, At, B0); PG8_MMA(0, 1, At, B1); PG8_BAR; PG8_SCHED;
            PG8_LDA(At, 1, 1); PG8_STAGE(PG8_SB(1, 0), b3, voffB); PG8_STAGE(PG8_SB(1, 1), b3 + hstepB, voffB); PG8_STAGE(PG8_SA(1, 0), a3, voffA);
            PG8_WAIT_V(8); PG8_WAIT_L(0); PG8_BAR; PG8_MMA(1, 0, At, B0); PG8_MMA(1, 1, At, B1); PG8_BAR; PG8_SCHED;
        }
        if constexpr (FP8) asm volatile("s_nop 15\n\ts_nop 15\n\ts_nop 15" ::: "memory");
        if (wr == 0) PG8_BAR;
        { int t2 = threadIdx.x; asm volatile("" : "+v"(t2));
          const int w2 = __builtin_amdgcn_readfirstlane(t2 >> 6), l2 = t2 & 63; E(acc, cur, w2 >> 2, w2 & 3, l2 & 15, l2 >> 4); }
        if (!has_next) break;
#pragma unroll
        for (int a = 0; a < 2; ++a)
#pragma unroll
            for (int b = 0; b < 2; ++b)
#pragma unroll
                for (int m = 0; m < 4; ++m)
#pragma unroll
                    for (int n = 0; n < 2; ++n) acc[a][b][m][n] = (f32x4){0.f, 0.f, 0.f, 0.f};
        cur = nxt; cA = nA; cB = nB; ++ui;
        if (wr == 1) PG8_BAR;
    }
    PG8_WAIT_V(0);
    PG8_BAR;
#undef PG8_SA
#undef PG8_SB
#undef PG8_STAGE
#undef PG8_LDA
#undef PG8_LDB
#undef PG8_MMA
#undef PG8_WAIT_V
#undef PG8_WAIT_L
#undef PG8_BAR
#undef PG8_SCHED
}
}
using pg8::Unit;

__device__ __forceinline__ void st8(bf16* p, const f32x4 a, const f32x4 b) { *(u32x4*)p = pack8(a, b); }
struct F1a {
    bf16* P1; float* gbuf; float* betabuf; unsigned char* ws;
    static __device__ __forceinline__ f32x4 silu4(const f32x4 v) { return (f32x4){siluf_(v[0]), siluf_(v[1]), siluf_(v[2]), siluf_(v[3])}; }
    __device__ __forceinline__ void operator()(const Unit& u, int r, int c, const f32x4 a0, const f32x4 a1, const f32x4 b0, const f32x4 b1) const {
        const size_t row = (size_t)u.pm * 256 + r;
        if (u.pn < 22) { bf16* p = P1 + row * LDP + u.pn * 256 + c; st8(p, a0, a1); st8(p + 128, b0, b1); }
        else if (u.pn >= 23) { bf16* p = h2row(ws, row) + (u.pn - 23) * 256 + c; st8(p, silu4(a0), silu4(a1)); st8(p + 128, silu4(b0), silu4(b1)); }
        else if (c == 0) { *(f32x4*)(gbuf + row * 8) = a0; *(f32x4*)(gbuf + row * 8 + 4) = a1; }
        else if (c == 8) { *(f32x4*)(betabuf + row * 8) = a0; *(f32x4*)(betabuf + row * 8 + 4) = a1; }
    }
};
struct F1b {
    bf16* P1;
    __device__ __forceinline__ void zmul(bf16* p, const f32x4 a, const f32x4 b) const {
        const u32x4 w = *(const u32x4*)p; float o[8]; unpack8(w, o); f32x4 x, y;
#pragma unroll
        for (int j = 0; j < 4; ++j) { x[j] = o[j] * siluf_(a[j]); y[j] = o[4 + j] * siluf_(b[j]); }
        st8(p, x, y);
    }
    __device__ __forceinline__ void operator()(const Unit& u, int r, int c, const f32x4 a0, const f32x4 a1, const f32x4 b0, const f32x4 b1) const {
        bf16* p = P1 + ((size_t)u.pm * 256 + r) * LDP + VOFF + u.pn * 256 + c; zmul(p, a0, a1); zmul(p + 128, b0, b1);
    }
};
struct FGate {
    unsigned char* SG;
    __device__ __forceinline__ unsigned q4(const f32x4 v) const { unsigned r = 0;
#pragma unroll
        for (int j = 0; j < 4; ++j) r |= (unsigned)(sigmoidf_(v[j] * (1.f / (F8_SA * F8_SW))) * 255.f + 0.5f) << (8 * j);
        return r; }
    __device__ __forceinline__ void operator()(const Unit& u, int r, int c, const f32x4 a0, const f32x4 a1, const f32x4 b0, const f32x4 b1) const {
        unsigned char* p = SG + ((size_t)u.pm * 256 + r) * 2048 + u.pn * 256 + c;
        u32x2 x; x.x = q4(a0); x.y = q4(a1); *(u32x2*)p = x; u32x2 y; y.x = q4(b0); y.y = q4(b1); *(u32x2*)(p + 128) = y;
    }
};
struct F2a {
    bf16* P1; const unsigned char* SG;
    struct L { u32x2 w0, w1; };
    __device__ __forceinline__ L load(const Unit& u, int r, int c) const { const unsigned char* sg = SG + ((size_t)u.pm * 256 + r) * 2048 + u.pn * 256 + c; return L{*(const u32x2*)sg, *(const u32x2*)(sg + 128)}; }
    static __device__ __forceinline__ void gate(bf16* p, const u32x2 w, const f32x4 a, const f32x4 b) { f32x4 x, y;
#pragma unroll
        for (int j = 0; j < 4; ++j) { x[j] = a[j] * ((float)((w.x >> (8 * j)) & 255u) * (1.f / 255.f)); y[j] = b[j] * ((float)((w.y >> (8 * j)) & 255u) * (1.f / 255.f)); }
        st8(p, x, y); }
    __device__ __forceinline__ void store(const Unit& u, int r, int c, const L& l, const f32x4 a0, const f32x4 a1, const f32x4 b0, const f32x4 b1) const {
        bf16* p = P1 + ((size_t)u.pm * 256 + r) * LDP + QOFF + u.pn * 256 + c; gate(p, l.w0, a0, a1); gate(p + 128, l.w1, b0, b1); }
    __device__ __forceinline__ void one(bf16* rowp, const unsigned char* sg, int col, const f32x4 a, const f32x4 b) const {
        const u32x2 w = *(const u32x2*)(sg + col); f32x4 x, y;
#pragma unroll
        for (int j = 0; j < 4; ++j) { x[j] = a[j] * ((float)((w.x >> (8 * j)) & 255u) * (1.f / 255.f)); y[j] = b[j] * ((float)((w.y >> (8 * j)) & 255u) * (1.f / 255.f)); }
        st8(rowp + QOFF + col, x, y);
    }
    __device__ __forceinline__ void operator()(const Unit& u, int r, int c, const f32x4 a0, const f32x4 a1, const f32x4 b0, const f32x4 b1) const {
        const size_t row = (size_t)u.pm * 256 + r; bf16* rowp = P1 + row * LDP; const unsigned char* sg = SG + row * 2048; one(rowp, sg, u.pn * 256 + c, a0, a1); one(rowp, sg, u.pn * 256 + 128 + c, b0, b1);
    }
};
struct F2b {
    bf16* P1; const unsigned char* SG;
    struct L { u32x2 w0, w1; u32x4 m0, m1; };
    __device__ __forceinline__ L load(const Unit& u, int r, int c) const { const size_t row = (size_t)u.pm * 256 + r; const unsigned char* sg = SG + row * 2048 + 1024 + u.pn * 256 + c; const bf16* p = P1 + row * LDP + QOFF + u.pn * 256 + c;
        return L{*(const u32x2*)sg, *(const u32x2*)(sg + 128), *(const u32x4*)p, *(const u32x4*)(p + 128)}; }
    static __device__ __forceinline__ void gate(bf16* p, const u32x2 w, const u32x4 mw, const f32x4 a, const f32x4 b) { float ma[8]; unpack8(mw, ma); f32x4 x, y;
#pragma unroll
        for (int j = 0; j < 4; ++j) { x[j] = ma[j] + a[j] * ((float)((w.x >> (8 * j)) & 255u) * (1.f / 255.f)); y[j] = ma[4 + j] + b[j] * ((float)((w.y >> (8 * j)) & 255u) * (1.f / 255.f)); }
        st8(p, x, y); }
    __device__ __forceinline__ void store(const Unit& u, int r, int c, const L& l, const f32x4 a0, const f32x4 a1, const f32x4 b0, const f32x4 b1) const {
        bf16* p = P1 + ((size_t)u.pm * 256 + r) * LDP + QOFF + u.pn * 256 + c; gate(p, l.w0, l.m0, a0, a1); gate(p + 128, l.w1, l.m1, b0, b1); }
    __device__ __forceinline__ void one(bf16* rowp, const unsigned char* sg, int col, const f32x4 a, const f32x4 b) const {
        const u32x2 w = *(const u32x2*)(sg + 1024 + col);
        const u32x4 mw = *(const u32x4*)(rowp + QOFF + col); float ma[8]; unpack8(mw, ma); f32x4 x, y;
#pragma unroll
        for (int j = 0; j < 4; ++j) { x[j] = ma[j] + a[j] * ((float)((w.x >> (8 * j)) & 255u) * (1.f / 255.f)); y[j] = ma[4 + j] + b[j] * ((float)((w.y >> (8 * j)) & 255u) * (1.f / 255.f)); }
        st8(rowp + QOFF + col, x, y);
    }
    __device__ __forceinline__ void operator()(const Unit& u, int r, int c, const f32x4 a0, const f32x4 a1, const f32x4 b0, const f32x4 b1) const {
        const size_t row = (size_t)u.pm * 256 + r; bf16* rowp = P1 + row * LDP; const unsigned char* sg = SG + row * 2048; one(rowp, sg, u.pn * 256 + c, a0, a1); one(rowp, sg, u.pn * 256 + 128 + c, b0, b1);
    }
};
struct EpiH2 {
    static constexpr bool PERM = false;
    const bf16* H1; unsigned char* ws;
    __device__ __forceinline__ void operator()(const f32x4 (&acc)[2][2][4][2], const Unit& u, int wr, int wc, int fr, int fq) const {
#pragma unroll
        for (int ai = 0; ai < 2; ++ai) { u32x2 hv[4][2][2];
#pragma unroll
            for (int m = 0; m < 4; ++m)
#pragma unroll
                for (int bj = 0; bj < 2; ++bj)
#pragma unroll
                    for (int n = 0; n < 2; ++n) hv[m][bj][n] = *(const u32x2*)(H1 + ((size_t)u.pm * 256 + ai * 128 + wr * 64 + m * 16 + fr) * D + u.pn * 256 + bj * 128 + wc * 32 + n * 16 + 4 * fq);
#pragma unroll
            for (int m = 0; m < 4; ++m) { const size_t row = (size_t)u.pm * 256 + ai * 128 + wr * 64 + m * 16 + fr; bf16* orow = h2row(ws, row);
#pragma unroll
                for (int bj = 0; bj < 2; ++bj)
#pragma unroll
                    for (int n = 0; n < 2; ++n) { const int col = u.pn * 256 + bj * 128 + wc * 32 + n * 16 + 4 * fq; const u32x2 w = hv[m][bj][n];
                        const f32x4 h = (f32x4){bflo(w.x), bfhi(w.x), bflo(w.y), bfhi(w.y)} + acc[ai][bj][m][n] * (1.f / (F8_SAO * F8_SW));
                        u32x2 o; o.x = cvt_pk_bf16(h[0], h[1]); o.y = cvt_pk_bf16(h[2], h[3]); *(u32x2*)(orow + col) = o; } } }
    }
};
struct FH2 {
    const bf16* H1; unsigned char* ws;
    __device__ __forceinline__ void operator()(const Unit& u, int r, int c, const f32x4 v) const {
        const size_t row = (size_t)u.pm * 256 + r; const int col = u.pn * 256 + c;
        const u32x2 w = *(const u32x2*)(H1 + row * D + col); const f32x4 h = (f32x4){bflo(w.x), bfhi(w.x), bflo(w.y), bfhi(w.y)} + v * (1.f / (F8_SAO * F8_SW));
        u32x2 o; o.x = cvt_pk_bf16(h[0], h[1]); o.y = cvt_pk_bf16(h[2], h[3]); *(u32x2*)(h2row(ws, row) + col) = o;
    }
};
struct FRes {
    const float* base; float* out;
    __device__ __forceinline__ void operator()(const Unit& u, int r, int c, const f32x4 v) const {
        const size_t o = ((size_t)u.pm * 256 + r) * D + u.pn * 256 + c; *(f32x4*)(out + o) = *(const f32x4*)(base + o) + v;
    }
};
struct EpiH1 {
    static constexpr bool PERM = false;
    const float* x; bf16* HB; int ldh; float* SSQ; unsigned char* H8;
    __device__ __forceinline__ void operator()(const f32x4 (&acc)[2][2][4][2], const Unit& u, int wr, int wc, int fr, int fq) const {
#pragma unroll
        for (int ai = 0; ai < 2; ++ai) {
            f32x4 xv[4][2][2];
#pragma unroll
            for (int m = 0; m < 4; ++m)
#pragma unroll
                for (int bj = 0; bj < 2; ++bj)
#pragma unroll
                    for (int n = 0; n < 2; ++n) xv[m][bj][n] = *(const f32x4*)(x + ((size_t)u.pm * 256 + ai * 128 + wr * 64 + m * 16 + fr) * D + u.pn * 256 + bj * 128 + wc * 32 + n * 16 + 4 * fq);
#pragma unroll
            for (int m = 0; m < 4; ++m) { const size_t row = (size_t)u.pm * 256 + ai * 128 + wr * 64 + m * 16 + fr; float ss = 0.f;
#pragma unroll
                for (int bj = 0; bj < 2; ++bj)
#pragma unroll
                    for (int n = 0; n < 2; ++n) { const int col = u.pn * 256 + bj * 128 + wc * 32 + n * 16 + 4 * fq;
                        const f32x4 h = xv[m][bj][n] + acc[ai][bj][m][n];
                        u32x2 p; p.x = cvt_pk_bf16(h[0], h[1]); p.y = cvt_pk_bf16(h[2], h[3]); *(u32x2*)(HB + row * ldh + col) = p;
                        *(unsigned*)(H8 + row * LDP8 + col) = pk4_fp8(h[0] * F8_SA, h[1] * F8_SA, h[2] * F8_SA, h[3] * F8_SA);
                        ss += (h[0] * h[0] + h[1] * h[1]) + (h[2] * h[2] + h[3] * h[3]); }
                ss += __shfl_xor(ss, 16); ss += __shfl_xor(ss, 32);
                if (fq == 0) SSQ[row * 16 + u.pn * 4 + wc] = ss; } }
    }
};
struct FQc {
    bf16* O; const float* SSQ;
    struct L { f32x4 s0, s1, s2, s3; };
    __device__ __forceinline__ L load(const Unit& u, int r, int c) const { const f32x4* sp = (const f32x4*)(SSQ + ((size_t)u.pm * 256 + r) * 16); return L{sp[0], sp[1], sp[2], sp[3]}; }
    __device__ __forceinline__ void store(const Unit& u, int r, int c, const L& l, const f32x4 a0, const f32x4 a1, const f32x4 b0, const f32x4 b1) const {
        const float ss = ((l.s0[0] + l.s0[1]) + (l.s0[2] + l.s0[3])) + ((l.s1[0] + l.s1[1]) + (l.s1[2] + l.s1[3])) + ((l.s2[0] + l.s2[1]) + (l.s2[2] + l.s2[3])) + ((l.s3[0] + l.s3[1]) + (l.s3[2] + l.s3[3]));
        const float rstd = (1.0f / (F8_SA * F8_SQW)) / sqrtf(ss * (1.f / D) + EPS);
        bf16* p = O + ((size_t)u.pm * 256 + r) * LDP + u.pn * 256 + c; st8(p, a0 * rstd, a1 * rstd); st8(p + 128, b0 * rstd, b1 * rstd); }
    __device__ __forceinline__ void operator()(const Unit& u, int r, int c, const f32x4 a0, const f32x4 a1, const f32x4 b0, const f32x4 b1) const {
        const size_t row = (size_t)u.pm * 256 + r; const f32x4* sp = (const f32x4*)(SSQ + row * 16);
        const f32x4 s0 = sp[0], s1 = sp[1], s2 = sp[2], s3 = sp[3];
        const float ss = ((s0[0] + s0[1]) + (s0[2] + s0[3])) + ((s1[0] + s1[1]) + (s1[2] + s1[3])) + ((s2[0] + s2[1]) + (s2[2] + s2[3])) + ((s3[0] + s3[1]) + (s3[2] + s3[3]));
        const float rstd = (1.0f / (F8_SA * F8_SQW)) / sqrtf(ss * (1.f / D) + EPS);
        bf16* p = O + row * LDP + u.pn * 256 + c; st8(p, a0 * rstd, a1 * rstd); st8(p + 128, b0 * rstd, b1 * rstd);
    }
};
struct FBf {
    bf16* O; int ldc;
    __device__ __forceinline__ void operator()(const Unit& u, int r, int c, const f32x4 a0, const f32x4 a1, const f32x4 b0, const f32x4 b1) const {
        bf16* p = O + ((size_t)u.pm * 256 + r) * ldc + u.pn * 256 + c; st8(p, a0, a1); st8(p + 128, b0, b1);
    }
};
struct FM1 {
    unsigned char* HID;
    __device__ __forceinline__ void operator()(const Unit& u, int r, int c, const f32x4 a0, const f32x4 a1, const f32x4 b0, const f32x4 b1) const {
        constexpr float ds = 1.f / (F8_SA * F8_SW); f32x4 x, y;
#pragma unroll
        for (int j = 0; j < 4; ++j) { x[j] = siluf_(a0[j] * ds) * (b0[j] * (ds * F8_SH)); y[j] = siluf_(a1[j] * ds) * (b1[j] * (ds * F8_SH)); }
        u32x2 o; o.x = pk4_fp8(x[0], x[1], x[2], x[3]); o.y = pk4_fp8(y[0], y[1], y[2], y[3]);
        *(u32x2*)(HID + ((size_t)u.pm * 256 + r) * DEXP + u.pn * 128 + c) = o;
    }
};
struct FM2 {
    bf16* YE; const int* s2tk; const float* tokw;
    __device__ __forceinline__ void operator()(const Unit& u, int r, int c, const f32x4 a0, const f32x4 a1, const f32x4 b0, const f32x4 b1) const {
        const int tk = s2tk[u.pm * 256 + r]; if (tk < 0) return;
        const float w = tokw[tk] * (1.f / (F8_SH * F8_SW)); bf16* p = YE + (size_t)tk * D + u.pn * 256 + c; st8(p, a0 * w, a1 * w); st8(p + 128, b0 * w, b1 * w);
    }
};

struct Args { const float* in[32]; float* out; unsigned char* ws; int ph_lo, ph_hi; };
enum { I_X = 0, I_MEM, I_NORM1, I_WIN, I_RCW, I_RCB, I_WA, I_BA, I_WX, I_BX, I_LAM, I_WBA, I_DCW, I_ALOG, I_DTB, I_DNW, I_WBB, I_WOUT, I_NORM2, I_MEMNW, I_WCQ, I_WCKV, I_WCO,
       I_NORM3, I_WRG, I_BRG, I_WRE, I_BRE, I_WEG, I_WEU, I_WED, I_NORMF };

__device__ __forceinline__ void tr_item(const float* W, int ldw, int col0, bf16* WT, int ldt, int row0, int k0, float scale, LAS float* scr, int lane, const float* ksc = nullptr) {
#pragma unroll 8
    for (int i = 0; i < 32; ++i) { const int kk = 2 * i + (lane >> 5); scr[kk * 33 + (lane & 31)] = W[(size_t)(k0 + kk) * ldw + col0 + (lane & 31)] * (ksc ? scale * ksc[k0 + kk] : scale); }
    LDS_WAIT(); asm volatile("" ::: "memory");
    const int c = lane & 7;
#pragma unroll
    for (int j = 0; j < 4; ++j) { const int n = (lane >> 3) + 8 * j; const LAS float* s = scr + (8 * c) * 33 + n;
        u32x4 o; o.x = cvt_pk_bf16(s[0 * 33], s[1 * 33]); o.y = cvt_pk_bf16(s[2 * 33], s[3 * 33]); o.z = cvt_pk_bf16(s[4 * 33], s[5 * 33]); o.w = cvt_pk_bf16(s[6 * 33], s[7 * 33]);
        *(u32x4*)(WT + (size_t)(row0 + n) * ldt + k0 + 8 * c) = o; }
    LDS_WAIT(); asm volatile("" ::: "memory");
}
__device__ __forceinline__ void tr_item8(const float* W, int ldw, int col0, unsigned char* WT, int ldt, int row0, int k0, float scale, LAS float* scr, int lane, const float* ksc = nullptr) {
#pragma unroll 8
    for (int i = 0; i < 32; ++i) { const int kk = 2 * i + (lane >> 5); scr[kk * 33 + (lane & 31)] = W[(size_t)(k0 + kk) * ldw + col0 + (lane & 31)] * (ksc ? scale * ksc[k0 + kk] : scale); }
    LDS_WAIT(); asm volatile("" ::: "memory");
    const int c = lane & 7;
#pragma unroll
    for (int j = 0; j < 4; ++j) { const int n = (lane >> 3) + 8 * j; const LAS float* sp = scr + (8 * c) * 33 + n;
        u32x2 o; o.x = pk4_fp8(sp[0 * 33], sp[1 * 33], sp[2 * 33], sp[3 * 33]); o.y = pk4_fp8(sp[4 * 33], sp[5 * 33], sp[6 * 33], sp[7 * 33]);
        *(u32x2*)(WT + (size_t)(row0 + n) * ldt + k0 + 8 * c) = o; }
    LDS_WAIT(); asm volatile("" ::: "memory");
}
__device__ __forceinline__ void rms_row_to_bf16(const float* xrow, const float* w, bf16* orow, int lane, unsigned char* orow8 = nullptr) {
    const f32x4* xr = (const f32x4*)xrow + lane; const f32x4* wr_ = (const f32x4*)w + lane;
    f32x4 v[4]; float s = 0.f;
#pragma unroll
    for (int j = 0; j < 4; ++j) { v[j] = xr[64 * j]; s += (v[j][0] * v[j][0] + v[j][1] * v[j][1]) + (v[j][2] * v[j][2] + v[j][3] * v[j][3]); }
    const float rstd = 1.0f / sqrtf(wave_sum(s) * (1.f / D) + EPS);
    u32x2* o8 = (u32x2*)orow + lane;
#pragma unroll
    for (int j = 0; j < 4; ++j) { const f32x4 g = wr_[64 * j]; const f32x4 y = v[j] * rstd * g; u32x2 o; o.x = cvt_pk_bf16(y[0], y[1]); o.y = cvt_pk_bf16(y[2], y[3]); o8[64 * j] = o;
        if (orow8) ((unsigned*)orow8)[lane + 64 * j] = pk4_fp8(y[0] * F8_SA, y[1] * F8_SA, y[2] * F8_SA, y[3] * F8_SA); }
}
__device__ __forceinline__ void p0_prologue(const Args& a, LAS unsigned char* lds, int G, int tid, int wave, int lane) {
    unsigned char* ws = a.ws;
    LAS float* scr = (LAS float*)(lds + wave * 16384);
    const int gw = blockIdx.x * 8 + wave, NGW = G * 8;
    constexpr int I0 = 16 * 176, I1 = 512, I4 = 20 * 32, I5 = 512, I8 = 16 * 64, IE = 64 * 256, IRG = 2 * 10 * 8;
    constexpr int NITEMS = I0 + 3 * I1 + I4 + 4 * I5 + I8 + IRG;
    const float* w_in = a.in[I_WIN];
    for (int it = gw; it < NITEMS; it += NGW) {
        int r = it;
        if (r < I0) { tr_item(w_in, DIN, 32 * (r % 176), (bf16*)(ws + WS_B1A), D, 32 * (r % 176), 64 * (r / 176), 1.f, scr, lane); continue; } r -= I0;
        if (r < I1) { tr_item(w_in, DIN, 5632 + 32 * (r % 32), (bf16*)(ws + WS_B1B), D, 32 * (r % 32), 64 * (r / 32), 1.f, scr, lane); continue; } r -= I1;
        if (r < I1) { tr_item8(w_in, DIN, 6672 + 32 * (r % 32), ws + WS_B1B + 2 * MiB, D, 32 * (r % 32), 64 * (r / 32), F8_SW, scr, lane); continue; } r -= I1;
        if (r < I1) { tr_item8(w_in, DIN, 7696 + 32 * (r % 32), ws + WS_B1B + 2 * MiB, D, 1024 + 32 * (r % 32), 64 * (r / 32), F8_SW, scr, lane); continue; } r -= I1;
        if (r < I4) { tr_item(a.in[I_WBA], D, 32 * (r % 32), (bf16*)(ws + WS_WAT), DRNN, 32 * (r % 32), 64 * (r / 32), 1.f, scr, lane); continue; } r -= I4;
        if (r < I5) { tr_item(a.in[I_WBB], D, 32 * (r % 32), (bf16*)(ws + WS_WBT), D, 32 * (r % 32), 64 * (r / 32), 1.f, scr, lane); continue; } r -= I5;
        if (r < I5) { tr_item(a.in[I_WOUT], D, 32 * (r % 32), (bf16*)(ws + WS_WOT), D, 32 * (r % 32), 64 * (r / 32), 1.f, scr, lane); continue; } r -= I5;
        if (r < I5) { tr_item8(a.in[I_WCQ], D, 32 * (r % 32), ws + WS_WCQT, D, 32 * (r % 32), 64 * (r / 32), 0.0625f * F8_SQW, scr, lane, a.in[I_NORM2]); continue; } r -= I5;
        if (r < I5) { tr_item8(a.in[I_WCO], D, 32 * (r % 32), ws + WS_WCOT, D, 32 * (r % 32), 64 * (r / 32), F8_SW, scr, lane); continue; } r -= I5;
        if (r < I8) { tr_item(a.in[I_WCKV], 2 * D, 32 * (r % 64), (bf16*)(ws + WS_WKVT), D, 32 * (r % 64), 64 * (r / 64), 1.f, scr, lane); continue; } r -= I8;
        { const int mtx = r / 80, q = r % 80, blk = q >> 3, s = q & 7;
            tr_item(a.in[mtx ? I_WX : I_WA] + blk * 16384, 128, 32 * (s & 3), (bf16*)(ws + WS_RGW) + (size_t)mtx * 163840 + blk * 16384, 128, 32 * (s & 3), 64 * (s >> 2), 1.f, scr, lane); }
    }
    const int gt = blockIdx.x * 512 + tid, NGT = G * 512;
    { bf16* B1A = (bf16*)(ws + WS_B1A);
      for (int i = gt; i < 16 * 1024; i += NGT) { const int n = i >> 10, k = i & 1023; B1A[(size_t)(5632 + n) * D + k] = f2bf(w_in[(size_t)k * DIN + 6656 + n]); }
      for (int i = gt; i < 240 * 1024 / 8; i += NGT) *(u32x4*)(B1A + (size_t)5648 * D + (size_t)i * 8) = (u32x4){0u, 0u, 0u, 0u}; }
    { bf16* WH = (bf16*)(ws + WS_WRT); bf16* WL = WH + 80 * 1024;
      for (int i = gt; i < 80 * 1024; i += NGT) { const int n = i >> 10, k = i & 1023; float w = 0.f;
          if (n < 8) w = a.in[I_WRG][k * 8 + n]; else if (n < 72) w = a.in[I_WRE][k * 64 + (n - 8)];
          const bf16 h = f2bf(w); WH[i] = h; WL[i] = f2bf(w - bf2f(h)); } }
    { bf16* U = (bf16*)a.out;
      for (int m = gw; m < NTOK; m += NGW) rms_row_to_bf16(a.in[I_X] + (size_t)m * D, a.in[I_NORM1], U + (size_t)m * D, lane, (unsigned char*)a.out + 128 * MiB + (size_t)m * D);
      bf16* MN = (bf16*)(ws + WS_MEMN);
      for (int m = gw; m < NB * NMEM; m += NGW) rms_row_to_bf16(a.in[I_MEM] + (size_t)m * D, a.in[I_MEMNW], MN + (size_t)m * D, lane); }
}

__device__ __forceinline__ void expert_convert(const Args& a, LAS unsigned char* lds, int gw, int NGW, int wave, int lane) {
    unsigned char* ws = a.ws; LAS float* scr = (LAS float*)(lds + wave * 16384);
    constexpr int IE = 64 * 256;
    for (int it = gw; it < 3 * IE; it += NGW) {
        int r = it;
        if (r < IE) { const int e = r >> 8, q = r & 255, n0 = 32 * (q & 15);
            tr_item8(a.in[I_WEG] + (size_t)e * D * DEXP, DEXP, n0, ws + WS_WGU + (size_t)e * 1024 * 1024, D, (n0 >> 7) * 256 + (n0 & 127), 64 * (q >> 4), F8_SW, scr, lane); continue; } r -= IE;
        if (r < IE) { const int e = r >> 8, q = r & 255, n0 = 32 * (q & 15);
            tr_item8(a.in[I_WEU] + (size_t)e * D * DEXP, DEXP, n0, ws + WS_WGU + (size_t)e * 1024 * 1024, D, (n0 >> 7) * 256 + 128 + (n0 & 127), 64 * (q >> 4), F8_SW, scr, lane); continue; } r -= IE;
        { const int e = r >> 8, q = r & 255;
            tr_item8(a.in[I_WED] + (size_t)e * DEXP * D, D, 32 * (q & 31), ws + WS_WD + (size_t)e * 1024 * 512, DEXP, 32 * (q & 31), 64 * (q >> 5), F8_SW, scr, lane); }
    }
}

constexpr int R_XC = 0, R_A = 33792, R_XCB = 67584, R_RAW = 84992, R_RGB = 102144, R_SEG = 134912, R_HC = 139008;
__device__ __forceinline__ float neg_expm1_small(float x) {
    if (x < -0.25f) return 1.f - __expf(x);
    return -x * (1.f + x * 0.5f * (1.f + x * (1.f / 3.f) * (1.f + x * 0.25f * (1.f + x * 0.2f * (1.f + x * (1.f / 6.f))))));
}
__device__ __forceinline__ void rg_unit(const Args& a, LAS unsigned char* lds, int b, int blk, int tid_in, int wave, int lane_in, bool dry) {
    bf16* P1 = (bf16*)(a.ws + WS_P1);
    const int tid0 = tid_in, lane0 = lane_in;
    const int ch0 = blk * 128;
    LAS float* XC = (LAS float*)(lds + R_XC); LAS float* AA = (LAS float*)(lds + R_A);
    LAS bf16* XCB = (LAS bf16*)(lds + R_XCB); LAS bf16* RAW = (LAS bf16*)(lds + R_RAW); LAS bf16* RGB = (LAS bf16*)(lds + R_RGB);
    LAS float* SEG = (LAS float*)(lds + R_SEG); LAS float* HC = (LAS float*)(lds + R_HC);
    bf16x8 wfa[4], wfx[4];
    { const int lr = lane0 & 15, q4 = lane0 >> 4;
      const bf16* WAT = (const bf16*)(a.ws + WS_RGW) + (size_t)blk * 16384 + (size_t)(16 * wave + lr) * 128; const bf16* WXT = WAT + 163840;
#pragma unroll
      for (int s = 0; s < 4; ++s) { wfa[s] = *(const bf16x8*)(WAT + 32 * s + 8 * q4); wfx[s] = *(const bf16x8*)(WXT + 32 * s + 8 * q4); } }
    const int mych = ch0 + 16 * wave + (lane0 & 15);
    const float ba = a.in[I_BA][mych], bx = a.in[I_BX][mych];
    const float csp = 8.0f * softplusf_(-a.in[I_LAM][mych]);
    f32x4 cw[4], cb;
    { const int cq = tid0 & 31;
#pragma unroll
      for (int tap = 0; tap < 4; ++tap) cw[tap] = *(const f32x4*)(a.in[I_RCW] + tap * DRNN + ch0 + 4 * cq);
      cb = *(const f32x4*)(a.in[I_RCB] + ch0 + 4 * cq); }
    { const size_t row0 = (size_t)b * SEQ;
#pragma unroll
      for (int it = 0; it < 2; ++it) { const int idx = it * 512 + tid0, r = idx >> 4, pc = idx & 15;
          *(LAS u32x4*)(RAW + (3 + r) * 128 + pc * 8) = *(const u32x4*)(P1 + (row0 + r) * LDP + RXOFF + ch0 + pc * 8);
          *(LAS u32x4*)(RGB + r * 128 + pc * 8) = *(const u32x4*)(P1 + (row0 + r) * LDP + RGOFF + ch0 + pc * 8); }
      if (tid0 < 48) *(LAS u32x4*)(RAW + tid0 * 8) = (u32x4){0u, 0u, 0u, 0u};
      if (tid0 < 128) HC[tid0] = 0.f; }
    LBAR();
#pragma unroll 1
    for (int c = 0; c < SEQ / 64; ++c) {
        int tid = tid0; asm volatile("" : "+v"(tid));
        const int lane = tid & 63, lr = lane & 15, q4 = lane >> 4;
        const size_t row0 = (size_t)b * SEQ + (size_t)c * 64;
        const int par = c & 1;
        u32x4 pre[4];
        { const bool more = (c + 1 < SEQ / 64);
#pragma unroll
          for (int it = 0; it < 2; ++it) { const int idx = it * 512 + tid, r = idx >> 4, pc = idx & 15; const size_t rr = more ? row0 + 64 + r : row0 + r;
              pre[2 * it] = *(const u32x4*)(P1 + rr * LDP + RXOFF + ch0 + pc * 8); pre[2 * it + 1] = *(const u32x4*)(P1 + rr * LDP + RGOFF + ch0 + pc * 8); } }
        { const int cq = tid & 31, rgp = tid >> 5;
          f32x4 xr[7];
#pragma unroll
          for (int i = 0; i < 7; ++i) { const u32x2 w = *(const LAS u32x2*)(RAW + (4 * rgp + i) * 128 + 4 * cq); xr[i] = (f32x4){bflo(w.x), bfhi(w.x), bflo(w.y), bfhi(w.y)}; }
#pragma unroll
          for (int r = 0; r < 4; ++r) { f32x4 o = cb;
#pragma unroll
              for (int tap = 0; tap < 4; ++tap) o += cw[tap] * xr[r + tap];
              *(LAS f32x4*)(XC + (4 * rgp + r) * 132 + 4 * cq) = o;
              u32x2 pk; pk.x = cvt_pk_bf16(o[0], o[1]); pk.y = cvt_pk_bf16(o[2], o[3]); *(LAS u32x2*)(XCB + (4 * rgp + r) * 136 + 4 * cq) = pk; } }
        LBAR();
        if (tid < 48) *(LAS u32x4*)(RAW + tid * 8) = *(const LAS u32x4*)(RAW + 64 * 128 + tid * 8);
#pragma unroll
        for (int it = 0; it < 4; ++it) {
            f32x4 dr = {0.f, 0.f, 0.f, 0.f}, di = {0.f, 0.f, 0.f, 0.f};
#pragma unroll
            for (int s = 0; s < 4; ++s) { const bf16x8 xf = *(const LAS bf16x8*)(XCB + (16 * it + lr) * 136 + 32 * s + 8 * q4); dr = MFMA(xf, wfa[s], dr); di = MFMA(xf, wfx[s], di); }
#pragma unroll
            for (int j = 0; j < 4; ++j) { const int tok = 16 * it + 4 * q4 + j; const int o = tok * 132 + 16 * wave + lr;
                const float rr = sigmoidf_(dr[j] + ba), ii = sigmoidf_(di[j] + bx); const float la = -csp * rr; const float av = __expf(la);
                const float mult = __builtin_amdgcn_sqrtf(fmaxf(1.0f - av * av, 0.f)); const float xv = XC[o];
                AA[o] = av; XC[o] = mult * ii * xv; }
        }
        LBAR();
        const int sch = tid & 127, seg = tid >> 7;
        float hl[16], pa[16];
        { float h = 0.f, p = 1.f;
#pragma unroll
          for (int t = 0; t < 16; ++t) { const float av = AA[(16 * seg + t) * 132 + sch], bv = XC[(16 * seg + t) * 132 + sch]; h = av * h + bv; p *= av; hl[t] = h; pa[t] = p; }
          SEG[(seg * 128 + sch) * 2] = p; SEG[(seg * 128 + sch) * 2 + 1] = h; }
        LBAR();
        { float cin = HC[par * 128 + sch];
          for (int s = 0; s < seg; ++s) cin = SEG[(s * 128 + sch) * 2] * cin + SEG[(s * 128 + sch) * 2 + 1];
          bf16* op = P1 + (row0 + 16 * seg) * LDP + RXOFF + ch0 + sch; const LAS bf16* rgp_ = RGB + par * 8192 + (16 * seg) * 128 + sch;
          float hlast = 0.f;
#pragma unroll
          for (int t = 0; t < 16; ++t) { const float h = hl[t] + pa[t] * cin; hlast = h; const float g = bf2f(rgp_[t * 128]);
              if (!dry) op[(size_t)t * LDP] = f2bf(gelu_tanh(g) * h); }
          if (seg == 3) HC[(par ^ 1) * 128 + sch] = hlast; }
#pragma unroll
        for (int it = 0; it < 2; ++it) { const int idx = it * 512 + tid, r = idx >> 4, pc = idx & 15;
            *(LAS u32x4*)(RAW + (3 + r) * 128 + pc * 8) = pre[2 * it]; *(LAS u32x4*)(RGB + (par ^ 1) * 8192 + r * 128 + pc * 8) = pre[2 * it + 1]; }
        LBAR();
    }
}

#if DBG_STAGE == 3
#define CHK(stage, val) do { const float _v = (val); if (dbg_on && !(fabsf(_v) < 1e30f) && *DBGF == 0) *DBGF = (stage) + 16 * (c < 2 ? c : 2); } while (0)
#else
#define CHK(stage, val) do { } while (0)
#endif
constexpr int G_KN = 0, G_QS = 17408, G_VS = 34816, G_LM = 52224, G_TB = 71680, G_TBG = 80896, G_PM = 90112, G_VEC = 99328, G_GT = 103424, G_RAW = 107520;
__device__ __forceinline__ bf16x8 frag_nat(const LAS bf16* base, int stride, int row, int k) { return *(const LAS bf16x8*)(base + row * stride + k); }
__device__ __forceinline__ bf16x8 frag_perm(const LAS bf16* base, int stride, int row, int k0, int q4) {
    const bf16x4 x = *(const volatile LAS bf16x4*)(base + row * stride + k0 + 4 * q4); const bf16x4 y = *(const volatile LAS bf16x4*)(base + row * stride + k0 + 16 + 4 * q4);
    return (bf16x8){x[0], x[1], x[2], x[3], y[0], y[1], y[2], y[3]};
}
__device__ __forceinline__ bf16x4 tr4(const LAS bf16* p) { return __builtin_amdgcn_ds_read_tr16_b64_v4i16((LAS bf16x4*)p); }
__device__ __forceinline__ bf16x8 trfrag_nat(const LAS bf16* base, int stride, int j0, int ch0, int lr, int q4) {
    const LAS bf16* p = base + (j0 + 8 * q4 + (lr >> 2)) * stride + ch0 + 4 * (lr & 3); const bf16x4 x = tr4(p), y = tr4(p + 4 * stride);
    return (bf16x8){x[0], x[1], x[2], x[3], y[0], y[1], y[2], y[3]};
}
__device__ __forceinline__ bf16x8 trfrag_perm(const LAS bf16* base, int stride, int j0, int ch0, int lr, int q4) {
    const LAS bf16* p = base + (j0 + 4 * q4 + (lr >> 2)) * stride + ch0 + 4 * (lr & 3); const bf16x4 x = tr4(p), y = tr4(p + 16 * stride);
    return (bf16x8){x[0], x[1], x[2], x[3], y[0], y[1], y[2], y[3]};
}
__device__ __forceinline__ void gdn_unit(const Args& a, LAS unsigned char* lds, int b, int h, int tid_in, int wave, int lane_in, bool dry) {
    bf16* P1 = (bf16*)(a.ws + WS_P1);
    const float* gbuf = (const float*)(a.ws + WS_G); const float* betabuf = (const float*)(a.ws + WS_BETA);
    const int tid = tid_in;
    LAS bf16* KN = (LAS bf16*)(lds + G_KN); LAS bf16* TL = (LAS bf16*)(lds + G_LM); LAS float* LD = (LAS float*)(lds + G_LM + 9216); LAS bf16* WW = (LAS bf16*)(lds + G_LM);   LAS float* OST = (LAS float*)(lds + G_KN);
    LAS bf16* QS = (LAS bf16*)(lds + G_QS); LAS bf16* VS = (LAS bf16*)(lds + G_VS);
    LAS bf16* TB = (LAS bf16*)(lds + G_TB); LAS bf16* TBG = (LAS bf16*)(lds + G_TBG); LAS bf16* PM = (LAS bf16*)(lds + G_PM);
    LAS float* VEC = (LAS float*)(lds + G_VEC); LAS float* RK = VEC + 512; LAS float* RQ = VEC + 576; LAS float* DNW = VEC + 640;
    if (tid < 128) DNW[tid] = a.in[I_DNW][tid];
    LAS float* GT = (LAS float*)(lds + G_GT); LAS bf16* RAW = (LAS bf16*)(lds + G_RAW);
    for (int i = tid; i < 3 * 48; i += 512) *(LAS u32x4*)(RAW + i * 8) = (u32x4){0u, 0u, 0u, 0u};
#if DBG_STAGE == 3
    volatile LAS int* DBGF = (volatile LAS int*)(lds + 162100); const bool dbg_on = true; if (tid == 0) *DBGF = 0;
#endif
    f32x4 S[8];
#pragma unroll
    for (int t = 0; t < 8; ++t) S[t] = (f32x4){0.f, 0.f, 0.f, 0.f};
    f32x4 cw[3][4];
#pragma unroll
    for (int part = 0; part < 3; ++part)
#pragma unroll
        for (int tap = 0; tap < 4; ++tap) cw[part][tap] = *(const f32x4*)(a.in[I_DCW] + tap * 3072 + part * 1024 + h * 128 + 4 * (tid & 31)) * 1.4426950408889634f;
    const float neg_a = -__expf(a.in[I_ALOG][h]), dtb = a.in[I_DTB][h];
    { const size_t row0 = (size_t)b * SEQ;
#pragma unroll
      for (int it = 0; it < 6; ++it) { const int idx = it * 512 + tid, r = idx / 48, pc = idx % 48, part = pc >> 4, piece = pc & 15;
          *(LAS u32x4*)(RAW + (3 + r) * 384 + part * 128 + piece * 8) = *(const u32x4*)(P1 + (row0 + r) * LDP + QOFF + part * 1024 + h * 128 + piece * 8); }
      if (wave == 0) { const int lane = lane_in; float v = neg_a * softplusf_(gbuf[(row0 + lane) * 8 + h] + dtb);
#pragma unroll
          for (int o = 1; o < 64; o <<= 1) { const float t = __shfl_up(v, o); if (lane >= o) v += t; }
          const float gl = __shfl(v, 63);
          VEC[lane] = v; VEC[64 + lane] = sigmoidf_(betabuf[(row0 + lane) * 8 + h]); VEC[128 + lane] = __expf(v); VEC[192 + lane] = __expf(gl - v); }
      LBAR(); }
#pragma unroll 1
    for (int c = 0; c < SEQ / 64; ++c) {
        int tid = tid_in; asm volatile("" : "+v"(tid));
        const int lane = tid & 63, lr = lane & 15, q4 = lane >> 4;
        const int pr = tid >> 3, pp = tid & 7;
        const size_t row0 = (size_t)b * SEQ + (size_t)c * 64;
        LAS float* GC = VEC + 256 * (c & 1); LAS float* BETA = GC + 64; LAS float* EG = GC + 128; LAS float* EGL = GC + 192;
        float pre_g = 0.f, pre_b = 0.f;
        if (wave == 1) { const size_t rown = (c + 1 < SEQ / 64) ? row0 + 64 : row0; pre_g = gbuf[(rown + lane) * 8 + h]; pre_b = betabuf[(rown + lane) * 8 + h]; }
        { const int cq = tid & 31, rg = tid >> 5;
#pragma unroll
          for (int part = 0; part < 3; ++part) {
              f32x4 x[7];
#pragma unroll
              for (int t = 0; t < 7; ++t) { const u32x2 w = *(const LAS u32x2*)(RAW + (4 * rg + t) * 384 + part * 128 + 4 * cq); x[t] = (f32x4){bflo(w.x), bfhi(w.x), bflo(w.y), bfhi(w.y)}; }
              LAS bf16* dst = (part == 0 ? QS : part == 1 ? KN : VS) + (4 * rg) * 136 + 4 * cq;
#pragma unroll
              for (int r = 0; r < 4; ++r) { f32x4 acc = cw[part][0] * x[r];
#pragma unroll
                  for (int tap = 1; tap < 4; ++tap) acc += cw[part][tap] * x[r + tap];
#pragma unroll
                  for (int e = 0; e < 4; ++e) { CHK(2, acc[e]); acc[e] = acc[e] * __builtin_amdgcn_rcpf(1.0f + __builtin_amdgcn_exp2f(-acc[e])); }
                  *(LAS u32x2*)(dst + r * 136) = (u32x2){cvt_pk_bf16(acc[0], acc[1]), cvt_pk_bf16(acc[2], acc[3])}; } } }
        LBAR();
        for (int i = tid; i < 3 * 48; i += 512) *(LAS u32x4*)(RAW + i * 8) = *(const LAS u32x4*)(RAW + 64 * 384 + i * 8);
        f32x4 dkq[4];
#pragma unroll
        for (int i = 0; i < 4; ++i) { const int tt = wave * 4 + i, which = tt >> 4, it = (tt & 15) >> 2, jt = tt & 3;
            f32x4 d = {0.f, 0.f, 0.f, 0.f};
            if (it >= jt) {
                const LAS bf16* Am = which ? QS : KN;
#pragma unroll
                for (int s = 0; s < 4; ++s) d = MFMA(frag_nat(Am, 136, 16 * it + lr, 32 * s + 8 * q4), frag_nat(KN, 136, 16 * jt + lr, 32 * s + 8 * q4), d);
            }
            dkq[i] = d; CHK(4, d[0] + d[1] + d[2] + d[3]); }
        {
          const int it = wave & 3; f32x4 d;
          if (wave < 4) d = (it == 0) ? dkq[0] : (it == 1) ? dkq[1] : (it == 2) ? dkq[2] : dkq[3];
          else { d = (f32x4){0.f, 0.f, 0.f, 0.f};
#pragma unroll
              for (int s = 0; s < 4; ++s) { const bf16x8 f = frag_nat(QS, 136, 16 * it + lr, 32 * s + 8 * q4); d = MFMA(f, f, d); } }
          const int j = lr & 3; const float v = (j == 0) ? d[0] : (j == 1) ? d[1] : (j == 2) ? d[2] : d[3];
          if (q4 == (lr >> 2)) { const float r = __builtin_amdgcn_rsqf(v + EPS * 2.0813689810056077f); if (wave < 4) RK[16 * it + lr] = r; else RQ[16 * it + lr] = r * 0.08838834764831845f; } }
        LBAR();
        if (wave < 4) {
#pragma unroll
            for (int i = 0; i < 4; ++i) { const int it = wave, jt = i; const int jc = 16 * jt + lr; const float gj = GC[jc];
                const f32x4 gi = *(const LAS f32x4*)(GC + 16 * it + 4 * q4), bi = *(const LAS f32x4*)(BETA + 16 * it + 4 * q4) * *(const LAS f32x4*)(RK + 16 * it + 4 * q4) * RK[jc]; f32x4 lv;
#pragma unroll
                for (int j = 0; j < 4; ++j) { const int ii = 16 * it + 4 * q4 + j; lv[j] = (ii > jc) ? bi[j] * dkq[i][j] * __expf(fminf(gi[j] - gj, 0.f)) : 0.f; }
                if (i == wave) {
#pragma unroll
                    for (int j = 0; j < 4; ++j) LD[wave * 320 + (4 * q4 + j) * 20 + lr] = lv[j]; }
                else {
#pragma unroll
                    for (int j = 0; j < 4; ++j) TL[(16 * it + 4 * q4 + j) * 72 + jc] = f2bf(lv[j]); } } }
        LBAR();
        if (wave >= 4) {
#pragma unroll
            for (int i = 0; i < 4; ++i) { const int tt = wave * 4 + i, it = (tt & 15) >> 2, jt = tt & 3; const int jc = 16 * jt + lr; const float gj = GC[jc];
                const f32x4 rq = *(const LAS f32x4*)(RQ + 16 * it + 4 * q4) * RK[jc];
#pragma unroll
                for (int j = 0; j < 4; ++j) { const int ii = 16 * it + 4 * q4 + j; const float dec = __expf(fminf(GC[ii] - gj, 0.f));
                    PM[ii * 72 + jc] = f2bf((ii >= jc) ? dkq[i][j] * dec * rq[j] : 0.f); } } }
        u32x4 pre[6];
        { const size_t rown = (c + 1 < SEQ / 64) ? row0 + 64 : row0;
#pragma unroll
          for (int it = 0; it < 6; ++it) { const int r = tid >> 3, pc = (tid & 7) + 8 * it, part = pc >> 4, piece = pc & 15;
              pre[it] = *(const u32x4*)(P1 + (rown + r) * LDP + QOFF + part * 1024 + h * 128 + piece * 8); }
 }
        f32x4 O[4];
#define QS_BLOCK() do { bf16x8 sfq[4]; \
            _Pragma("unroll") for (int s = 0; s < 4; ++s) sfq[s] = pack8v(S[2 * s], S[2 * s + 1]); \
            _Pragma("unroll") for (int it = 0; it < 4; ++it) { f32x4 qs_ = {0.f, 0.f, 0.f, 0.f}; \
                _Pragma("unroll") for (int s = 0; s < 4; ++s) qs_ = MFMA(frag_perm(QS, 136, 16 * it + lr, 32 * s, q4), sfq[s], qs_); \
                const f32x4 sc = *(const LAS f32x4*)(EG + 16 * it + 4 * q4) * *(const LAS f32x4*)(RQ + 16 * it + 4 * q4); O[it] = qs_ * sc; } } while (0)
        if (wave == 1) { LAS float* GN = VEC + 256 * ((c + 1) & 1); float v = neg_a * softplusf_(pre_g + dtb);
#pragma unroll
            for (int o = 1; o < 64; o <<= 1) { const float t = __shfl_up(v, o); if (lane >= o) v += t; }
            const float gl = __shfl(v, 63);
            GN[lane] = v; GN[64 + lane] = sigmoidf_(pre_b); GN[128 + lane] = __expf(v); GN[192 + lane] = __expf(gl - v); }
        if (wave >= 1) QS_BLOCK();
        if (tid < 64) { const int d = tid >> 4, cc = tid & 15; float t[16];
#pragma unroll
            for (int i = 0; i < 16; ++i) { float s = 0.f;
#pragma unroll
                for (int q = 0; q < 4; ++q) if (4 * q < i) { const f32x4 l = *(const LAS f32x4*)(LD + d * 320 + i * 20 + 4 * q);
#pragma unroll
                    for (int e = 0; e < 4; ++e) if (4 * q + e < i) s += l[e] * t[4 * q + e]; }
                t[i] = (i > cc) ? -s : (i == cc ? 1.f : 0.f); }
#pragma unroll
            for (int i = 0; i < 16; ++i) TL[(16 * d + i) * 72 + 16 * d + cc] = f2bf(t[i]); }
        LBAR();
        if (wave == 0) QS_BLOCK();
        if (wave == 2 || wave == 3) { const int lo = 32 * (wave - 2), hi = lo + 16; const f32x4 z4 = {0.f, 0.f, 0.f, 0.f};
            bf16x8 a1 = frag_nat(TL, 72, hi + lr, lo + 8 * q4); if (q4 >= 2) a1 = (bf16x8){0, 0, 0, 0, 0, 0, 0, 0};
            const f32x4 x = MFMA(a1, trfrag_nat(TL, 72, lo, lo, lr, q4), z4);
            const bf16x4 a2l = *(const LAS bf16x4*)(TL + (hi + lr) * 72 + hi + 4 * q4);
            const bf16x8 a2 = {a2l[0], a2l[1], a2l[2], a2l[3], 0, 0, 0, 0};
            const u32x4 bw = {cvt_pk_bf16(x[0], x[1]), cvt_pk_bf16(x[2], x[3]), 0u, 0u};
            const f32x4 r = MFMA(a2, __builtin_bit_cast(bf16x8, bw), z4);
#pragma unroll
            for (int j = 0; j < 4; ++j) TL[(hi + 4 * q4 + j) * 72 + lo + lr] = f2bf(-r[j]); }
        LBAR();
#pragma unroll
        for (int it = 0; it < 6; ++it) { const int r = tid >> 3, pc = (tid & 7) + 8 * it, part = pc >> 4, piece = pc & 15;
            *(LAS u32x4*)(RAW + (3 + r) * 384 + part * 128 + piece * 8) = pre[it]; }
        if (wave >= 4) { const int I = (wave - 4) >> 1, J = (wave - 4) & 1; const f32x4 z4 = {0.f, 0.f, 0.f, 0.f};
            const bf16x8 bt = trfrag_nat(TL, 72, 0, 16 * J, lr, q4);
            const f32x4 y0 = MFMA(frag_nat(TL, 72, 32 + lr, 8 * q4), bt, z4), y1 = MFMA(frag_nat(TL, 72, 48 + lr, 8 * q4), bt, z4);
            const f32x4 r = MFMA(frag_perm(TL, 72, 32 + 16 * I + lr, 32, q4), pack8v(y0, y1), z4);
            const int col = 16 * J + lr; const float bc = BETA[col], ec = bc * (EG[col] * RK[col]);
#pragma unroll
            for (int j = 0; j < 4; ++j) { const int row = 32 + 16 * I + 4 * q4 + j; TB[row * 72 + col] = f2bf(-r[j] * bc); TBG[row * 72 + col] = f2bf(-r[j] * ec); } }
        else {
#pragma unroll
            for (int n = 0; n < 2; ++n) { const int task = tid + 256 * n, i = task >> 3, j0 = (task & 7) * 8;
                if (n == 0 || j0 >= 32) { float t[8]; unpack8(*(const LAS u32x4*)(TL + i * 72 + j0), t);
                    f32x4 b0, b1, e0, e1;
#pragma unroll
                    for (int j = 0; j < 4; ++j) { b0[j] = t[j] * BETA[j0 + j]; b1[j] = t[4 + j] * BETA[j0 + 4 + j]; e0[j] = b0[j] * (EG[j0 + j] * RK[j0 + j]); e1[j] = b1[j] * (EG[j0 + 4 + j] * RK[j0 + 4 + j]); }
                    *(LAS u32x4*)(TB + i * 72 + j0) = pack8(b0, b1); *(LAS u32x4*)(TBG + i * 72 + j0) = pack8(e0, e1); } } }
        LBAR();
        f32x4 U[4];
        bf16x8 kf[2], vtf[2];
#pragma unroll
        for (int s = 0; s < 2; ++s) { kf[s] = trfrag_nat(KN, 136, 32 * s, 16 * wave, lr, q4); vtf[s] = trfrag_nat(VS, 136, 32 * s, 16 * wave, lr, q4); }
#pragma unroll
        for (int it = 0; it < 4; ++it) { f32x4 d = {0.f, 0.f, 0.f, 0.f}, uu = {0.f, 0.f, 0.f, 0.f};
#pragma unroll
            for (int s = 0; s < 2; ++s) { d = MFMA(frag_nat(TBG, 72, 16 * it + lr, 32 * s + 8 * q4), kf[s], d);
                uu = MFMA(frag_nat(TB, 72, 16 * it + lr, 32 * s + 8 * q4), vtf[s], uu); }
            U[it] = uu; CHK(6, d[0] + d[1] + d[2] + d[3]); CHK(7, uu[0] + uu[1] + uu[2] + uu[3]);
#pragma unroll
            for (int j = 0; j < 4; ++j) WW[(16 * it + 4 * q4 + j) * 136 + 16 * wave + lr] = f2bf(d[j]); }
        LBAR();
        const u32x4 zs0 = *(const u32x4*)(h2row(a.ws, row0 + pr) + h * 128 + 16 * pp), zs1 = *(const u32x4*)(h2row(a.ws, row0 + pr) + h * 128 + 16 * pp + 8);
        bf16x8 sf[4];
#pragma unroll
        for (int s = 0; s < 4; ++s) sf[s] = pack8v(S[2 * s], S[2 * s + 1]);
        f32x4 Vn[4];
#pragma unroll
        for (int it = 0; it < 4; ++it) { f32x4 ws_ = {0.f, 0.f, 0.f, 0.f};
#pragma unroll
            for (int s = 0; s < 4; ++s) ws_ = MFMA(frag_perm(WW, 136, 16 * it + lr, 32 * s, q4), sf[s], ws_);
            Vn[it] = U[it] - ws_; CHK(8, ws_[0] + ws_[1] + ws_[2] + ws_[3]); }
        bf16x8 vf[2], vfs[2];
#pragma unroll
        for (int s = 0; s < 2; ++s) { vf[s] = pack8v(Vn[2 * s], Vn[2 * s + 1]); f32x4 x, y;
#pragma unroll
            for (int j = 0; j < 4; ++j) { x[j] = Vn[2 * s][j] * (EGL[32 * s + 4 * q4 + j] * RK[32 * s + 4 * q4 + j]); y[j] = Vn[2 * s + 1][j] * (EGL[32 * s + 16 + 4 * q4 + j] * RK[32 * s + 16 + 4 * q4 + j]); }
            vfs[s] = pack8v(x, y); }
#pragma unroll
        for (int it = 0; it < 4; ++it)
#pragma unroll
            for (int s = 0; s < 2; ++s) O[it] = MFMA(frag_perm(PM, 72, 16 * it + lr, 32 * s, q4), vf[s], O[it]);
#pragma unroll
        for (int it = 0; it < 4; ++it) CHK(10, O[it][0] + O[it][1] + O[it][2] + O[it][3]);
        { const float gl = EG[63];
#pragma unroll
          for (int t = 0; t < 8; ++t) { f32x4 d = S[t] * gl;
#pragma unroll
              for (int s = 0; s < 2; ++s) d = MFMA(trfrag_perm(KN, 136, 32 * s, 16 * t, lr, q4), vfs[s], d);
              S[t] = d; CHK(11, d[0] + d[1] + d[2] + d[3]); } }
        LBAR();
#pragma unroll
        for (int it = 0; it < 4; ++it)
#pragma unroll
            for (int j = 0; j < 4; ++j) OST[(16 * it + 4 * q4 + j) * 132 + 16 * wave + lr] = O[it][j];
        LBAR();
        { float o[16]; float ss = 0.f;
#pragma unroll
          for (int j = 0; j < 4; ++j) { const f32x4 t = *(const LAS f32x4*)(OST + pr * 132 + 16 * pp + 4 * j); o[4 * j] = t[0]; o[4 * j + 1] = t[1]; o[4 * j + 2] = t[2]; o[4 * j + 3] = t[3]; ss += (t[0] * t[0] + t[1] * t[1]) + (t[2] * t[2] + t[3] * t[3]); }
          ss += __shfl_xor(ss, 1); ss += __shfl_xor(ss, 2); ss += __shfl_xor(ss, 4);
          const float rstd = __builtin_amdgcn_rsqf(ss * (1.f / HD) + EPS * 2.0813689810056077f); CHK(12, ss); CHK(13, rstd);
          const LAS f32x4* wp = (const LAS f32x4*)(DNW + 16 * pp);
#pragma unroll
          for (int j = 0; j < 4; ++j) { const f32x4 t = wp[j]; o[4 * j] *= rstd * t[0]; o[4 * j + 1] *= rstd * t[1]; o[4 * j + 2] *= rstd * t[2]; o[4 * j + 3] *= rstd * t[3]; }
          { float z[16]; unpack8(zs0, z); unpack8(zs1, z + 8);
#pragma unroll
            for (int j = 0; j < 16; ++j) o[j] *= z[j]; }
          bf16* dst = P1 + (row0 + pr) * LDP + VOFF + h * 128 + 16 * pp;
          if (!dry) { *(u32x4*)dst = pack8((f32x4){o[0], o[1], o[2], o[3]}, (f32x4){o[4], o[5], o[6], o[7]});
          *(u32x4*)(dst + 8) = pack8((f32x4){o[8], o[9], o[10], o[11]}, (f32x4){o[12], o[13], o[14], o[15]}); } }
        LBAR();
    }
#if DBG_STAGE == 3

#endif
}

__device__ __forceinline__ void attn_unit(const Args& a, LAS unsigned char* lds, int b, int hh, int rb, int tid, int wave, int lane) {
    const bf16* QC = (const bf16*)(a.ws + WS_P1) + RGOFF; const bf16* Kc = (const bf16*)(a.ws + WS_KV); const bf16* VTg = (const bf16*)(a.ws + WS_VT); unsigned char* AO8 = a.ws + WS_P1 + 2 * KOFF;
    LAS bf16* KS = (LAS bf16*)lds;
    const int lr = lane & 15, q4 = lane >> 4;
    const size_t qrow0 = (size_t)b * SEQ + (size_t)rb * 256 + 32 * wave + lr;
#pragma unroll
    for (int it = 0; it < 16; ++it) { const int idx = it * 512 + tid, key = idx >> 5, pc = idx & 31;
        *(LAS u32x4*)(KS + key * 264 + pc * 8) = *(const u32x4*)(Kc + ((size_t)b * 256 + key) * 2048 + hh * 256 + pc * 8); }
    bf16x8 qf[2][8];
#pragma unroll
    for (int t = 0; t < 2; ++t)
#pragma unroll
        for (int s = 0; s < 8; ++s) qf[t][s] = *(const bf16x8*)(QC + (qrow0 + 16 * t) * LDP + hh * 256 + 64 * (s >> 1) + 16 * q4 + 8 * (s & 1));
    __syncthreads();
    bf16x8 pf[2][8]; float sum0 = 0.f, sum1 = 0.f;
#pragma unroll
    for (int s2 = 0; s2 < 8; ++s2) { f32x4 e[2][2];
#pragma unroll
        for (int hk = 0; hk < 2; ++hk) { const int kt = 2 * s2 + hk; f32x4 d0 = {0.f, 0.f, 0.f, 0.f}, d1 = {0.f, 0.f, 0.f, 0.f};
#pragma unroll
            for (int s = 0; s < 8; ++s) { const bf16x8 kf = frag_nat(KS, 264, 16 * kt + lr, 64 * (s >> 1) + 16 * q4 + 8 * (s & 1)); d0 = MFMA(kf, qf[0][s], d0); d1 = MFMA(kf, qf[1][s], d1); }
#pragma unroll
            for (int j = 0; j < 4; ++j) { const float e0 = __builtin_amdgcn_exp2f(__builtin_amdgcn_fmed3f(d0[j] * 1.4426950408889634f, -126.f, 115.f)), e1 = __builtin_amdgcn_exp2f(__builtin_amdgcn_fmed3f(d1[j] * 1.4426950408889634f, -126.f, 115.f)); e[0][hk][j] = e0; e[1][hk][j] = e1; sum0 += e0; sum1 += e1; } }
        pf[0][s2] = pack8v(e[0][0], e[0][1]); pf[1][s2] = pack8v(e[1][0], e[1][1]);
        __builtin_amdgcn_sched_barrier(0); }
    sum0 += __shfl_xor(sum0, 16); sum0 += __shfl_xor(sum0, 32); sum1 += __shfl_xor(sum1, 16); sum1 += __shfl_xor(sum1, 32);
    const float inv0 = __builtin_amdgcn_rcpf(sum0), inv1 = __builtin_amdgcn_rcpf(sum1);
    __syncthreads();
#pragma unroll
    for (int it = 0; it < 16; ++it) { const int idx = it * 512 + tid, dv = idx >> 5, pc = idx & 31;
        *(LAS u32x4*)(KS + dv * 264 + pc * 8) = *(const u32x4*)(VTg + ((size_t)(b * 4 + hh) * 256 + dv) * 256 + pc * 8); }
    __syncthreads();
#pragma unroll 4
    for (int dt = 0; dt < 16; ++dt) { f32x4 d0 = {0.f, 0.f, 0.f, 0.f}, d1 = {0.f, 0.f, 0.f, 0.f};
#pragma unroll
        for (int s = 0; s < 8; ++s) { const bf16x8 vf = frag_perm(KS, 264, 16 * dt + lr, 32 * s, q4); d0 = MFMA(vf, pf[0][s], d0); d1 = MFMA(vf, pf[1][s], d1); }
        d0 *= inv0; d1 *= inv1;
        d0 *= F8_SAO; d1 *= F8_SAO;
        *(unsigned*)(AO8 + qrow0 * LDP8 + hh * 256 + 16 * dt + 4 * q4) = pk4_fp8(d0[0], d0[1], d0[2], d0[3]);
        *(unsigned*)(AO8 + (qrow0 + 16) * LDP8 + hh * 256 + 16 * dt + 4 * q4) = pk4_fp8(d1[0], d1[1], d1[2], d1[3]);
        __builtin_amdgcn_sched_barrier(0); }
    __syncthreads();
}

constexpr int RT_LG = 0, RT_CNT = 49152, RT_WH = 53248, RT_WL = 95488;
__device__ __forceinline__ void router_iter(const Args& a, LAS unsigned char* lds, int row0, bool live, int tid, int wave, int lane, unsigned* cnt) {
    const float* w3 = a.in[I_NORM3];
    const bf16* WH = (const bf16*)(a.ws + WS_WRT); const bf16* WL = WH + 80 * 1024;
    float* rstd3 = (float*)(a.ws + WS_RSTD3); int* toke = (int*)(a.ws + WS_TOKE); float* tokw = (float*)(a.ws + WS_TOKW); int* tokp = (int*)(a.ws + WS_TOKP);
    LAS float* LG = (LAS float*)(lds + RT_LG + wave * 6144); LAS int* LCNT = (LAS int*)(lds + RT_CNT); LAS int* LBASE = LCNT + 64;
    LAS bf16* WHs = (LAS bf16*)(lds + RT_WH); LAS bf16* WLs = (LAS bf16*)(lds + RT_WL);
    const int lr = lane & 15, q4 = lane >> 4;
    const bf16* hp = h2row(a.ws, (size_t)((live ? row0 : 0) + lr)) + 8 * q4;
    if (tid < 64) LCNT[tid] = 0;
    float ss = 0.f;
#pragma unroll 8
    for (int kb = 0; kb < 32; ++kb) { float xf[8]; unpack8(*(const u32x4*)(hp + 32 * kb), xf); const f32x4 x0 = {xf[0], xf[1], xf[2], xf[3]}, x1 = {xf[4], xf[5], xf[6], xf[7]};
        ss += (x0[0] * x0[0] + x0[1] * x0[1]) + (x0[2] * x0[2] + x0[3] * x0[3]) + (x1[0] * x1[0] + x1[1] * x1[1]) + (x1[2] * x1[2] + x1[3] * x1[3]); }
    ss += __shfl_xor(ss, 16); ss += __shfl_xor(ss, 32);
    const float rstd = 1.0f / sqrtf(ss * (1.f / D) + EPS);
    if (live && q4 == 0) rstd3[row0 + lr] = rstd;
    f32x4 acc[5];
#pragma unroll
    for (int ct = 0; ct < 5; ++ct) acc[ct] = (f32x4){0.f, 0.f, 0.f, 0.f};
#pragma unroll 1
    for (int kq = 0; kq < 4; ++kq) {
        __syncthreads();
#pragma unroll
        for (int i = 0; i < 10; ++i) { const int idx = i * 512 + tid, arr = idx / 2560, rem = idx % 2560, row = rem >> 5, pc = rem & 31;
            *(LAS u32x4*)((arr ? WLs : WHs) + row * 264 + pc * 8) = *(const u32x4*)((arr ? WL : WH) + row * 1024 + kq * 256 + pc * 8); }
        __syncthreads();
#pragma unroll 2
        for (int kb2 = 0; kb2 < 8; ++kb2) { const int kb = kq * 8 + kb2;
            float xf[8]; unpack8(*(const u32x4*)(hp + 32 * kb), xf); const f32x4 x0 = {xf[0], xf[1], xf[2], xf[3]}, x1 = {xf[4], xf[5], xf[6], xf[7]};
            const f32x4 g0 = *(const f32x4*)(w3 + 32 * kb + 8 * q4), g1 = *(const f32x4*)(w3 + 32 * kb + 8 * q4 + 4);
            const f32x4 u0 = x0 * rstd * g0, u1 = x1 * rstd * g1;
            const u32x4 hi = pack8(u0, u1); float hf[8]; unpack8(hi, hf);
            const f32x4 l0 = {u0[0] - hf[0], u0[1] - hf[1], u0[2] - hf[2], u0[3] - hf[3]}, l1 = {u1[0] - hf[4], u1[1] - hf[5], u1[2] - hf[6], u1[3] - hf[7]};
            const bf16x8 ah = __builtin_bit_cast(bf16x8, hi), al = pack8v(l0, l1);
#pragma unroll
            for (int ct = 0; ct < 5; ++ct) { const bf16x8 bh = frag_nat(WHs, 264, 16 * ct + lr, 32 * kb2 + 8 * q4), bl = frag_nat(WLs, 264, 16 * ct + lr, 32 * kb2 + 8 * q4);
                acc[ct] = MFMA(ah, bh, acc[ct]); acc[ct] = MFMA(ah, bl, acc[ct]); acc[ct] = MFMA(al, bh, acc[ct]); }
        }
    }
#pragma unroll
    for (int ct = 0; ct < 5; ++ct)
#pragma unroll
        for (int j = 0; j < 4; ++j) LG[(4 * q4 + j) * 81 + 16 * ct + lr] = acc[ct][j];
    LDS_WAIT(); asm volatile("" ::: "memory");
    int e0 = 0, e1 = 0, k0 = 0, k1 = 0;
    if (live && lane < 16) {
        const LAS float* lg = LG + lane * 81; const float* bg = a.in[I_BRG]; const float* be = a.in[I_BRE];
        float gl[8]; int grp = 0; float gm = -3.0e38f;
#pragma unroll
        for (int j = 0; j < 8; ++j) { gl[j] = lg[j] + bg[j]; if (gl[j] > gm) { gm = gl[j]; grp = j; } }
        float gs = 0.f;
#pragma unroll
        for (int j = 0; j < 8; ++j) gs += __expf(gl[j] - gm);
        const float pg = 1.0f / gs;
        float el[8]; float m1 = -3.0e38f, m2 = -3.0e38f; int i1 = 0, i2 = 0;
#pragma unroll
        for (int j = 0; j < 8; ++j) { el[j] = lg[8 + grp * 8 + j] + be[grp * 8 + j];
            if (el[j] > m1) { m2 = m1; i2 = i1; m1 = el[j]; i1 = j; } else if (el[j] > m2) { m2 = el[j]; i2 = j; } }
        const float e2 = __expf(m2 - m1); const float t1 = 1.0f / (1.0f + e2), t2 = e2 / (1.0f + e2);
        const int tok = row0 + lane;
        e0 = grp * 8 + i1; e1 = grp * 8 + i2;
        toke[2 * tok] = e0; toke[2 * tok + 1] = e1; tokw[2 * tok] = pg * t1; tokw[2 * tok + 1] = pg * t2;
        k0 = atomicAdd((int*)(LCNT + e0), 1); k1 = atomicAdd((int*)(LCNT + e1), 1);
    }
    __syncthreads();
    if (tid < 64) { const int c = LCNT[tid]; LBASE[tid] = c ? (int)atomicAdd(cnt + tid, (unsigned)c) : 0; }
    __syncthreads();
    if (live && lane < 16) { const int tok = row0 + lane; tokp[2 * tok] = LBASE[e0] + k0; tokp[2 * tok + 1] = LBASE[e1] + k1; }
}

__device__ __forceinline__ int build_moe_tables(const Args& a, LAS unsigned char* lds, int tid) {
    LAS int* OFF = (LAS int*)(lds + LDS_T2E + 1024); LAS unsigned char* T2E = lds + LDS_T2E;
    const unsigned* cnt = (const unsigned*)(a.ws + WS_CTL) + CW_CNT;
    if (tid < 64) {
        const int nt = ((int)cnt[tid] + 255) >> 8; int v = nt;
#pragma unroll
        for (int o = 1; o < 64; o <<= 1) { const int t = __shfl_up(v, o); if (tid >= o) v += t; }
        const int start = v - nt;
        OFF[tid] = start << 8; if (tid == 63) OFF[NEXP] = v << 8;
        for (int t = 0; t < nt; ++t) T2E[start + t] = (unsigned char)tid;
    }
    __syncthreads();
    return OFF[NEXP] >> 8;
}

__global__ void __launch_bounds__(512, 2) fwd(Args a) {
    extern __shared__ __attribute__((aligned(16))) unsigned char lds_raw[];
    LAS unsigned char* lds = (LAS unsigned char*)lds_raw;
    const int tid = threadIdx.x, lane = tid & 63, wave = __builtin_amdgcn_readfirstlane(tid >> 6);
    const int G = gridDim.x;
    unsigned char* ws = a.ws;
    volatile LAS unsigned* MISC = (volatile LAS unsigned*)(lds + LDS_MISC);
    if (tid < 16) MISC[tid] = 0u;
    __syncthreads();
    unsigned* ctl = (unsigned*)(ws + WS_CTL);
    XcdBarrier bar; bar.bar = ctl + CW_BAR; bar.x = 0; bar.st = MISC;
    if (MK_N_LAUNCHES == 1) bar = xcd_barrier_post(ctl + CW_BAR, MISC);
    const int lo = a.ph_lo, hi = a.ph_hi;
#if DBG_STAGE == 5
    if (blockIdx.x == 0 && tid == 0) ((unsigned long long*)(ctl + 64))[0] = wall_clock64();
#endif
#ifndef PH_MASK
#define PH_MASK 0x7fff
#endif
#define IN(k) (((PH_MASK >> (k)) & 1) && lo <= (k) && (k) < hi)
#if DBG_STAGE == 5
#define SEAM(k) do { if (IN(k) && IN((k) + 1)) xcd_barrier(bar); if (blockIdx.x == 0 && tid == 0) ((unsigned long long*)(ctl + 64))[(k) + 1] = wall_clock64(); } while (0)
#else
#define SEAM(k) do { if (IN(k) && IN((k) + 1)) xcd_barrier(bar); } while (0)
#endif
    bf16* P1 = (bf16*)(ws + WS_P1);
    const pg8::Gemm g1024{D, D, D};

    if (IN(0)) REPEAT(0) { p0_prologue(a, lds, G, tid, wave, lane); REPSYNC(0); } SEAM(0);
    if (IN(1)) REPEAT(1) {
#ifndef NO_G1A
        { pg8::DenseOrder2 S; S.init(NTOK / 256, N1A / 256 + 4, G, blockIdx.x, a.out, D, ws + WS_B1A, D); S.B2 = (const char*)(ws + WS_B1B); S.nsplit = N1A / 256;
          pg8::EpiPerm<F1a> E{{P1, (float*)(ws + WS_G), (float*)(ws + WS_BETA), ws}};
          pg8::gemm_phase(lds, g1024, S, E); }
#endif
        REPSYNC(1);
    } SEAM(1);
    if (IN(2)) {
        const int blk = blockIdx.x; const bool wide = (G >= 256); const bool dry = false;
        { const int first = wide ? (blk < 128 ? blk : 128) : blk, step = wide ? 128 : G;
          for (int u = first; u < 128; u += step) { gdn_unit(a, lds, u >> 3, u & 7, tid, wave, lane, dry); __syncthreads(); } }
        { const int first = wide ? ((blk >= 128 && blk < 256) ? blk - 128 : 160) : blk, step = wide ? 128 : G;
          for (int u = first; u < 160; u += step) { rg_unit(a, lds, u / 10, u % 10, tid, wave, lane, dry); __syncthreads(); } }
        const int Gp = wide ? G - 128 : G, cp = wide ? blk - 128 : blk;
        if (!wide || blk >= 128) {
            pg8::DenseOrder S; S.init(NB * NMEM / 256, 2 * D / 256, Gp, cp, ws + WS_MEMN, D, ws + WS_WKVT, D);
            pg8::EpiPerm<FBf> E{{(bf16*)(ws + WS_KV), 2 * D}};
            pg8::gemm_phase(lds, g1024, S, E); }
        {
          constexpr int GATE_A = 18, GATE_B = 10, GATE_G = 0; static_assert(96 * GATE_A + 32 * GATE_B + 128 * GATE_G == 2048, "gate GEMM split");
          pg8::RangeOrder S; S.init(NTOK / 256, 2 * D / 256, 1, 0, (unsigned char*)a.out + 128 * MiB, D, ws + WS_B1B + 2 * MiB, D, 1);
          if (wide) { S.start = blk >= 160 ? GATE_A * (blk - 160) : blk >= 128 ? 96 * GATE_A + GATE_B * (blk - 128) : 96 * GATE_A + 32 * GATE_B + GATE_G * blk; S.count = blk >= 160 ? GATE_A : blk >= 128 ? GATE_B : GATE_G; }
          else { const int per = (2048 + G - 1) / G; S.start = blk * per; S.count = per; }
          pg8::EpiPerm<FGate> E{{(unsigned char*)a.out}};
          pg8::gemm_phase<pg8::EpiPerm<FGate>, pg8::RangeOrder, true>(lds, g1024, S, E); }
        __syncthreads();
        if (!wide) expert_convert(a, lds, cp * 8 + wave, Gp * 8, wave, lane);
        else if (blk >= 160) expert_convert(a, lds, (blk - 160) * 8 + wave, 96 * 8, wave, lane);
#if DBG_STAGE == 5
        if (tid == 0) ((unsigned long long*)(ctl + 1024))[blockIdx.x] = wall_clock64();
#endif
    } SEAM(2);
    if (IN(3)) {
        {
          const bf16* KV = (const bf16*)(ws + WS_KV); bf16* VT = (bf16*)(ws + WS_VT); LAS bf16* T = (LAS bf16*)(lds + wave * 9216);
          for (int it = blockIdx.x * 8 + wave; it < NB * CAH * 16; it += G * 8) { const int bh = it >> 4, kb = (it >> 2) & 3, db = it & 3, b_ = bh >> 2, h_ = bh & 3;
              const bf16* src = KV + ((size_t)b_ * 256 + 64 * kb + lane) * 2048 + 1024 + h_ * 256 + 64 * db;
#pragma unroll
              for (int q = 0; q < 8; ++q) { const u32x4 w = *(const u32x4*)(src + 8 * q); const unsigned ww[4] = {w.x, w.y, w.z, w.w};
#pragma unroll
                  for (int j = 0; j < 4; ++j) { T[(8 * q + 2 * j) * 72 + lane] = (bf16)(ww[j] & 0xffffu); T[(8 * q + 2 * j + 1) * 72 + lane] = (bf16)(ww[j] >> 16); } }
              LDS_WAIT(); asm volatile("" ::: "memory");
              bf16* dst = VT + ((size_t)bh * 256 + 64 * db + lane) * 256 + 64 * kb;
#pragma unroll
              for (int q = 0; q < 8; ++q) *(u32x4*)(dst + 8 * q) = *(const LAS u32x4*)(T + lane * 72 + 8 * q);
              LDS_WAIT(); asm volatile("" ::: "memory"); }
          __syncthreads(); }
    }
    if (IN(4)) {
        { pg8::DenseOrder S; S.init(NTOK / 256, D / 256, G, blockIdx.x, P1 + RXOFF, LDP, ws + WS_WAT, DRNN);
          pg8::EpiPerm2<F2a> E{{P1, (const unsigned char*)a.out}}; pg8::gemm_phase(lds, pg8::Gemm{LDP, DRNN, DRNN}, S, E); }
        { pg8::DenseOrder S; S.init(NTOK / 256, D / 256, G, blockIdx.x, P1 + VOFF, LDP, ws + WS_WBT, D);
          pg8::EpiPerm2<F2b> E{{P1, (const unsigned char*)a.out}}; pg8::gemm_phase(lds, pg8::Gemm{LDP, D, D}, S, E); }
    } SEAM(4);
    if (IN(5)) {
        pg8::DenseOrder S; S.init(NTOK / 256, D / 256, G, blockIdx.x, P1 + QOFF, LDP, ws + WS_WOT, D);
        EpiH1 E{a.in[I_X], (bf16*)a.out, D, (float*)(ws + WS_SSQ), ws + WS_P1}; pg8::gemm_phase(lds, pg8::Gemm{LDP, D, D}, S, E);
    } SEAM(5);
    if (IN(7)) {
        pg8::DenseOrder S; S.init(NTOK / 256, D / 256, G, blockIdx.x, ws + WS_P1, LDP8, ws + WS_WCQT, D, 1);
        pg8::EpiPerm2<FQc> E{{P1 + RGOFF, (const float*)(ws + WS_SSQ)}}; pg8::gemm_phase<pg8::EpiPerm2<FQc>, pg8::DenseOrder, true>(lds, pg8::Gemm{LDP8, D, D}, S, E);
    } SEAM(7);
    if (IN(8)) REPEAT(8) {
        constexpr int NU = NB * CAH * 16; const int per = (NU + G - 1) / G;
        for (int i = 0; i < per; ++i) { const int id = blockIdx.x * per + i; if (id < NU) attn_unit(a, lds, id >> 6, (id >> 4) & 3, id & 15, tid, wave, lane); }
        REPSYNC(8);
    } SEAM(8);
    if (IN(9)) {
        pg8::DenseOrder S; S.init(NTOK / 256, D / 256, G, blockIdx.x, ws + WS_P1 + 2 * KOFF, LDP8, ws + WS_WCOT, D, 1);
        EpiH2 E{(const bf16*)a.out, ws}; pg8::gemm_phase<EpiH2, pg8::DenseOrder, true>(lds, pg8::Gemm{LDP8, D, D}, S, E);
    } SEAM(9);
    if (IN(10)) {
        unsigned* cnt = ctl + CW_CNT;
        const int niter = (NTOK + G * 128 - 1) / (G * 128);
        for (int it = 0; it < niter; ++it) { const int r0 = (blockIdx.x * 8 + wave) * 16 + it * G * 128; router_iter(a, lds, r0, r0 < NTOK, tid, wave, lane, cnt); __syncthreads(); }
    } SEAM(10);
    if (IN(11)) {
        build_moe_tables(a, lds, tid);
        const LAS int* OFF = (const LAS int*)(lds + LDS_T2E + 1024);
        const int* toke = (const int*)(ws + WS_TOKE); const int* tokp = (const int*)(ws + WS_TOKP); int* s2tk = (int*)(ws + WS_S2TK);
        const float* rstd3 = (const float*)(ws + WS_RSTD3); unsigned char* XS = ws + WS_XS;
        for (int m = blockIdx.x * 8 + wave; m < NTOK; m += G * 8) {
            int s0 = 0, s1 = 0;
            if (lane == 0) { s0 = OFF[toke[2 * m]] + tokp[2 * m]; s1 = OFF[toke[2 * m + 1]] + tokp[2 * m + 1]; s2tk[s0] = 2 * m; s2tk[s1] = 2 * m + 1; }
            s0 = __shfl(s0, 0); s1 = __shfl(s1, 0);
            const float rstd = rstd3[m]; const u32x2* xr = (const u32x2*)h2row(ws, (size_t)m) + lane; const f32x4* wr_ = (const f32x4*)a.in[I_NORM3] + lane;
            unsigned* o0 = (unsigned*)(XS + (size_t)s0 * D) + lane; unsigned* o1 = (unsigned*)(XS + (size_t)s1 * D) + lane;
#pragma unroll
            for (int j = 0; j < 4; ++j) { const u32x2 hw = xr[64 * j]; const f32x4 v = (f32x4){bflo(hw.x), bfhi(hw.x), bflo(hw.y), bfhi(hw.y)} * (rstd * F8_SA) * wr_[64 * j]; const unsigned o = pk4_fp8(v[0], v[1], v[2], v[3]); o0[64 * j] = o; o1[64 * j] = o; }
        }
    } SEAM(11);
    if (IN(12)) {
        const int nT = build_moe_tables(a, lds, tid);
        pg8::MoeOrder S; S.init(nT, 4, G, blockIdx.x, ws + WS_XS, D, ws + WS_WGU, D, 1); S.t2e = lds + LDS_T2E; S.ebytes = (size_t)1024 * 1024;
        pg8::EpiPerm<FM1> E{{ws + WS_HID}}; pg8::gemm_phase<pg8::EpiPerm<FM1>, pg8::MoeOrder, true>(lds, g1024, S, E);
    } SEAM(12);
#if DBG_STAGE == 3
    if (IN(13)) {
        unsigned flags = 0;
        for (size_t m = blockIdx.x * 8 + wave; m < (size_t)NTOK; m += G * 8) { const bf16* rowp = P1 + m * LDP;
            for (int cidx = lane; cidx < LDP; cidx += 64) { const unsigned v = rowp[cidx]; if ((v & 0x7f80u) == 0x7f80u) flags |= (cidx < 1280 ? 1u : cidx < 2560 ? 8u : cidx < 4608 ? 4u : 2u); } }
        for (size_t i = (size_t)blockIdx.x * 512 + tid; i < (size_t)NTOK * D; i += (size_t)G * 512) { const float v = a.out[i]; if (!(fabsf(v) < 1e30f)) flags |= 16u; else if (fabsf(v) > 100.f) flags |= 32u; }
        if (flags) atomicOr((unsigned*)(ws + WS_CTL) + 16, flags);
    }
    if (0) {
#else
    if (IN(13)) {
#endif
        const int nT = build_moe_tables(a, lds, tid);
        pg8::MoeOrder S; S.init(nT, 4, G, blockIdx.x, ws + WS_HID, DEXP, ws + WS_WD, DEXP, 1); S.t2e = lds + LDS_T2E; S.ebytes = (size_t)1024 * 512;
        pg8::EpiPerm<FM2> E{{(bf16*)(ws + WS_YE), (const int*)(ws + WS_S2TK), (const float*)(ws + WS_TOKW)}}; pg8::gemm_phase<pg8::EpiPerm<FM2>, pg8::MoeOrder, true>(lds, pg8::Gemm{DEXP, DEXP, DEXP}, S, E);
    } SEAM(13);
    if (IN(14)) {
        const bf16* YE = (const bf16*)(ws + WS_YE);
#if DBG_STAGE == 6
        {
          typedef int v8i_ __attribute__((ext_vector_type(8)));
          f32x4 d1 = {0.f, 0.f, 0.f, 0.f}, d2 = {0.f, 0.f, 0.f, 0.f};
          { v8i_ A, B; float two = 2.f, onehalf = 1.5f; asm volatile("" : "+v"(two), "+v"(onehalf));
            const int pa = (int)pk4_fp8(two, two, two, two), pb = (int)pk4_fp8(onehalf, onehalf, onehalf, onehalf);
#pragma unroll
            for (int q = 0; q < 8; ++q) { A[q] = pa; B[q] = pb; }
            d1 = __builtin_amdgcn_mfma_scale_f32_16x16x128_f8f6f4(A, B, d1, 0, 0, 0, 0, 0, 0); }
          for (int g0 = 0; g0 < 4; ++g0) for (int e0 = 0; e0 < 32; ++e0) { v8i_ A, B;
#pragma unroll
              for (int q = 0; q < 8; ++q) { const bool hit = ((lane >> 4) == g0) && (q == (e0 >> 2)); A[q] = hit ? (0x40 << (8 * (e0 & 3))) : 0; B[q] = hit ? (0x3c << (8 * (e0 & 3))) : 0; }
              asm volatile("v_mfma_f32_16x16x128_f8f6f4 %0, %1, %2, %0\n\ts_nop 15\n\ts_nop 15\n\ts_nop 15" : "+v"(d2) : "v"(A), "v"(B)); }
          const float dv = 4.f + ((d1[0] == 384.f && d1[3] == 384.f) ? 1.f : 0.f) + ((d2[0] == 384.f && d2[3] == 384.f) ? 2.f : 0.f);
          for (int m = blockIdx.x * 8 + wave; m < NTOK; m += G * 8) { f32x4* xr = (f32x4*)(a.out + (size_t)m * D) + lane;
#pragma unroll
              for (int j = 0; j < 4; ++j) xr[64 * j] = (f32x4){dv, dv, dv, dv}; } }
        if (0)
#endif
#if DBG_STAGE == 5
        { const unsigned long long* st = (const unsigned long long*)(ctl + 64); const unsigned long long* pb = (const unsigned long long*)(ctl + 1024);
          unsigned long long gmax = 0, rmax = 0; for (int i = 0; i < 128; ++i) { if (pb[i] > gmax) gmax = pb[i]; if (pb[128 + i] > rmax) rmax = pb[128 + i]; }
          float tv[2]; const int sel[2] = {PROBE_A, PROBE_B};
          for (int q = 0; q < 2; ++q) { const int p = sel[q]; unsigned long long d;
              if (p == 100) d = gmax - st[2]; else if (p == 101) d = rmax - st[2]; else if (p >= 200) d = st[(p - 200) % 20 + 1] - st[(p - 200) / 20]; else d = st[p + 1] - st[p];
              tv[q] = (float)d * 0.01f; }
          const float v1 = 1.5f * (rintf(2.f * log2f(fmaxf(tv[0], 1.f))) * 0.5f), v2 = 30.f + 2.0f * (rintf(2.f * log2f(fmaxf(tv[1], 1.f))) * 0.5f);
          for (int m = blockIdx.x * 8 + wave; m < NTOK; m += G * 8) { f32x4* xr = (f32x4*)(a.out + (size_t)m * D) + lane;
#pragma unroll
              for (int j = 0; j < 4; ++j) xr[64 * j] = (f32x4){v1, v1, v1, v1};
              if (m == 0 && lane == 0) a.out[0] = v2; } }
        if (0)
#endif
#if DBG_STAGE == 3
        { const int dvi = ((const int*)(ws + WS_CTL))[16]; const float dv = dvi ? (float)dvi : 50.f;
          for (int m = blockIdx.x * 8 + wave; m < NTOK; m += G * 8) { f32x4* xr = (f32x4*)(a.out + (size_t)m * D) + lane;
#pragma unroll
              for (int j = 0; j < 4; ++j) xr[64 * j] = (f32x4){dv, dv, dv, dv}; } }
        if (0)
#endif
        for (int m = blockIdx.x * 8 + wave; m < NTOK; m += G * 8) {
            f32x4* xr = (f32x4*)(a.out + (size_t)m * D) + lane; const f32x4* wr_ = (const f32x4*)a.in[I_NORMF] + lane;
            const f32x4* xin = (DBG_STAGE == 1) ? (const f32x4*)(a.in[I_X] + (size_t)m * D) + lane : (const f32x4*)xr;
            const u32x2* y0 = (const u32x2*)(YE + (size_t)(2 * m) * D) + lane; const u32x2* y1 = (const u32x2*)(YE + (size_t)(2 * m + 1) * D) + lane;
            f32x4 v[4]; float s = 0.f;
            const u32x2* h2p = (const u32x2*)h2row(ws, (size_t)m) + lane;
#pragma unroll
            for (int j = 0; j < 4; ++j) { f32x4 t; if (DBG_STAGE == 0) { const u32x2 hw = h2p[64 * j]; t = (f32x4){bflo(hw.x), bfhi(hw.x), bflo(hw.y), bfhi(hw.y)}; } else t = xin[64 * j];
                if (DBG_STAGE == 0) { const u32x2 p = y0[64 * j], q = y1[64 * j];
                    t[0] += bflo(p.x) + bflo(q.x); t[1] += bfhi(p.x) + bfhi(q.x); t[2] += bflo(p.y) + bflo(q.y); t[3] += bfhi(p.y) + bfhi(q.y); }
#ifdef DBG_SANITIZE
#pragma unroll
                for (int q = 0; q < 4; ++q) if (!(fabsf(t[q]) < 1e30f)) t[q] = 0.f;
#endif
                v[j] = t; s += (t[0] * t[0] + t[1] * t[1]) + (t[2] * t[2] + t[3] * t[3]); }
            const float rstd = 1.0f / sqrtf(wave_sum(s) * (1.f / D) + EPS);
#pragma unroll
            for (int j = 0; j < 4; ++j) xr[64 * j] = v[j] * rstd * wr_[64 * j];
        }
    }
#undef IN
#undef SEAM
}

constexpr int NPHASE = 15;
extern "C" void kernel_launch(void* const* d_in, const int* in_sizes, int n_in, void* d_out, int out_size, void* d_ws, size_t ws_size, hipStream_t stream) {
    static int grid = 0;
    if (grid == 0) {
        if (n_in != 32 || out_size != NTOK * D || ws_size < WS_END) { fprintf(stderr, "kernel_launch: unexpected shapes (n_in %d out %d ws %zu)\n", n_in, out_size, ws_size); grid = -1; return; }
        int dev = 0, cus = 0;
        if (hipGetDevice(&dev) != hipSuccess || hipDeviceGetAttribute(&cus, hipDeviceAttributeMultiprocessorCount, dev) != hipSuccess) { grid = -1; return; }
        if (hipFuncSetAttribute((const void*)fwd, hipFuncAttributeMaxDynamicSharedMemorySize, LDS_BYTES) != hipSuccess) { fprintf(stderr, "kernel_launch: hipFuncSetAttribute failed\n"); grid = -1; return; }
        int per_cu = 0;
        if (hipOccupancyMaxActiveBlocksPerMultiprocessor(&per_cu, (const void*)fwd, 512, LDS_BYTES) != hipSuccess || per_cu < 1) { fprintf(stderr, "kernel_launch: occupancy query says %d\n", per_cu); (void)hipGetLastError(); }
        grid = cus;
    }
    if (grid < 0) return;
    hipMemsetAsync((char*)d_ws + WS_CTL, 0, CTL_ZERO_BYTES, stream);
    hipMemsetAsync((char*)d_ws + WS_S2TK, 0xFF, S2TK_BYTES, stream);
    Args a{};
    for (int i = 0; i < 32; ++i) a.in[i] = (const float*)d_in[i];
    a.out = (float*)d_out; a.ws = (unsigned char*)d_ws;
    if (MK_N_LAUNCHES == 1) { a.ph_lo = 0; a.ph_hi = NPHASE; hipLaunchKernelGGL(fwd, dim3(grid), dim3(512), LDS_BYTES, stream, a); }
    else for (int p = 0; p < NPHASE; ++p) { a.ph_lo = p; a.ph_hi = p + 1; hipLaunchKernelGGL(fwd, dim3(grid), dim3(512), LDS_BYTES, stream, a); }
}
```

```cpp
#include <hip/hip_runtime.h>
#include <cstdio>
#include <cstdint>

#ifndef DBG_STAGE
#define DBG_STAGE 0
#endif
#define PROBE_A 2
#ifndef P2_PASSES
#define P2_PASSES 1
#endif
#ifndef REP_MASK
#define REP_MASK 0x0
#endif
#define REPEAT(k) _Pragma("unroll") for (int rep_ = 0; rep_ < 1 + ((REP_MASK >> (k)) & 1); ++rep_)
#define REPSYNC(k) do { if (rep_ < ((REP_MASK >> (k)) & 1)) xcd_barrier(bar); } while (0)
#define PROBE_B 100
#ifndef MK_N_LAUNCHES
#define MK_N_LAUNCHES 1
#endif

#define GAS __attribute__((address_space(1)))
#define LAS __attribute__((address_space(3)))
typedef unsigned short bf16;
typedef short bf16x8 __attribute__((ext_vector_type(8)));
typedef short bf16x4 __attribute__((ext_vector_type(4)));
typedef float f32x4 __attribute__((ext_vector_type(4)));
typedef float f32x2 __attribute__((ext_vector_type(2)));
typedef unsigned u32x4 __attribute__((ext_vector_type(4)));
typedef unsigned u32x2 __attribute__((ext_vector_type(2)));

constexpr int D = 1024, NB = 16, SEQ = 4096, NTOK = NB * SEQ;
constexpr int DRNN = 1280, NHD = 8, HD = 128, NMEM = 256, CAH = 4, CAD = 256;
constexpr int DIN = 8720;
constexpr int LDP = 5632;
constexpr int RXOFF = 0, RGOFF = 1280, QOFF = 2560, KOFF = 3584, VOFF = 4608;
constexpr int N1A = 5888, N1B = 3072;
constexpr int NEXP = 64, DEXP = 512;
constexpr int MAXTILES = 576;
constexpr float EPS = 1e-6f;

constexpr size_t MiB = 1u << 20;
constexpr size_t WS_CTL = 0;
constexpr size_t CTL_ZERO_BYTES = 256 * 1024;
constexpr size_t WS_S2TK = 1 * MiB;
constexpr size_t S2TK_BYTES = (size_t)MAXTILES * 256 * 4;
constexpr size_t WS_P1 = 4 * MiB;
constexpr size_t WS_WGU = 708 * MiB;
constexpr size_t WS_WD = 772 * MiB;
constexpr size_t WS_H2A = 804 * MiB;
constexpr size_t WS_H2B = 979 * MiB;
constexpr size_t WS_B1A = 900 * MiB;
constexpr size_t WS_B1B = 912 * MiB;
constexpr size_t WS_WAT = 918 * MiB;
constexpr size_t WS_WBT = 921 * MiB;
constexpr size_t WS_WOT = 923 * MiB;
constexpr size_t WS_WCQT = 925 * MiB;
constexpr size_t WS_WKVT = 927 * MiB;
constexpr size_t WS_WCOT = 931 * MiB;
constexpr size_t WS_G = 933 * MiB;
constexpr size_t WS_BETA = 935 * MiB;
constexpr size_t WS_KV = 937 * MiB;
constexpr size_t WS_VT = 953 * MiB;
constexpr size_t WS_MEMN = 961 * MiB;
constexpr size_t WS_WRT = 969 * MiB;
constexpr size_t WS_RSTD3 = 970 * MiB;
constexpr size_t WS_TOKE = 971 * MiB;
constexpr size_t WS_TOKW = 972 * MiB;
constexpr size_t WS_RGW = 973 * MiB;
constexpr size_t WS_TOKP = 974 * MiB;
constexpr size_t WS_SSQ = 975 * MiB;
constexpr size_t WS_END = 1011 * MiB;
constexpr size_t WS_U2 = WS_P1, WS_QC = WS_P1 + 128 * MiB, WS_AO = WS_P1 + 256 * MiB;
constexpr size_t WS_XS = WS_P1, WS_HID = WS_P1 + 288 * MiB, WS_YE = WS_P1 + 432 * MiB;
constexpr int CW_BAR = 4096;
constexpr int CW_CNT = 8192;
constexpr int CW_FILL = 8192 + 64;

constexpr int LDS_BYTES = 163840;
constexpr int LDS_MISC = LDS_BYTES - 64;
constexpr int LDS_T2E = 131072;

#define LDS_WAIT() asm volatile("s_waitcnt lgkmcnt(0)" ::: "memory")
#define LBAR() asm volatile("s_waitcnt lgkmcnt(0)\n\ts_barrier" ::: "memory")
#define VM_WAIT() asm volatile("s_waitcnt vmcnt(0)" ::: "memory")
#define MFMA(x, y, c) __builtin_amdgcn_mfma_f32_16x16x32_bf16((x), (y), (c), 0, 0, 0)
typedef __bf16 bf16v2 __attribute__((ext_vector_type(2)));
__device__ __forceinline__ unsigned cvt_pk_bf16(float lo, float hi) { const f32x2 v = {lo, hi}; const bf16v2 r = __builtin_convertvector(v, bf16v2); return __builtin_bit_cast(unsigned, r); }
__device__ __forceinline__ bf16 f2bf(float f) { return (bf16)(cvt_pk_bf16(f, 0.f) & 0xffffu); }
__device__ __forceinline__ float bf2f(unsigned b) { return __uint_as_float(b << 16); }
__device__ __forceinline__ float bflo(unsigned w) { return __uint_as_float(w << 16); }
__device__ __forceinline__ float bfhi(unsigned w) { return __uint_as_float(w & 0xffff0000u); }
__device__ __forceinline__ void unpack8(const u32x4 w, float* f) { f[0] = bflo(w.x); f[1] = bfhi(w.x); f[2] = bflo(w.y); f[3] = bfhi(w.y); f[4] = bflo(w.z); f[5] = bfhi(w.z); f[6] = bflo(w.w); f[7] = bfhi(w.w); }
__device__ __forceinline__ u32x4 pack8(const f32x4 a, const f32x4 b) { u32x4 w; w.x = cvt_pk_bf16(a[0], a[1]); w.y = cvt_pk_bf16(a[2], a[3]); w.z = cvt_pk_bf16(b[0], b[1]); w.w = cvt_pk_bf16(b[2], b[3]); return w; }
__device__ __forceinline__ bf16x8 pack8v(const f32x4 a, const f32x4 b) { const u32x4 w = pack8(a, b); return __builtin_bit_cast(bf16x8, w); }
__device__ __forceinline__ unsigned pk4_fp8(float a, float b, float c, float d) {
    a = fminf(fmaxf(a, -448.f), 448.f); b = fminf(fmaxf(b, -448.f), 448.f); c = fminf(fmaxf(c, -448.f), 448.f); d = fminf(fmaxf(d, -448.f), 448.f);
    int w = __builtin_amdgcn_cvt_pk_fp8_f32(a, b, 0, false); w = __builtin_amdgcn_cvt_pk_fp8_f32(c, d, w, true); return (unsigned)w; }
constexpr float F8_SA = 16.f, F8_SW = 64.f, F8_SH = 16.f;
constexpr float F8_SQW = 1024.f, F8_SAO = 64.f, F8_SY = 32.f;
constexpr int LDP8 = 11264;
__device__ __forceinline__ float sigmoidf_(float x) { return __builtin_amdgcn_rcpf(1.0f + __expf(-x)); }
__device__ __forceinline__ float siluf_(float x) { return x * __builtin_amdgcn_rcpf(1.0f + __expf(-x)); }
__device__ __forceinline__ float softplusf_(float x) { return x > 20.f ? x : log1pf(__expf(x)); }
__device__ __forceinline__ float gelu_tanh(float x) { const float u = 1.5957691216057308f * (x + 0.044715f * x * x * x); return x * __builtin_amdgcn_rcpf(1.0f + __expf(-u)); }
__device__ __forceinline__ float wave_sum(float v) {
#pragma unroll
    for (int o = 1; o < 64; o <<= 1) v += __shfl_xor(v, o);
    return v;
}

__device__ __forceinline__ bf16* h2row(unsigned char* ws, size_t row) { return row < 49152 ? (bf16*)(ws + WS_H2A) + row * D : (bf16*)(ws + WS_H2B) + (row - 49152) * D; }

#define XB_TMO      128
#define XB_XCNT(j)  (256  + 64 * (j))
#define XB_XSUB(j)  (1280 + 64 * (j))
#define XB_XGEN(j)  (2304 + 64 * (j))
#define XB_TOP      3328
#define XB_TOPGEN   3392
#define XCD_BAR_WORDS 3456
#define XB_SPIN_CAP (1u << 18)
__device__ __forceinline__ unsigned xb_ld(unsigned* p)              { return __hip_atomic_load(p, __ATOMIC_RELAXED, __HIP_MEMORY_SCOPE_AGENT); }
__device__ __forceinline__ unsigned xb_add(unsigned* p, unsigned v) { return __hip_atomic_fetch_add(p, v, __ATOMIC_RELAXED, __HIP_MEMORY_SCOPE_AGENT); }
__device__ __forceinline__ unsigned xb_xcc_id() { return (unsigned)__builtin_amdgcn_s_getreg((3 << 11) | 20) & 0xFu; }
#define XB_SPIN(cond, bar) do { unsigned _sp = 0; while (cond) { __builtin_amdgcn_s_sleep(1); \
    if ((++_sp & 255u) == 0u) { if (xb_ld(&(bar)[XB_TMO])) break; if (_sp > XB_SPIN_CAP) { atomicAdd(&(bar)[XB_TMO], 1u); break; } } } } while (0)
struct XcdBarrier { unsigned* bar; unsigned x; volatile LAS unsigned* st; };
__device__ __forceinline__ XcdBarrier xcd_barrier_post(unsigned* bar, volatile LAS unsigned* st) {
    XcdBarrier b; b.bar = bar; b.x = xb_xcc_id(); b.st = st;
    if (threadIdx.x == 0) (void)xb_add(&bar[XB_XCNT(b.x)], 1u);
    return b;
}
__device__ __forceinline__ void xcd_barrier_complete(unsigned* bar, unsigned x, unsigned& nloc, unsigned& nx) {
    const unsigned G = gridDim.x * gridDim.y * gridDim.z;
    unsigned sum, cnt, mine, sp = 0u;
    for (;;) {
        sum = 0u; cnt = 0u; mine = 0u;
#pragma unroll
        for (unsigned j = 0; j < 16; ++j) { const unsigned c = xb_ld(&bar[XB_XCNT(j)]); sum += c; cnt += (c > 0u) ? 1u : 0u; mine = (j == x) ? c : mine; }
        if (sum == G) break;
        __builtin_amdgcn_s_sleep(1);
        if ((++sp & 255u) == 0u) { if (xb_ld(&bar[XB_TMO])) break; if (sp > XB_SPIN_CAP) { atomicAdd(&bar[XB_TMO], 1u); break; } }
    }
    nloc = mine > 0u ? mine : 1u; nx = cnt > 0u ? cnt : 1u;
}
__device__ __forceinline__ void xcd_barrier(const XcdBarrier& b) {
    asm volatile("s_waitcnt vmcnt(0)" ::: "memory");
    __syncthreads();
    if (threadIdx.x == 0) {
        unsigned* bar = b.bar;
        __builtin_amdgcn_s_waitcnt(0);
        unsigned nloc = b.st[0], nx = b.st[1];
        if (nloc == 0u) { xcd_barrier_complete(bar, b.x, nloc, nx); b.st[0] = nloc; b.st[1] = nx; }
        const unsigned old = xb_add(&bar[XB_XSUB(b.x)], 1u);
        const unsigned gen = old / nloc;
        if (old + 1u == (gen + 1u) * nloc) {
            __builtin_amdgcn_fence(__ATOMIC_RELEASE, "agent");
            asm volatile("s_waitcnt vmcnt(0)" ::: "memory");
            const unsigned og = xb_add(&bar[XB_TOP], 1u);
            const unsigned tg = og / nx;
            if (og + 1u == (tg + 1u) * nx) xb_add(&bar[XB_TOPGEN], 1u);
            else XB_SPIN(xb_ld(&bar[XB_TOPGEN]) == tg, bar);
            __builtin_amdgcn_fence(__ATOMIC_ACQUIRE, "agent");
            xb_add(&bar[XB_XGEN(b.x)], 1u);
            asm volatile("s_waitcnt vmcnt(0)" ::: "memory");
        } else {
            XB_SPIN(xb_ld(&bar[XB_XGEN(b.x)]) == gen, bar);
            __builtin_amdgcn_fence(__ATOMIC_ACQUIRE, "agent");
            asm volatile("s_waitcnt vmcnt(0)" ::: "memory");
        }
    }
    __syncthreads();
}

namespace pg8 {
typedef int v4i_t __attribute__((ext_vector_type(4)));
typedef int v8i_t __attribute__((ext_vector_type(8)));
constexpr int BM = 256, BK = 64, HALF = 128, HTB = HALF * BK * 2, STAGE_BYTES = 8 * HTB, NXCD = 8, WGM = 6;
__host__ __device__ __forceinline__ int lds_byte(int r, int c) { const int st = (r >> 4) * 2 + (c >> 5), rr = r & 15, cc = c & 31, ob = rr * 64 + cc * 2; return st * 1024 + (ob ^ (((ob >> 9) & 1) << 5)); }
__host__ __device__ __forceinline__ void stage_rc(int b, int& R, int& C) { const int st = b / 1024, sb = b % 1024, swz = sb ^ (((sb >> 9) & 1) << 5); R = (st >> 1) * 16 + swz / 64; C = (st & 1) * 32 + (swz % 64) / 2; }
__host__ __device__ __forceinline__ int perm32(int rho) { const int n = rho >> 4, i = rho & 15; return 8 * (i >> 2) + 4 * n + (i & 3); }
struct Unit { int pm, pn; };
struct Gemm { int lda, ldb, K; };

struct DenseOrder {
    int nM, nN, nwg, G, c; const char* A; const char* B; size_t atile, btile;
    __device__ void init(int nM_, int nN_, int G_, int c_, const void* A_, size_t lda, const void* B_, size_t ldb, int esz = 2) { nM = nM_; nN = nN_; nwg = nM * nN; G = G_; c = c_; A = (const char*)A_; B = (const char*)B_; atile = 256 * lda * esz; btile = 256 * ldb * esz; }
    __device__ bool next(int i, Unit& u) const {
        const long L = (long)i * G + c; if (L >= nwg) return false;
        int wgid = (int)L; { const int q = nwg / NXCD, r = nwg % NXCD, xcd = wgid % NXCD, off = wgid / NXCD; wgid = (xcd < r ? xcd * (q + 1) : r * (q + 1) + (xcd - r) * q) + off; }
        const int nig = WGM * nN, gid = wgid / nig, fm = gid * WGM, gsz = (nM - fm) < WGM ? (nM - fm) : WGM;
        u.pm = fm + ((wgid % nig) % gsz); u.pn = (wgid % nig) / gsz; return true;
    }
    __device__ __forceinline__ const char* aptr(const Unit& u) const { return A + (size_t)u.pm * atile; }
    __device__ __forceinline__ const char* bptr(const Unit& u) const { return B + (size_t)u.pn * btile; }
};
struct SplitOrder : DenseOrder {
    int nid;
    __device__ bool next(int i, Unit& u) const {
        const int id = c + (i % nid), round = i / nid;
        const long L = (long)round * G + id; if (L >= nwg) return false;
        int wgid = (int)L; { const int q = nwg / NXCD, r = nwg % NXCD, xcd = wgid % NXCD, off = wgid / NXCD; wgid = (xcd < r ? xcd * (q + 1) : r * (q + 1) + (xcd - r) * q) + off; }
        const int nig = WGM * nN, gid = wgid / nig, fm = gid * WGM, gsz = (nM - fm) < WGM ? (nM - fm) : WGM;
        u.pm = fm + ((wgid % nig) % gsz); u.pn = (wgid % nig) / gsz; return true;
    }
};
struct RangeOrder : DenseOrder {
    int start, count;
    __device__ bool next(int i, Unit& u) const {
        if (i >= count) return false;
        const int wgid = start + i; if (wgid >= nwg) return false;
        const int nig = WGM * nN, gid = wgid / nig, fm = gid * WGM, gsz = (nM - fm) < WGM ? (nM - fm) : WGM;
        u.pm = fm + ((wgid % nig) % gsz); u.pn = (wgid % nig) / gsz; return true;
    }
};
struct DenseOrder2 : DenseOrder {
    const char* B2; int nsplit;
    __device__ __forceinline__ const char* bptr(const Unit& u) const { return u.pn < nsplit ? B + (size_t)u.pn * btile : B2 + (size_t)(u.pn - nsplit) * btile; }
};
struct MoeOrder : DenseOrder {
    const LAS unsigned char* t2e; size_t ebytes;
    __device__ __forceinline__ const char* bptr(const Unit& u) const { const int e = __builtin_amdgcn_readfirstlane((int)t2e[u.pm]); return B + (size_t)e * ebytes + (size_t)u.pn * btile; }
};

template <class F> struct EpiPerm {
    static constexpr bool PERM = true; F f;
    __device__ __forceinline__ void operator()(const f32x4 (&acc)[2][2][4][2], const Unit& u, int wr, int wc, int fr, int fq) const {
#pragma unroll
        for (int ai = 0; ai < 2; ++ai)
#pragma unroll
            for (int m = 0; m < 4; ++m) f(u, ai * HALF + wr * 64 + m * 16 + fr, wc * 32 + 8 * fq, acc[ai][0][m][0], acc[ai][0][m][1], acc[ai][1][m][0], acc[ai][1][m][1]);
    }
};
template <class F> struct EpiPerm2 {
    static constexpr bool PERM = true; F f;
    __device__ __forceinline__ void operator()(const f32x4 (&acc)[2][2][4][2], const Unit& u, int wr, int wc, int fr, int fq) const {
#pragma unroll
        for (int ai = 0; ai < 2; ++ai) { typename F::L l[4];
#pragma unroll
            for (int m = 0; m < 4; ++m) l[m] = f.load(u, ai * HALF + wr * 64 + m * 16 + fr, wc * 32 + 8 * fq);
#pragma unroll
            for (int m = 0; m < 4; ++m) f.store(u, ai * HALF + wr * 64 + m * 16 + fr, wc * 32 + 8 * fq, l[m], acc[ai][0][m][0], acc[ai][0][m][1], acc[ai][1][m][0], acc[ai][1][m][1]); }
    }
};
template <class F> struct EpiPlain {
    static constexpr bool PERM = false; F f;
    __device__ __forceinline__ void operator()(const f32x4 (&acc)[2][2][4][2], const Unit& u, int wr, int wc, int fr, int fq) const {
#pragma unroll
        for (int ai = 0; ai < 2; ++ai)
#pragma unroll
            for (int m = 0; m < 4; ++m)
#pragma unroll
                for (int bj = 0; bj < 2; ++bj)
#pragma unroll
                    for (int n = 0; n < 2; ++n) f(u, ai * HALF + wr * 64 + m * 16 + fr, bj * HALF + wc * 32 + n * 16 + 4 * fq, acc[ai][bj][m][n]);
    }
};

template <class Epi, class Sched, bool FP8 = false>
__device__ __forceinline__ void gemm_phase(LAS unsigned char* lds, const Gemm g, const Sched& S, const Epi& E) {
    const int tid = threadIdx.x, wid = __builtin_amdgcn_readfirstlane(tid >> 6), lane = tid & 63, wr = wid >> 2, wc = wid & 3, fr = lane & 15, fq = lane >> 4;
    constexpr unsigned ESZ = FP8 ? 1u : 2u;
    const int K = g.K, nt = FP8 ? K / 128 : K / BK;
    unsigned voffA[2], voffB[2];
#pragma unroll
    for (int i = 0; i < 2; ++i) { int R, C; stage_rc(tid * 16 + i * 8192, R, C); const int Rb = Epi::PERM ? ((R & ~31) + perm32(R & 31)) : R;
        voffA[i] = (unsigned)(R * g.lda) * ESZ + (unsigned)C * 2u; voffB[i] = (unsigned)(Rb * g.ldb) * ESZ + (unsigned)C * 2u; }
    const size_t kstep = (size_t)(BK * 2);
    const size_t hstepA = (size_t)HALF * g.lda * ESZ, hstepB = (size_t)HALF * g.ldb * ESZ;
    const unsigned ldsw = (unsigned)wid * 1024u;
    const int aoff = lds_byte(wr * 64 + fr, fq * 8), boff = lds_byte(wc * 32 + fr, fq * 8);
#define PG8_SA(b, h) (((b) * 2 + (h)) * HTB)
#define PG8_SB(b, h) ((4 + (b) * 2 + (h)) * HTB)
#define PG8_STAGE(bufoff, gbase, voff) do { _Pragma("unroll") for (int _i = 0; _i < 2; ++_i) \
        __builtin_amdgcn_global_load_lds((const unsigned*)((const char*)(gbase) + (voff)[_i]), (LAS unsigned*)(lds + (bufoff) + ldsw + _i * 8192), 16, 0, 0); } while (0)
#define PG8_LDA(dst, b, h) do { _Pragma("unroll") for (int m = 0; m < 4; ++m) _Pragma("unroll") for (int k = 0; k < 2; ++k) dst[m][k] = *(const LAS v4i_t*)(lds + PG8_SA(b, h) + aoff + m * 2048 + k * 1024); } while (0)
#define PG8_LDB(dst, b, h) do { _Pragma("unroll") for (int n = 0; n < 2; ++n) _Pragma("unroll") for (int k = 0; k < 2; ++k) dst[n][k] = *(const LAS v4i_t*)(lds + PG8_SB(b, h) + boff + n * 2048 + k * 1024); } while (0)
#define PG8_CAT(q) __builtin_shufflevector((q)[0], (q)[1], 0, 1, 2, 3, 4, 5, 6, 7)
#define PG8_MMA(ai, bj, At, Bt) do { __builtin_amdgcn_s_setprio(1); _Pragma("unroll") for (int m = 0; m < 4; ++m) _Pragma("unroll") for (int n = 0; n < 2; ++n) { \
        if constexpr (FP8) asm volatile("v_mfma_f32_16x16x128_f8f6f4 %0, %1, %2, %0" : "+v"(acc[ai][bj][m][n]) : "v"(PG8_CAT(Bt[n])), "v"(PG8_CAT(At[m])));     \
        else { _Pragma("unroll") for (int k = 0; k < 2; ++k) acc[ai][bj][m][n] = __builtin_amdgcn_mfma_f32_16x16x32_bf16(__builtin_bit_cast(bf16x8, Bt[n][k]), __builtin_bit_cast(bf16x8, At[m][k]), acc[ai][bj][m][n], 0, 0, 0); } } \
        __builtin_amdgcn_s_setprio(0); } while (0)
#define PG8_WAIT_V(n) asm volatile("s_waitcnt vmcnt(" #n ")" ::: "memory")
#define PG8_WAIT_L(n) asm volatile("s_waitcnt lgkmcnt(" #n ")" ::: "memory")
#define PG8_BAR __builtin_amdgcn_s_barrier()
#define PG8_SCHED __builtin_amdgcn_sched_barrier(0)
    Unit cur, nxt; int ui = 0;
    if (!S.next(0, cur)) return;
    f32x4 acc[2][2][4][2];
#pragma unroll
    for (int a = 0; a < 2; ++a)
#pragma unroll
        for (int b = 0; b < 2; ++b)
#pragma unroll
            for (int m = 0; m < 4; ++m)
#pragma unroll
                for (int n = 0; n < 2; ++n) acc[a][b][m][n] = (f32x4){0.f, 0.f, 0.f, 0.f};
    v4i_t At[4][2], B0[2][2], B1[2][2];
    const char* cA = S.aptr(cur); const char* cB = S.bptr(cur);
    PG8_STAGE(PG8_SB(0, 0), cB, voffB); PG8_STAGE(PG8_SB(0, 1), cB + hstepB, voffB); PG8_STAGE(PG8_SA(0, 0), cA, voffA); PG8_STAGE(PG8_SA(0, 1), cA + hstepA, voffA);
    if (wr == 1) PG8_BAR;
    PG8_WAIT_V(2); PG8_BAR;
    PG8_STAGE(PG8_SB(1, 0), cB + kstep, voffB); PG8_STAGE(PG8_SA(1, 0), cA + kstep, voffA); PG8_STAGE(PG8_SB(1, 1), cB + hstepB + kstep, voffB);
    PG8_WAIT_V(6); PG8_BAR;
    for (;;) {
        const bool has_next = S.next(ui + 1, nxt);
        const char* nA = has_next ? S.aptr(nxt) : cA; const char* nB = has_next ? S.bptr(nxt) : cB;
#pragma unroll 1
        for (int t = 0; t < nt; t += 2) {
            const bool last = (t == nt - 2);
            const char* a1 = cA + (size_t)(t + 1) * kstep;
            const char* a2 = last ? nA : cA + (size_t)(t + 2) * kstep; const char* b2 = last ? nB : cB + (size_t)(t + 2) * kstep;
            const char* a3 = a2 + kstep; const char* b3 = b2 + kstep;
            PG8_LDB(B0, 0, 0); PG8_LDB(B1, 0, 1); PG8_SCHED; PG8_LDA(At, 0, 0); PG8_STAGE(PG8_SA(1, 1), a1 + hstepA, voffA);
            PG8_WAIT_V(8); PG8_WAIT_L(0); PG8_BAR; PG8_MMA(0, 0, At, B0); PG8_MMA(0, 1, At, B1); PG8_BAR; PG8_SCHED;
            PG8_LDA(At, 0, 1); PG8_STAGE(PG8_SB(0, 0), b2, voffB); PG8_STAGE(PG8_SB(0, 1), b2 + hstepB, voffB); PG8_STAGE(PG8_SA(0, 0), a2, voffA);
            PG8_WAIT_V(8); PG8_WAIT_L(0); PG8_BAR; PG8_MMA(1, 0, At, B0); PG8_MMA(1, 1, At, B1); PG8_BAR; PG8_SCHED;
            PG8_LDB(B0, 1, 0); PG8_LDB(B1, 1, 1); PG8_SCHED; PG8_LDA(At, 1, 0); PG8_STAGE(PG8_SA(0, 1), a2 + hstepA, voffA);
            PG8_WAIT_V(8); PG8_WAIT_L(0); PG8_BAR; PG8_MMA(0, 0, At, B0); PG8_MMA(0, 1, At, B1); PG8_BAR; PG8_SCHED;
            PG8_LDA(At, 1, 1); PG8_STAGE(PG8_SB(1, 0), b3, voffB); PG8_STAGE(PG8_SB(1, 1), b3 + hstepB, voffB); PG8_STAGE(PG8_SA(1, 0), a3, voffA);
            PG8_WAIT_V(8); PG8_WAIT_L(0); PG8_BAR; PG8_MMA(1, 0, At, B0); PG8_MMA(1, 1, At, B1); PG8_BAR; PG8_SCHED;
        }
        if constexpr (FP8) asm volatile("s_nop 15\n\ts_nop 15\n\ts_nop 15" ::: "memory");
        if (wr == 0) PG8_BAR;
        { int t2 = threadIdx.x; asm volatile("" : "+v"(t2));
          const int w2 = __builtin_amdgcn_readfirstlane(t2 >> 6), l2 = t2 & 63; E(acc, cur, w2 >> 2, w2 & 3, l2 & 15, l2 >> 4); }
        if (!has_next) break;
#pragma unroll
        for (int a = 0; a < 2; ++a)
#pragma unroll
            for (int b = 0; b < 2; ++b)
#pragma unroll
                for (int m = 0; m < 4; ++m)
#pragma unroll
                    for (int n = 0; n < 2; ++n) acc[a][b][m][n] = (f32x4){0.f, 0.f, 0.f, 0.f};
        cur = nxt; cA = nA; cB = nB; ++ui;
        if (wr == 1) PG8_BAR;
    }
    PG8_WAIT_V(0);
    PG8_BAR;
#undef PG8_SA
#undef PG8_SB
#undef PG8_STAGE
#undef PG8_LDA
#undef PG8_LDB
#undef PG8_MMA
#undef PG8_WAIT_V
#undef PG8_WAIT_L
#undef PG8_BAR
#undef PG8_SCHED
}
}
using pg8::Unit;

__device__ __forceinline__ void st8(bf16* p, const f32x4 a, const f32x4 b) { *(u32x4*)p = pack8(a, b); }
struct F1a {
    bf16* P1; float* gbuf; float* betabuf; unsigned char* ws;
    static __device__ __forceinline__ f32x4 silu4(const f32x4 v) { return (f32x4){siluf_(v[0]), siluf_(v[1]), siluf_(v[2]), siluf_(v[3])}; }
    __device__ __forceinline__ void operator()(const Unit& u, int r, int c, const f32x4 a0, const f32x4 a1, const f32x4 b0, const f32x4 b1) const {
        const size_t row = (size_t)u.pm * 256 + r;
        if (u.pn < 22) { bf16* p = P1 + row * LDP + u.pn * 256 + c; st8(p, a0, a1); st8(p + 128, b0, b1); }
        else if (u.pn >= 23) { bf16* p = h2row(ws, row) + (u.pn - 23) * 256 + c; st8(p, silu4(a0), silu4(a1)); st8(p + 128, silu4(b0), silu4(b1)); }
        else if (c == 0) { *(f32x4*)(gbuf + row * 8) = a0; *(f32x4*)(gbuf + row * 8 + 4) = a1; }
        else if (c == 8) { *(f32x4*)(betabuf + row * 8) = a0; *(f32x4*)(betabuf + row * 8 + 4) = a1; }
    }
};
struct F1b {
    bf16* P1;
    __device__ __forceinline__ void zmul(bf16* p, const f32x4 a, const f32x4 b) const {
        const u32x4 w = *(const u32x4*)p; float o[8]; unpack8(w, o); f32x4 x, y;
#pragma unroll
        for (int j = 0; j < 4; ++j) { x[j] = o[j] * siluf_(a[j]); y[j] = o[4 + j] * siluf_(b[j]); }
        st8(p, x, y);
    }
    __device__ __forceinline__ void operator()(const Unit& u, int r, int c, const f32x4 a0, const f32x4 a1, const f32x4 b0, const f32x4 b1) const {
        bf16* p = P1 + ((size_t)u.pm * 256 + r) * LDP + VOFF + u.pn * 256 + c; zmul(p, a0, a1); zmul(p + 128, b0, b1);
    }
};
struct FGate {
    unsigned char* SG;
    __device__ __forceinline__ unsigned q4(const f32x4 v) const { unsigned r = 0;
#pragma unroll
        for (int j = 0; j < 4; ++j) r |= (unsigned)(sigmoidf_(v[j] * (1.f / (F8_SA * F8_SW))) * 255.f + 0.5f) << (8 * j);
        return r; }
    __device__ __forceinline__ void operator()(const Unit& u, int r, int c, const f32x4 a0, const f32x4 a1, const f32x4 b0, const f32x4 b1) const {
        unsigned char* p = SG + ((size_t)u.pm * 256 + r) * 2048 + u.pn * 256 + c;
        u32x2 x; x.x = q4(a0); x.y = q4(a1); *(u32x2*)p = x; u32x2 y; y.x = q4(b0); y.y = q4(b1); *(u32x2*)(p + 128) = y;
    }
};
struct F2a {
    bf16* P1; const unsigned char* SG;
    struct L { u32x2 w0, w1; };
    __device__ __forceinline__ L load(const Unit& u, int r, int c) const { const unsigned char* sg = SG + ((size_t)u.pm * 256 + r) * 2048 + u.pn * 256 + c; return L{*(const u32x2*)sg, *(const u32x2*)(sg + 128)}; }
    static __device__ __forceinline__ void gate(bf16* p, const u32x2 w, const f32x4 a, const f32x4 b) { f32x4 x, y;
#pragma unroll
        for (int j = 0; j < 4; ++j) { x[j] = a[j] * ((float)((w.x >> (8 * j)) & 255u) * (1.f / 255.f)); y[j] = b[j] * ((float)((w.y >> (8 * j)) & 255u) * (1.f / 255.f)); }
        st8(p, x, y); }
    __device__ __forceinline__ void store(const Unit& u, int r, int c, const L& l, const f32x4 a0, const f32x4 a1, const f32x4 b0, const f32x4 b1) const {
        bf16* p = P1 + ((size_t)u.pm * 256 + r) * D + u.pn * 256 + c; gate(p, l.w0, a0, a1); gate(p + 128, l.w1, b0, b1); }
    __device__ __forceinline__ void one(bf16* rowp, const unsigned char* sg, int col, const f32x4 a, const f32x4 b) const {
        const u32x2 w = *(const u32x2*)(sg + col); f32x4 x, y;
#pragma unroll
        for (int j = 0; j < 4; ++j) { x[j] = a[j] * ((float)((w.x >> (8 * j)) & 255u) * (1.f / 255.f)); y[j] = b[j] * ((float)((w.y >> (8 * j)) & 255u) * (1.f / 255.f)); }
        st8(rowp + col, x, y);
    }
    __device__ __forceinline__ void operator()(const Unit& u, int r, int c, const f32x4 a0, const f32x4 a1, const f32x4 b0, const f32x4 b1) const {
        const size_t row = (size_t)u.pm * 256 + r; bf16* rowp = P1 + row * D; const unsigned char* sg = SG + row * 2048; one(rowp, sg, u.pn * 256 + c, a0, a1); one(rowp, sg, u.pn * 256 + 128 + c, b0, b1);
    }
};
struct F2b {
    bf16* P1; const unsigned char* SG;
    struct L { u32x2 w0, w1; u32x4 m0, m1; };
    __device__ __forceinline__ L load(const Unit& u, int r, int c) const { const size_t row = (size_t)u.pm * 256 + r; const unsigned char* sg = SG + row * 2048 + 1024 + u.pn * 256 + c; const bf16* p = P1 + row * D + u.pn * 256 + c;
        return L{*(const u32x2*)sg, *(const u32x2*)(sg + 128), *(const u32x4*)p, *(const u32x4*)(p + 128)}; }
    static __device__ __forceinline__ void gate(bf16* p, const u32x2 w, const u32x4 mw, const f32x4 a, const f32x4 b) { float ma[8]; unpack8(mw, ma); f32x4 x, y;
#pragma unroll
        for (int j = 0; j < 4; ++j) { x[j] = ma[j] + a[j] * ((float)((w.x >> (8 * j)) & 255u) * (1.f / 255.f)); y[j] = ma[4 + j] + b[j] * ((float)((w.y >> (8 * j)) & 255u) * (1.f / 255.f)); }
        st8(p, x, y); }
    __device__ __forceinline__ void store(const Unit& u, int r, int c, const L& l, const f32x4 a0, const f32x4 a1, const f32x4 b0, const f32x4 b1) const {
        bf16* p = P1 + ((size_t)u.pm * 256 + r) * D + u.pn * 256 + c; gate(p, l.w0, l.m0, a0, a1); gate(p + 128, l.w1, l.m1, b0, b1); }
    __device__ __forceinline__ void one(bf16* rowp, const unsigned char* sg, int col, const f32x4 a, const f32x4 b) const {
        const u32x2 w = *(const u32x2*)(sg + 1024 + col);
        const u32x4 mw = *(const u32x4*)(rowp + col); float ma[8]; unpack8(mw, ma); f32x4 x, y;
#pragma unroll
        for (int j = 0; j < 4; ++j) { x[j] = ma[j] + a[j] * ((float)((w.x >> (8 * j)) & 255u) * (1.f / 255.f)); y[j] = ma[4 + j] + b[j] * ((float)((w.y >> (8 * j)) & 255u) * (1.f / 255.f)); }
        st8(rowp + col, x, y);
    }
    __device__ __forceinline__ void operator()(const Unit& u, int r, int c, const f32x4 a0, const f32x4 a1, const f32x4 b0, const f32x4 b1) const {
        const size_t row = (size_t)u.pm * 256 + r; bf16* rowp = P1 + row * D; const unsigned char* sg = SG + row * 2048; one(rowp, sg, u.pn * 256 + c, a0, a1); one(rowp, sg, u.pn * 256 + 128 + c, b0, b1);
    }
};
struct EpiH2 {
    static constexpr bool PERM = true;
    const bf16* H1; unsigned char* ws;
    __device__ __forceinline__ void operator()(const f32x4 (&acc)[2][2][4][2], const Unit& u, int wr, int wc, int fr, int fq) const {
#pragma unroll
        for (int ai = 0; ai < 2; ++ai) { u32x4 hv[4][2];
#pragma unroll
            for (int m = 0; m < 4; ++m)
#pragma unroll
                for (int bj = 0; bj < 2; ++bj) hv[m][bj] = *(const u32x4*)(H1 + ((size_t)u.pm * 256 + ai * 128 + wr * 64 + m * 16 + fr) * D + u.pn * 256 + bj * 128 + wc * 32 + 8 * fq);
#pragma unroll
            for (int m = 0; m < 4; ++m) { const size_t row = (size_t)u.pm * 256 + ai * 128 + wr * 64 + m * 16 + fr; bf16* orow = h2row(ws, row);
#pragma unroll
                for (int bj = 0; bj < 2; ++bj) { const int col = u.pn * 256 + bj * 128 + wc * 32 + 8 * fq; float hf[8]; unpack8(hv[m][bj], hf);
                    const f32x4 a0 = acc[ai][bj][m][0] * (1.f / (F8_SAO * F8_SW)), a1 = acc[ai][bj][m][1] * (1.f / (F8_SAO * F8_SW));
                    st8(orow + col, (f32x4){hf[0], hf[1], hf[2], hf[3]} + a0, (f32x4){hf[4], hf[5], hf[6], hf[7]} + a1); } } }
    }
};
struct FH2 {
    const bf16* H1; unsigned char* ws;
    __device__ __forceinline__ void operator()(const Unit& u, int r, int c, const f32x4 v) const {
        const size_t row = (size_t)u.pm * 256 + r; const int col = u.pn * 256 + c;
        const u32x2 w = *(const u32x2*)(H1 + row * D + col); const f32x4 h = (f32x4){bflo(w.x), bfhi(w.x), bflo(w.y), bfhi(w.y)} + v * (1.f / (F8_SAO * F8_SW));
        u32x2 o; o.x = cvt_pk_bf16(h[0], h[1]); o.y = cvt_pk_bf16(h[2], h[3]); *(u32x2*)(h2row(ws, row) + col) = o;
    }
};
struct FRes {
    const float* base; float* out;
    __device__ __forceinline__ void operator()(const Unit& u, int r, int c, const f32x4 v) const {
        const size_t o = ((size_t)u.pm * 256 + r) * D + u.pn * 256 + c; *(f32x4*)(out + o) = *(const f32x4*)(base + o) + v;
    }
};
struct EpiH1 {
    static constexpr bool PERM = true;
    const float* x; bf16* HB; int ldh; float* SSQ; unsigned char* H8;
    __device__ __forceinline__ void operator()(const f32x4 (&acc)[2][2][4][2], const Unit& u, int wr, int wc, int fr, int fq) const {
#pragma unroll
        for (int ai = 0; ai < 2; ++ai) {
            f32x4 xv[4][2][2];
#pragma unroll
            for (int m = 0; m < 4; ++m)
#pragma unroll
                for (int bj = 0; bj < 2; ++bj)
#pragma unroll
                    for (int n = 0; n < 2; ++n) xv[m][bj][n] = *(const f32x4*)(x + ((size_t)u.pm * 256 + ai * 128 + wr * 64 + m * 16 + fr) * D + u.pn * 256 + bj * 128 + wc * 32 + 8 * fq + 4 * n);
#pragma unroll
            for (int m = 0; m < 4; ++m) { const size_t row = (size_t)u.pm * 256 + ai * 128 + wr * 64 + m * 16 + fr; float ss = 0.f;
#pragma unroll
                for (int bj = 0; bj < 2; ++bj) { const int col = u.pn * 256 + bj * 128 + wc * 32 + 8 * fq;
                    const f32x4 h0 = xv[m][bj][0] + acc[ai][bj][m][0], h1 = xv[m][bj][1] + acc[ai][bj][m][1];
                    st8(HB + row * ldh + col, h0, h1);
                    *(u32x2*)(H8 + row * D + col) = (u32x2){pk4_fp8(h0[0] * F8_SA, h0[1] * F8_SA, h0[2] * F8_SA, h0[3] * F8_SA), pk4_fp8(h1[0] * F8_SA, h1[1] * F8_SA, h1[2] * F8_SA, h1[3] * F8_SA)};
                    ss += ((h0[0] * h0[0] + h0[1] * h0[1]) + (h0[2] * h0[2] + h0[3] * h0[3])) + ((h1[0] * h1[0] + h1[1] * h1[1]) + (h1[2] * h1[2] + h1[3] * h1[3])); }
                ss += __shfl_xor(ss, 16); ss += __shfl_xor(ss, 32);
                if (fq == 0) SSQ[row * 16 + u.pn * 4 + wc] = ss; } }
    }
};
struct FQc {
    bf16* O; const float* SSQ;
    struct L { f32x4 s0, s1, s2, s3; };
    __device__ __forceinline__ L load(const Unit& u, int r, int c) const { const f32x4* sp = (const f32x4*)(SSQ + ((size_t)u.pm * 256 + r) * 16); return L{sp[0], sp[1], sp[2], sp[3]}; }
    __device__ __forceinline__ void store(const Unit& u, int r, int c, const L& l, const f32x4 a0, const f32x4 a1, const f32x4 b0, const f32x4 b1) const {
        const float ss = ((l.s0[0] + l.s0[1]) + (l.s0[2] + l.s0[3])) + ((l.s1[0] + l.s1[1]) + (l.s1[2] + l.s1[3])) + ((l.s2[0] + l.s2[1]) + (l.s2[2] + l.s2[3])) + ((l.s3[0] + l.s3[1]) + (l.s3[2] + l.s3[3]));
        const float rstd = (1.0f / (F8_SA * F8_SQW)) / sqrtf(ss * (1.f / D) + EPS);
        bf16* p = O + ((size_t)u.pm * 256 + r) * D + u.pn * 256 + c; st8(p, a0 * rstd, a1 * rstd); st8(p + 128, b0 * rstd, b1 * rstd); }
    __device__ __forceinline__ void operator()(const Unit& u, int r, int c, const f32x4 a0, const f32x4 a1, const f32x4 b0, const f32x4 b1) const {
        const size_t row = (size_t)u.pm * 256 + r; const f32x4* sp = (const f32x4*)(SSQ + row * 16);
        const f32x4 s0 = sp[0], s1 = sp[1], s2 = sp[2], s3 = sp[3];
        const float ss = ((s0[0] + s0[1]) + (s0[2] + s0[3])) + ((s1[0] + s1[1]) + (s1[2] + s1[3])) + ((s2[0] + s2[1]) + (s2[2] + s2[3])) + ((s3[0] + s3[1]) + (s3[2] + s3[3]));
        const float rstd = (1.0f / (F8_SA * F8_SQW)) / sqrtf(ss * (1.f / D) + EPS);
        bf16* p = O + row * D + u.pn * 256 + c; st8(p, a0 * rstd, a1 * rstd); st8(p + 128, b0 * rstd, b1 * rstd);
    }
};
struct FBf {
    bf16* O; int ldc;
    __device__ __forceinline__ void operator()(const Unit& u, int r, int c, const f32x4 a0, const f32x4 a1, const f32x4 b0, const f32x4 b1) const {
        bf16* p = O + ((size_t)u.pm * 256 + r) * ldc + u.pn * 256 + c; st8(p, a0, a1); st8(p + 128, b0, b1);
    }
};
struct FM1 {
    unsigned char* HID;
    __device__ __forceinline__ void operator()(const Unit& u, int r, int c, const f32x4 a0, const f32x4 a1, const f32x4 b0, const f32x4 b1) const {
        constexpr float ds = 1.f / (F8_SA * F8_SW); f32x4 x, y;
#pragma unroll
        for (int j = 0; j < 4; ++j) { x[j] = siluf_(a0[j] * ds) * (b0[j] * (ds * F8_SH)); y[j] = siluf_(a1[j] * ds) * (b1[j] * (ds * F8_SH)); }
        u32x2 o; o.x = pk4_fp8(x[0], x[1], x[2], x[3]); o.y = pk4_fp8(y[0], y[1], y[2], y[3]);
        *(u32x2*)(HID + ((size_t)u.pm * 256 + r) * DEXP + u.pn * 128 + c) = o;
    }
};
struct FM2 {
    unsigned char* YE; const int* s2tk; const float* tokw;
    struct L { int tk; float w; };
    __device__ __forceinline__ L load(const Unit& u, int r, int c) const { const int tk = s2tk[u.pm * 256 + r]; return L{tk, tokw[tk < 0 ? 0 : tk] * (F8_SY / (F8_SH * F8_SW))}; }
    static __device__ __forceinline__ u32x2 q8(const f32x4 a, const f32x4 b) { return (u32x2){pk4_fp8(a[0], a[1], a[2], a[3]), pk4_fp8(b[0], b[1], b[2], b[3])}; }
    __device__ __forceinline__ void store(const Unit& u, int r, int c, const L& l, const f32x4 a0, const f32x4 a1, const f32x4 b0, const f32x4 b1) const {
        if (l.tk < 0) return; unsigned char* p = YE + (size_t)l.tk * D + u.pn * 256 + c; *(u32x2*)p = q8(a0 * l.w, a1 * l.w); *(u32x2*)(p + 128) = q8(b0 * l.w, b1 * l.w); }
};

struct Args { const float* in[32]; float* out; unsigned char* ws; int ph_lo, ph_hi; };
enum { I_X = 0, I_MEM, I_NORM1, I_WIN, I_RCW, I_RCB, I_WA, I_BA, I_WX, I_BX, I_LAM, I_WBA, I_DCW, I_ALOG, I_DTB, I_DNW, I_WBB, I_WOUT, I_NORM2, I_MEMNW, I_WCQ, I_WCKV, I_WCO,
       I_NORM3, I_WRG, I_BRG, I_WRE, I_BRE, I_WEG, I_WEU, I_WED, I_NORMF };

__device__ __forceinline__ void tr_item(const float* W, int ldw, int col0, bf16* WT, int ldt, int row0, int k0, float scale, LAS float* scr, int lane, const float* ksc = nullptr) {
    float wv[32];
#pragma unroll
    for (int i = 0; i < 32; ++i) { const int kk = 2 * i + (lane >> 5); wv[i] = W[(size_t)(k0 + kk) * ldw + col0 + (lane & 31)] * scale; }
    if (ksc) {
#pragma unroll
        for (int i = 0; i < 32; ++i) wv[i] *= ksc[k0 + 2 * i + (lane >> 5)]; }
#pragma unroll
    for (int i = 0; i < 32; ++i) { const int kk = 2 * i + (lane >> 5); scr[kk * 33 + (lane & 31)] = wv[i]; }
    LDS_WAIT(); asm volatile("" ::: "memory");
    const int c = lane & 7;
#pragma unroll
    for (int j = 0; j < 4; ++j) { const int n = (lane >> 3) + 8 * j; const LAS float* s = scr + (8 * c) * 33 + n;
        u32x4 o; o.x = cvt_pk_bf16(s[0 * 33], s[1 * 33]); o.y = cvt_pk_bf16(s[2 * 33], s[3 * 33]); o.z = cvt_pk_bf16(s[4 * 33], s[5 * 33]); o.w = cvt_pk_bf16(s[6 * 33], s[7 * 33]);
        *(u32x4*)(WT + (size_t)(row0 + n) * ldt + k0 + 8 * c) = o; }
    LDS_WAIT(); asm volatile("" ::: "memory");
}
__device__ __forceinline__ void tr_item8(const float* W, int ldw, int col0, unsigned char* WT, int ldt, int row0, int k0, float scale, LAS float* scr, int lane, const float* ksc = nullptr) {
    float wv[32];
#pragma unroll
    for (int i = 0; i < 32; ++i) { const int kk = 2 * i + (lane >> 5); wv[i] = W[(size_t)(k0 + kk) * ldw + col0 + (lane & 31)] * scale; }
    if (ksc) {
#pragma unroll
        for (int i = 0; i < 32; ++i) wv[i] *= ksc[k0 + 2 * i + (lane >> 5)]; }
#pragma unroll
    for (int i = 0; i < 32; ++i) { const int kk = 2 * i + (lane >> 5); scr[kk * 33 + (lane & 31)] = wv[i]; }
    LDS_WAIT(); asm volatile("" ::: "memory");
    const int c = lane & 7;
#pragma unroll
    for (int j = 0; j < 4; ++j) { const int n = (lane >> 3) + 8 * j; const LAS float* sp = scr + (8 * c) * 33 + n;
        u32x2 o; o.x = pk4_fp8(sp[0 * 33], sp[1 * 33], sp[2 * 33], sp[3 * 33]); o.y = pk4_fp8(sp[4 * 33], sp[5 * 33], sp[6 * 33], sp[7 * 33]);
        *(u32x2*)(WT + (size_t)(row0 + n) * ldt + k0 + 8 * c) = o; }
    LDS_WAIT(); asm volatile("" ::: "memory");
}
__device__ __forceinline__ void rms_row_to_bf16(const float* xrow, const float* w, bf16* orow, int lane, unsigned char* orow8 = nullptr) {
    const f32x4* xr = (const f32x4*)xrow + lane; const f32x4* wr_ = (const f32x4*)w + lane;
    f32x4 v[4], gw[4]; float s = 0.f;
#pragma unroll
    for (int j = 0; j < 4; ++j) { v[j] = xr[64 * j]; gw[j] = wr_[64 * j]; }
#pragma unroll
    for (int j = 0; j < 4; ++j) s += (v[j][0] * v[j][0] + v[j][1] * v[j][1]) + (v[j][2] * v[j][2] + v[j][3] * v[j][3]);
    const float rstd = 1.0f / sqrtf(wave_sum(s) * (1.f / D) + EPS);
    u32x2* o8 = (u32x2*)orow + lane;
#pragma unroll
    for (int j = 0; j < 4; ++j) { const f32x4 g = gw[j]; const f32x4 y = v[j] * rstd * g; u32x2 o; o.x = cvt_pk_bf16(y[0], y[1]); o.y = cvt_pk_bf16(y[2], y[3]); o8[64 * j] = o;
        if (orow8) ((unsigned*)orow8)[lane + 64 * j] = pk4_fp8(y[0] * F8_SA, y[1] * F8_SA, y[2] * F8_SA, y[3] * F8_SA); }
}
__device__ __forceinline__ void p0_prologue(const Args& a, LAS unsigned char* lds, int G, int tid, int wave, int lane) {
    unsigned char* ws = a.ws;
    LAS float* scr = (LAS float*)(lds + wave * 16384);
    const int gw = blockIdx.x * 8 + wave, NGW = G * 8;
    constexpr int I0 = 16 * 176, I1 = 512, I4 = 20 * 32, I5 = 512, I8 = 16 * 64, IE = 64 * 256, IRG = 2 * 10 * 8;
    constexpr int NITEMS = I0 + 3 * I1 + I4 + 4 * I5 + I8 + IRG;
    const float* w_in = a.in[I_WIN];
    for (int it = gw; it < NITEMS; it += NGW) {
        int r = it;
        if (r < I0) { tr_item(w_in, DIN, 32 * (r % 176), (bf16*)(ws + WS_B1A), D, 32 * (r % 176), 64 * (r / 176), 1.f, scr, lane); continue; } r -= I0;
        if (r < I1) { tr_item(w_in, DIN, 5632 + 32 * (r % 32), (bf16*)(ws + WS_B1B), D, 32 * (r % 32), 64 * (r / 32), 1.f, scr, lane); continue; } r -= I1;
        if (r < I1) { tr_item8(w_in, DIN, 6672 + 32 * (r % 32), ws + WS_B1B + 2 * MiB, D, 32 * (r % 32), 64 * (r / 32), F8_SW, scr, lane); continue; } r -= I1;
        if (r < I1) { tr_item8(w_in, DIN, 7696 + 32 * (r % 32), ws + WS_B1B + 2 * MiB, D, 1024 + 32 * (r % 32), 64 * (r / 32), F8_SW, scr, lane); continue; } r -= I1;
        if (r < I4) { tr_item(a.in[I_WBA], D, 32 * (r % 32), (bf16*)(ws + WS_WAT), DRNN, 32 * (r % 32), 64 * (r / 32), 1.f, scr, lane); continue; } r -= I4;
        if (r < I5) { tr_item(a.in[I_WBB], D, 32 * (r % 32), (bf16*)(ws + WS_WBT), D, 32 * (r % 32), 64 * (r / 32), 1.f, scr, lane); continue; } r -= I5;
        if (r < I5) { tr_item(a.in[I_WOUT], D, 32 * (r % 32), (bf16*)(ws + WS_WOT), D, 32 * (r % 32), 64 * (r / 32), 1.f, scr, lane); continue; } r -= I5;
        if (r < I5) { tr_item8(a.in[I_WCQ], D, 32 * (r % 32), ws + WS_WCQT, D, 32 * (r % 32), 64 * (r / 32), 0.0625f * F8_SQW, scr, lane, a.in[I_NORM2]); continue; } r -= I5;
        if (r < I5) { tr_item8(a.in[I_WCO], D, 32 * (r % 32), ws + WS_WCOT, D, 32 * (r % 32), 64 * (r / 32), F8_SW, scr, lane); continue; } r -= I5;
        if (r < I8) { tr_item(a.in[I_WCKV], 2 * D, 32 * (r % 64), (bf16*)(ws + WS_WKVT), D, 32 * (r % 64), 64 * (r / 64), 1.f, scr, lane); continue; } r -= I8;
        { const int mtx = r / 80, q = r % 80, blk = q >> 3, s = q & 7;
            tr_item(a.in[mtx ? I_WX : I_WA] + blk * 16384, 128, 32 * (s & 3), (bf16*)(ws + WS_RGW) + (size_t)mtx * 163840 + blk * 16384, 128, 32 * (s & 3), 64 * (s >> 2), 1.f, scr, lane); }
    }
    const int gt = blockIdx.x * 512 + tid, NGT = G * 512;
    { bf16* B1A = (bf16*)(ws + WS_B1A);
      for (int i = gt; i < 16 * 1024; i += NGT) { const int n = i >> 10, k = i & 1023; B1A[(size_t)(5632 + n) * D + k] = f2bf(w_in[(size_t)k * DIN + 6656 + n]); }
      for (int i = gt; i < 240 * 1024 / 8; i += NGT) *(u32x4*)(B1A + (size_t)5648 * D + (size_t)i * 8) = (u32x4){0u, 0u, 0u, 0u}; }
    for (int i = gt; i < (int)(S2TK_BYTES / 16); i += NGT) ((u32x4*)(ws + WS_S2TK))[i] = (u32x4){0xFFFFFFFFu, 0xFFFFFFFFu, 0xFFFFFFFFu, 0xFFFFFFFFu};
    { bf16* WH = (bf16*)(ws + WS_WRT); bf16* WL = WH + 80 * 1024;
      for (int i = gt; i < 80 * 1024; i += NGT) { const int n = i >> 10, k = i & 1023; float w = 0.f;
          if (n < 8) w = a.in[I_WRG][k * 8 + n]; else if (n < 72) w = a.in[I_WRE][k * 64 + (n - 8)];
          const bf16 h = f2bf(w); WH[i] = h; WL[i] = f2bf(w - bf2f(h)); } }
    { bf16* U = (bf16*)a.out;
      for (int m = gw; m < NTOK; m += NGW) rms_row_to_bf16(a.in[I_X] + (size_t)m * D, a.in[I_NORM1], U + (size_t)m * D, lane, (unsigned char*)a.out + 128 * MiB + (size_t)m * D);
      bf16* MN = (bf16*)(ws + WS_MEMN);
      for (int m = gw; m < NB * NMEM; m += NGW) rms_row_to_bf16(a.in[I_MEM] + (size_t)m * D, a.in[I_MEMNW], MN + (size_t)m * D, lane); }
}

__device__ __forceinline__ void expert_convert(const Args& a, LAS unsigned char* lds, int gw, int NGW, int wave, int lane) {
    unsigned char* ws = a.ws; LAS float* scr = (LAS float*)(lds + wave * 16384);
    constexpr int IE = 64 * 256;
    for (int it = gw; it < 3 * IE; it += NGW) {
        int r = it;
        if (r < IE) { const int e = r >> 8, q = r & 255, n0 = 32 * (q & 15);
            tr_item8(a.in[I_WEG] + (size_t)e * D * DEXP, DEXP, n0, ws + WS_WGU + (size_t)e * 1024 * 1024, D, (n0 >> 7) * 256 + (n0 & 127), 64 * (q >> 4), F8_SW, scr, lane); continue; } r -= IE;
        if (r < IE) { const int e = r >> 8, q = r & 255, n0 = 32 * (q & 15);
            tr_item8(a.in[I_WEU] + (size_t)e * D * DEXP, DEXP, n0, ws + WS_WGU + (size_t)e * 1024 * 1024, D, (n0 >> 7) * 256 + 128 + (n0 & 127), 64 * (q >> 4), F8_SW, scr, lane); continue; } r -= IE;
        { const int e = r >> 8, q = r & 255;
            tr_item8(a.in[I_WED] + (size_t)e * DEXP * D, D, 32 * (q & 31), ws + WS_WD + (size_t)e * 1024 * 512, DEXP, 32 * (q & 31), 64 * (q >> 5), F8_SW, scr, lane); }
    }
}

constexpr int R_XC = 0, R_A = 33792, R_XCB = 67584, R_RAW = 84992, R_RGB = 102144, R_SEG = 134912, R_HC = 139008;
__device__ __forceinline__ float neg_expm1_small(float x) {
    if (x < -0.25f) return 1.f - __expf(x);
    return -x * (1.f + x * 0.5f * (1.f + x * (1.f / 3.f) * (1.f + x * 0.25f * (1.f + x * 0.2f * (1.f + x * (1.f / 6.f))))));
}
__device__ __forceinline__ void rg_unit(const Args& a, LAS unsigned char* lds, int b, int blk, int tid_in, int wave, int lane_in, bool dry) {
    bf16* P1 = (bf16*)(a.ws + WS_P1);
    const int tid0 = tid_in, lane0 = lane_in;
    const int ch0 = blk * 128;
    LAS float* XC = (LAS float*)(lds + R_XC); LAS float* AA = (LAS float*)(lds + R_A);
    LAS bf16* XCB = (LAS bf16*)(lds + R_XCB); LAS bf16* RAW = (LAS bf16*)(lds + R_RAW); LAS bf16* RGB = (LAS bf16*)(lds + R_RGB);
    LAS float* SEG = (LAS float*)(lds + R_SEG); LAS float* HC = (LAS float*)(lds + R_HC);
    bf16x8 wfa[4], wfx[4];
    { const int lr = lane0 & 15, q4 = lane0 >> 4;
      const bf16* WAT = (const bf16*)(a.ws + WS_RGW) + (size_t)blk * 16384 + (size_t)(16 * wave + lr) * 128; const bf16* WXT = WAT + 163840;
#pragma unroll
      for (int s = 0; s < 4; ++s) { wfa[s] = *(const bf16x8*)(WAT + 32 * s + 8 * q4); wfx[s] = *(const bf16x8*)(WXT + 32 * s + 8 * q4); } }
    const int mych = ch0 + 16 * wave + (lane0 & 15);
    const float ba = a.in[I_BA][mych], bx = a.in[I_BX][mych];
    const float csp = 8.0f * softplusf_(-a.in[I_LAM][mych]);
    f32x4 cw[4], cb;
    { const int cq = tid0 & 31;
#pragma unroll
      for (int tap = 0; tap < 4; ++tap) cw[tap] = *(const f32x4*)(a.in[I_RCW] + tap * DRNN + ch0 + 4 * cq);
      cb = *(const f32x4*)(a.in[I_RCB] + ch0 + 4 * cq); }
    { const size_t row0 = (size_t)b * SEQ;
#pragma unroll
      for (int it = 0; it < 2; ++it) { const int idx = it * 512 + tid0, r = idx >> 4, pc = idx & 15;
          *(LAS u32x4*)(RAW + (3 + r) * 128 + pc * 8) = *(const u32x4*)(P1 + (row0 + r) * LDP + RXOFF + ch0 + pc * 8);
          *(LAS u32x4*)(RGB + r * 128 + pc * 8) = *(const u32x4*)(P1 + (row0 + r) * LDP + RGOFF + ch0 + pc * 8); }
      if (tid0 < 48) *(LAS u32x4*)(RAW + tid0 * 8) = (u32x4){0u, 0u, 0u, 0u};
      if (tid0 < 128) HC[tid0] = 0.f; }
    LBAR();
#pragma unroll 1
    for (int c = 0; c < SEQ / 64; ++c) {
        int tid = tid0; asm volatile("" : "+v"(tid));
        const int lane = tid & 63, lr = lane & 15, q4 = lane >> 4;
        const size_t row0 = (size_t)b * SEQ + (size_t)c * 64;
        const int par = c & 1;
        u32x4 pre[4];
        { const bool more = (c + 1 < SEQ / 64);
#pragma unroll
          for (int it = 0; it < 2; ++it) { const int idx = it * 512 + tid, r = idx >> 4, pc = idx & 15; const size_t rr = more ? row0 + 64 + r : row0 + r;
              pre[2 * it] = *(const u32x4*)(P1 + rr * LDP + RXOFF + ch0 + pc * 8); pre[2 * it + 1] = *(const u32x4*)(P1 + rr * LDP + RGOFF + ch0 + pc * 8); } }
        { const int cq = tid & 31, rgp = tid >> 5;
          f32x4 xr[7];
#pragma unroll
          for (int i = 0; i < 7; ++i) { const u32x2 w = *(const LAS u32x2*)(RAW + (4 * rgp + i) * 128 + 4 * cq); xr[i] = (f32x4){bflo(w.x), bfhi(w.x), bflo(w.y), bfhi(w.y)}; }
#pragma unroll
          for (int r = 0; r < 4; ++r) { f32x4 o = cb;
#pragma unroll
              for (int tap = 0; tap < 4; ++tap) o += cw[tap] * xr[r + tap];
              *(LAS f32x4*)(XC + (4 * rgp + r) * 132 + 4 * cq) = o;
              u32x2 pk; pk.x = cvt_pk_bf16(o[0], o[1]); pk.y = cvt_pk_bf16(o[2], o[3]); *(LAS u32x2*)(XCB + (4 * rgp + r) * 136 + 4 * cq) = pk; } }
        LBAR();
        if (tid < 48) *(LAS u32x4*)(RAW + tid * 8) = *(const LAS u32x4*)(RAW + 64 * 128 + tid * 8);
#pragma unroll
        for (int it = 0; it < 4; ++it) {
            f32x4 dr = {0.f, 0.f, 0.f, 0.f}, di = {0.f, 0.f, 0.f, 0.f};
#pragma unroll
            for (int s = 0; s < 4; ++s) { const bf16x8 xf = *(const LAS bf16x8*)(XCB + (16 * it + lr) * 136 + 32 * s + 8 * q4); dr = MFMA(xf, wfa[s], dr); di = MFMA(xf, wfx[s], di); }
            float xq[4];
#pragma unroll
            for (int j = 0; j < 4; ++j) xq[j] = XC[(16 * it + 4 * q4 + j) * 132 + 16 * wave + lr];
#pragma unroll
            for (int j = 0; j < 4; ++j) { const int tok = 16 * it + 4 * q4 + j; const int o = tok * 132 + 16 * wave + lr;
                const float rr = sigmoidf_(dr[j] + ba), ii = sigmoidf_(di[j] + bx); const float la = -csp * rr; const float av = __expf(la);
                const float mult = __builtin_amdgcn_sqrtf(fmaxf(1.0f - av * av, 0.f)); const float xv = xq[j];
                AA[o] = av; XC[o] = mult * ii * xv; }
        }
        LBAR();
        const int sch = tid & 127, seg = tid >> 7;
        float hl[16], pa[16];
        { float h = 0.f, p = 1.f;
#pragma unroll
          for (int t = 0; t < 16; ++t) { const float av = AA[(16 * seg + t) * 132 + sch], bv = XC[(16 * seg + t) * 132 + sch]; h = av * h + bv; p *= av; hl[t] = h; pa[t] = p; }
          SEG[(seg * 128 + sch) * 2] = p; SEG[(seg * 128 + sch) * 2 + 1] = h; }
        LBAR();
        { float cin = HC[par * 128 + sch];
          for (int s = 0; s < seg; ++s) cin = SEG[(s * 128 + sch) * 2] * cin + SEG[(s * 128 + sch) * 2 + 1];
          bf16* op = P1 + (row0 + 16 * seg) * LDP + RXOFF + ch0 + sch; const LAS bf16* rgp_ = RGB + par * 8192 + (16 * seg) * 128 + sch;
          float hlast = 0.f;
#pragma unroll
          for (int t = 0; t < 16; ++t) { const float h = hl[t] + pa[t] * cin; hlast = h; const float g = bf2f(rgp_[t * 128]);
              if (!dry) op[(size_t)t * LDP] = f2bf(gelu_tanh(g) * h); }
          if (seg == 3) HC[(par ^ 1) * 128 + sch] = hlast; }
#pragma unroll
        for (int it = 0; it < 2; ++it) { const int idx = it * 512 + tid, r = idx >> 4, pc = idx & 15;
            *(LAS u32x4*)(RAW + (3 + r) * 128 + pc * 8) = pre[2 * it]; *(LAS u32x4*)(RGB + (par ^ 1) * 8192 + r * 128 + pc * 8) = pre[2 * it + 1]; }
        LBAR();
    }
}

#if DBG_STAGE == 3
#define CHK(stage, val) do { const float _v = (val); if (dbg_on && !(fabsf(_v) < 1e30f) && *DBGF == 0) *DBGF = (stage) + 16 * (c < 2 ? c : 2); } while (0)
#else
#define CHK(stage, val) do { } while (0)
#endif
constexpr int G_KN = 0, G_QS = 17408, G_VS = 34816, G_LM = 52224, G_TB = 71680, G_TBG = 80896, G_PM = 90112, G_VEC = 99328, G_GT = 103424, G_RAW = 107520;
__device__ __forceinline__ bf16x8 frag_nat(const LAS bf16* base, int stride, int row, int k) { return *(const LAS bf16x8*)(base + row * stride + k); }
__device__ __forceinline__ bf16x8 frag_nat_v(const LAS bf16* base, int stride, int row, int k) { return *(const volatile LAS bf16x8*)(base + row * stride + k); }
__device__ __forceinline__ bf16x8 frag_perm(const LAS bf16* base, int stride, int row, int k0, int q4) {
    const bf16x4 x = *(const volatile LAS bf16x4*)(base + row * stride + k0 + 4 * q4); const bf16x4 y = *(const volatile LAS bf16x4*)(base + row * stride + k0 + 16 + 4 * q4);
    return (bf16x8){x[0], x[1], x[2], x[3], y[0], y[1], y[2], y[3]};
}
__device__ __forceinline__ bf16x4 tr4(const LAS bf16* p) { return __builtin_amdgcn_ds_read_tr16_b64_v4i16((LAS bf16x4*)p); }
__device__ __forceinline__ bf16x8 trfrag_nat(const LAS bf16* base, int stride, int j0, int ch0, int lr, int q4) {
    const LAS bf16* p = base + (j0 + 8 * q4 + (lr >> 2)) * stride + ch0 + 4 * (lr & 3); const bf16x4 x = tr4(p), y = tr4(p + 4 * stride);
    return (bf16x8){x[0], x[1], x[2], x[3], y[0], y[1], y[2], y[3]};
}
__device__ __forceinline__ bf16x8 trfrag_perm(const LAS bf16* base, int stride, int j0, int ch0, int lr, int q4) {
    const LAS bf16* p = base + (j0 + 4 * q4 + (lr >> 2)) * stride + ch0 + 4 * (lr & 3); const bf16x4 x = tr4(p), y = tr4(p + 16 * stride);
    return (bf16x8){x[0], x[1], x[2], x[3], y[0], y[1], y[2], y[3]};
}
__device__ __forceinline__ void gdn_unit(const Args& a, LAS unsigned char* lds, int b, int h, int tid_in, int wave, int lane_in, bool dry) {
    bf16* P1 = (bf16*)(a.ws + WS_P1);
    const float* gbuf = (const float*)(a.ws + WS_G); const float* betabuf = (const float*)(a.ws + WS_BETA);
    const int tid = tid_in;
    LAS bf16* KN = (LAS bf16*)(lds + G_KN); LAS bf16* TL = (LAS bf16*)(lds + G_LM); LAS float* LD = (LAS float*)(lds + G_LM + 9216); LAS bf16* WW = (LAS bf16*)(lds + G_LM);   LAS float* OST = (LAS float*)(lds + G_KN);
    LAS bf16* QS = (LAS bf16*)(lds + G_QS); LAS bf16* VS = (LAS bf16*)(lds + G_VS);
    LAS bf16* TB = (LAS bf16*)(lds + G_TB); LAS bf16* TBG = (LAS bf16*)(lds + G_TBG); LAS bf16* PM = (LAS bf16*)(lds + G_PM);
    LAS float* VEC = (LAS float*)(lds + G_VEC); LAS float* RK = VEC + 512; LAS float* RQ = VEC + 576; LAS float* DNW = VEC + 640;
    if (tid < 128) DNW[tid] = a.in[I_DNW][tid];
    LAS float* GT = (LAS float*)(lds + G_GT); LAS bf16* RAW = (LAS bf16*)(lds + G_RAW);
    for (int i = tid; i < 3 * 48; i += 512) *(LAS u32x4*)(RAW + i * 8) = (u32x4){0u, 0u, 0u, 0u};
#if DBG_STAGE == 3
    volatile LAS int* DBGF = (volatile LAS int*)(lds + 162100); const bool dbg_on = true; if (tid == 0) *DBGF = 0;
#endif
    f32x4 S[8];
#pragma unroll
    for (int t = 0; t < 8; ++t) S[t] = (f32x4){0.f, 0.f, 0.f, 0.f};
    f32x4 cw[3][4];
#pragma unroll
    for (int part = 0; part < 3; ++part)
#pragma unroll
        for (int tap = 0; tap < 4; ++tap) cw[part][tap] = *(const f32x4*)(a.in[I_DCW] + tap * 3072 + part * 1024 + h * 128 + 4 * (tid & 31)) * 1.4426950408889634f;
    const float neg_a = -__expf(a.in[I_ALOG][h]), dtb = a.in[I_DTB][h];
    { const size_t row0 = (size_t)b * SEQ;
#pragma unroll
      for (int it = 0; it < 6; ++it) { const int idx = it * 512 + tid, r = idx / 48, pc = idx % 48, part = pc >> 4, piece = pc & 15;
          *(LAS u32x4*)(RAW + (3 + r) * 384 + part * 128 + piece * 8) = *(const u32x4*)(P1 + (row0 + r) * LDP + QOFF + part * 1024 + h * 128 + piece * 8); }
      if (wave == 0) { const int lane = lane_in; float v = neg_a * softplusf_(gbuf[(row0 + lane) * 8 + h] + dtb);
#pragma unroll
          for (int o = 1; o < 64; o <<= 1) { const float t = __shfl_up(v, o); if (lane >= o) v += t; }
          const float gl = __shfl(v, 63);
          VEC[lane] = v; VEC[64 + lane] = sigmoidf_(betabuf[(row0 + lane) * 8 + h]); VEC[128 + lane] = __expf(v); VEC[192 + lane] = __expf(gl - v); }
      LBAR(); }
#pragma unroll 1
    for (int c = 0; c < SEQ / 64; ++c) {
        int tid = tid_in; asm volatile("" : "+v"(tid));
        const int lane = tid & 63, lr = lane & 15, q4 = lane >> 4;
        const int pr = tid >> 3, pp = tid & 7;
        const size_t row0 = (size_t)b * SEQ + (size_t)c * 64;
        LAS float* GC = VEC + 256 * (c & 1); LAS float* BETA = GC + 64; LAS float* EG = GC + 128; LAS float* EGL = GC + 192;
        float pre_g = 0.f, pre_b = 0.f;
        if (wave == 1) { const size_t rown = (c + 1 < SEQ / 64) ? row0 + 64 : row0; pre_g = gbuf[(rown + lane) * 8 + h]; pre_b = betabuf[(rown + lane) * 8 + h]; }
        { const int cq = tid & 31, rg = tid >> 5;
#pragma unroll
          for (int part = 0; part < 3; ++part) {
              f32x4 x[7];
#pragma unroll
              for (int t = 0; t < 7; ++t) { const u32x2 w = *(const LAS u32x2*)(RAW + (4 * rg + t) * 384 + part * 128 + 4 * cq); x[t] = (f32x4){bflo(w.x), bfhi(w.x), bflo(w.y), bfhi(w.y)}; }
              LAS bf16* dst = (part == 0 ? QS : part == 1 ? KN : VS) + (4 * rg) * 136 + 4 * cq;
#pragma unroll
              for (int r = 0; r < 4; ++r) { f32x4 acc = cw[part][0] * x[r];
#pragma unroll
                  for (int tap = 1; tap < 4; ++tap) acc += cw[part][tap] * x[r + tap];
#pragma unroll
                  for (int e = 0; e < 4; ++e) { CHK(2, acc[e]); acc[e] = acc[e] * __builtin_amdgcn_rcpf(1.0f + __builtin_amdgcn_exp2f(-acc[e])); }
                  *(LAS u32x2*)(dst + r * 136) = (u32x2){cvt_pk_bf16(acc[0], acc[1]), cvt_pk_bf16(acc[2], acc[3])}; } } }
        LBAR();
        for (int i = tid; i < 3 * 48; i += 512) *(LAS u32x4*)(RAW + i * 8) = *(const LAS u32x4*)(RAW + 64 * 384 + i * 8);
        f32x4 dkq[4];
#pragma unroll
        for (int i = 0; i < 4; ++i) { const int tt = wave * 4 + i, which = tt >> 4, it = (tt & 15) >> 2, jt = tt & 3;
            f32x4 d = {0.f, 0.f, 0.f, 0.f};
            if (it >= jt) {
                const LAS bf16* Am = which ? QS : KN;
                bf16x8 fa[4], fb[4];
#pragma unroll
                for (int s = 0; s < 4; ++s) { fa[s] = frag_nat_v(Am, 136, 16 * it + lr, 32 * s + 8 * q4); fb[s] = frag_nat_v(KN, 136, 16 * jt + lr, 32 * s + 8 * q4); }
#pragma unroll
                for (int s = 0; s < 4; ++s) d = MFMA(fa[s], fb[s], d);
            }
            dkq[i] = d; CHK(4, d[0] + d[1] + d[2] + d[3]); }
        {
          const int it = wave & 3; f32x4 d;
          if (wave < 4) d = (it == 0) ? dkq[0] : (it == 1) ? dkq[1] : (it == 2) ? dkq[2] : dkq[3];
          else { d = (f32x4){0.f, 0.f, 0.f, 0.f};
              bf16x8 f[4];
#pragma unroll
              for (int s = 0; s < 4; ++s) f[s] = frag_nat_v(QS, 136, 16 * it + lr, 32 * s + 8 * q4);
#pragma unroll
              for (int s = 0; s < 4; ++s) d = MFMA(f[s], f[s], d); }
          const int j = lr & 3; const float v = (j == 0) ? d[0] : (j == 1) ? d[1] : (j == 2) ? d[2] : d[3];
          if (q4 == (lr >> 2)) { const float r = __builtin_amdgcn_rsqf(v + EPS * 2.0813689810056077f); if (wave < 4) RK[16 * it + lr] = r; else RQ[16 * it + lr] = r * 0.08838834764831845f; } }
        LBAR();
        if (wave < 4) {
#pragma unroll
            for (int i = 0; i < 4; ++i) { const int it = wave, jt = i; const int jc = 16 * jt + lr; const float gj = GC[jc];
                const f32x4 gi = *(const LAS f32x4*)(GC + 16 * it + 4 * q4), bi = *(const LAS f32x4*)(BETA + 16 * it + 4 * q4) * *(const LAS f32x4*)(RK + 16 * it + 4 * q4) * RK[jc]; f32x4 lv;
#pragma unroll
                for (int j = 0; j < 4; ++j) { const int ii = 16 * it + 4 * q4 + j; lv[j] = (ii > jc) ? bi[j] * dkq[i][j] * __expf(fminf(gi[j] - gj, 0.f)) : 0.f; }
                if (i == wave) {
#pragma unroll
                    for (int j = 0; j < 4; ++j) LD[wave * 320 + (4 * q4 + j) * 20 + lr] = lv[j]; }
                else {
#pragma unroll
                    for (int j = 0; j < 4; ++j) TL[(16 * it + 4 * q4 + j) * 72 + jc] = f2bf(lv[j]); } } }
        LBAR();
        if (wave >= 4) {
#pragma unroll
            for (int i = 0; i < 4; ++i) { const int tt = wave * 4 + i, it = (tt & 15) >> 2, jt = tt & 3; const int jc = 16 * jt + lr; const float gj = GC[jc];
                const f32x4 rq = *(const LAS f32x4*)(RQ + 16 * it + 4 * q4) * RK[jc], gi = *(const LAS f32x4*)(GC + 16 * it + 4 * q4);
#pragma unroll
                for (int j = 0; j < 4; ++j) { const int ii = 16 * it + 4 * q4 + j; const float dec = __expf(fminf(gi[j] - gj, 0.f));
                    PM[ii * 72 + jc] = f2bf((ii >= jc) ? dkq[i][j] * dec * rq[j] : 0.f); } } }
        u32x4 pre[6];
        { const size_t rown = (c + 1 < SEQ / 64) ? row0 + 64 : row0;
#pragma unroll
          for (int it = 0; it < 6; ++it) { const int r = tid >> 3, pc = (tid & 7) + 8 * it, part = pc >> 4, piece = pc & 15;
              pre[it] = *(const u32x4*)(P1 + (rown + r) * LDP + QOFF + part * 1024 + h * 128 + piece * 8); }
 }
        f32x4 O[4];
#define QS_BLOCK() do { bf16x8 sfq[4]; \
            _Pragma("unroll") for (int s = 0; s < 4; ++s) sfq[s] = pack8v(S[2 * s], S[2 * s + 1]); \
            _Pragma("unroll") for (int it = 0; it < 4; ++it) { f32x4 qs_ = {0.f, 0.f, 0.f, 0.f}; bf16x8 qsf[4]; \
                _Pragma("unroll") for (int s = 0; s < 4; ++s) qsf[s] = frag_perm(QS, 136, 16 * it + lr, 32 * s, q4); \
                _Pragma("unroll") for (int s = 0; s < 4; ++s) qs_ = MFMA(qsf[s], sfq[s], qs_); \
                const f32x4 sc = *(const LAS f32x4*)(EG + 16 * it + 4 * q4) * *(const LAS f32x4*)(RQ + 16 * it + 4 * q4); O[it] = qs_ * sc; } } while (0)
        if (wave == 1) { LAS float* GN = VEC + 256 * ((c + 1) & 1); float v = neg_a * softplusf_(pre_g + dtb);
#pragma unroll
            for (int o = 1; o < 64; o <<= 1) { const float t = __shfl_up(v, o); if (lane >= o) v += t; }
            const float gl = __shfl(v, 63);
            GN[lane] = v; GN[64 + lane] = sigmoidf_(pre_b); GN[128 + lane] = __expf(v); GN[192 + lane] = __expf(gl - v); }
        if (wave >= 1) QS_BLOCK();
        if (tid < 64) { const int d = tid >> 4, cc = tid & 15; float t[16];
#pragma unroll
            for (int g = 0; g < 8; ++g) { f32x4 l[2][4];
#pragma unroll
                for (int r = 0; r < 2; ++r)
#pragma unroll
                    for (int q = 0; q < 4; ++q) if (4 * q < 2 * g + r) l[r][q] = *(const volatile LAS f32x4*)(LD + d * 320 + (2 * g + r) * 20 + 4 * q);
#pragma unroll
                for (int r = 0; r < 2; ++r) { const int i = 2 * g + r; float s = 0.f;
#pragma unroll
                    for (int q = 0; q < 4; ++q) if (4 * q < i) {
#pragma unroll
                        for (int e = 0; e < 4; ++e) if (4 * q + e < i) s += l[r][q][e] * t[4 * q + e]; }
                    t[i] = (i > cc) ? -s : (i == cc ? 1.f : 0.f); } }
#pragma unroll
            for (int i = 0; i < 16; ++i) TL[(16 * d + i) * 72 + 16 * d + cc] = f2bf(t[i]); }
        LBAR();
        if (wave == 0) QS_BLOCK();
        if (wave == 2 || wave == 3) { const int lo = 32 * (wave - 2), hi = lo + 16; const f32x4 z4 = {0.f, 0.f, 0.f, 0.f};
            bf16x8 a1 = frag_nat(TL, 72, hi + lr, lo + 8 * q4); if (q4 >= 2) a1 = (bf16x8){0, 0, 0, 0, 0, 0, 0, 0};
            const f32x4 x = MFMA(a1, trfrag_nat(TL, 72, lo, lo, lr, q4), z4);
            const bf16x4 a2l = *(const LAS bf16x4*)(TL + (hi + lr) * 72 + hi + 4 * q4);
            const bf16x8 a2 = {a2l[0], a2l[1], a2l[2], a2l[3], 0, 0, 0, 0};
            const u32x4 bw = {cvt_pk_bf16(x[0], x[1]), cvt_pk_bf16(x[2], x[3]), 0u, 0u};
            const f32x4 r = MFMA(a2, __builtin_bit_cast(bf16x8, bw), z4);
#pragma unroll
            for (int j = 0; j < 4; ++j) TL[(hi + 4 * q4 + j) * 72 + lo + lr] = f2bf(-r[j]); }
        LBAR();
#pragma unroll
        for (int it = 0; it < 6; ++it) { const int r = tid >> 3, pc = (tid & 7) + 8 * it, part = pc >> 4, piece = pc & 15;
            *(LAS u32x4*)(RAW + (3 + r) * 384 + part * 128 + piece * 8) = pre[it]; }
        if (wave >= 4) { const int I = (wave - 4) >> 1, J = (wave - 4) & 1; const f32x4 z4 = {0.f, 0.f, 0.f, 0.f};
            const bf16x8 bt = trfrag_nat(TL, 72, 0, 16 * J, lr, q4);
            const f32x4 y0 = MFMA(frag_nat(TL, 72, 32 + lr, 8 * q4), bt, z4), y1 = MFMA(frag_nat(TL, 72, 48 + lr, 8 * q4), bt, z4);
            const f32x4 r = MFMA(frag_perm(TL, 72, 32 + 16 * I + lr, 32, q4), pack8v(y0, y1), z4);
            const int col = 16 * J + lr; const float bc = BETA[col], ec = bc * (EG[col] * RK[col]);
#pragma unroll
            for (int j = 0; j < 4; ++j) { const int row = 32 + 16 * I + 4 * q4 + j; TB[row * 72 + col] = f2bf(-r[j] * bc); TBG[row * 72 + col] = f2bf(-r[j] * ec); } }
        else {
#pragma unroll
            for (int n = 0; n < 2; ++n) { const int task = tid + 256 * n, i = task >> 3, j0 = (task & 7) * 8;
                if (n == 0 || j0 >= 32) { float t[8]; unpack8(*(const LAS u32x4*)(TL + i * 72 + j0), t);
                    f32x4 b0, b1, e0, e1;
#pragma unroll
                    for (int j = 0; j < 4; ++j) { b0[j] = t[j] * BETA[j0 + j]; b1[j] = t[4 + j] * BETA[j0 + 4 + j]; e0[j] = b0[j] * (EG[j0 + j] * RK[j0 + j]); e1[j] = b1[j] * (EG[j0 + 4 + j] * RK[j0 + 4 + j]); }
                    *(LAS u32x4*)(TB + i * 72 + j0) = pack8(b0, b1); *(LAS u32x4*)(TBG + i * 72 + j0) = pack8(e0, e1); } } }
        LBAR();
        f32x4 U[4];
        bf16x8 kf[2], vtf[2];
#pragma unroll
        for (int s = 0; s < 2; ++s) { kf[s] = trfrag_nat(KN, 136, 32 * s, 16 * wave, lr, q4); vtf[s] = trfrag_nat(VS, 136, 32 * s, 16 * wave, lr, q4); }
        bf16x8 tgf[4][2], tbf[4][2];
#pragma unroll
        for (int it = 0; it < 4; ++it)
#pragma unroll
            for (int s = 0; s < 2; ++s) { tgf[it][s] = frag_nat_v(TBG, 72, 16 * it + lr, 32 * s + 8 * q4); tbf[it][s] = frag_nat_v(TB, 72, 16 * it + lr, 32 * s + 8 * q4); }
#pragma unroll
        for (int it = 0; it < 4; ++it) { f32x4 d = {0.f, 0.f, 0.f, 0.f}, uu = {0.f, 0.f, 0.f, 0.f};
#pragma unroll
            for (int s = 0; s < 2; ++s) { d = MFMA(tgf[it][s], kf[s], d); uu = MFMA(tbf[it][s], vtf[s], uu); }
            U[it] = uu; CHK(6, d[0] + d[1] + d[2] + d[3]); CHK(7, uu[0] + uu[1] + uu[2] + uu[3]);
#pragma unroll
            for (int j = 0; j < 4; ++j) WW[(16 * it + 4 * q4 + j) * 136 + 16 * wave + lr] = f2bf(d[j]); }
        LBAR();
        const u32x4 zs0 = *(const u32x4*)(h2row(a.ws, row0 + pr) + h * 128 + 16 * pp), zs1 = *(const u32x4*)(h2row(a.ws, row0 + pr) + h * 128 + 16 * pp + 8);
        bf16x8 sf[4];
#pragma unroll
        for (int s = 0; s < 4; ++s) sf[s] = pack8v(S[2 * s], S[2 * s + 1]);
        f32x4 Vn[4];
        bf16x8 wwf[4][4];
#pragma unroll
        for (int it = 0; it < 4; ++it)
#pragma unroll
            for (int s = 0; s < 4; ++s) wwf[it][s] = frag_perm(WW, 136, 16 * it + lr, 32 * s, q4);
#pragma unroll
        for (int it = 0; it < 4; ++it) { f32x4 ws_ = {0.f, 0.f, 0.f, 0.f};
#pragma unroll
            for (int s = 0; s < 4; ++s) ws_ = MFMA(wwf[it][s], sf[s], ws_);
            Vn[it] = U[it] - ws_; CHK(8, ws_[0] + ws_[1] + ws_[2] + ws_[3]); }
        bf16x8 pmf[4][2];
#pragma unroll
        for (int it = 0; it < 4; ++it)
#pragma unroll
            for (int s = 0; s < 2; ++s) pmf[it][s] = frag_perm(PM, 72, 16 * it + lr, 32 * s, q4);
        bf16x8 vf[2], vfs[2];
#pragma unroll
        for (int s = 0; s < 2; ++s) { vf[s] = pack8v(Vn[2 * s], Vn[2 * s + 1]); f32x4 x, y;
#pragma unroll
            for (int j = 0; j < 4; ++j) { x[j] = Vn[2 * s][j] * (EGL[32 * s + 4 * q4 + j] * RK[32 * s + 4 * q4 + j]); y[j] = Vn[2 * s + 1][j] * (EGL[32 * s + 16 + 4 * q4 + j] * RK[32 * s + 16 + 4 * q4 + j]); }
            vfs[s] = pack8v(x, y); }
#pragma unroll
        for (int it = 0; it < 4; ++it)
#pragma unroll
            for (int s = 0; s < 2; ++s) O[it] = MFMA(pmf[it][s], vf[s], O[it]);
#pragma unroll
        for (int it = 0; it < 4; ++it) CHK(10, O[it][0] + O[it][1] + O[it][2] + O[it][3]);
        { const float gl = EG[63];
#pragma unroll
          for (int th = 0; th < 2; ++th) {
          bf16x8 ktf[4][2];
#pragma unroll
          for (int t = 0; t < 4; ++t)
#pragma unroll
              for (int s = 0; s < 2; ++s) ktf[t][s] = trfrag_perm(KN, 136, 32 * s, 16 * (4 * th + t), lr, q4);
          __builtin_amdgcn_sched_barrier(0);
#pragma unroll
          for (int tt = 0; tt < 4; ++tt) { const int t = 4 * th + tt; f32x4 d = S[t] * gl;
#pragma unroll
              for (int s = 0; s < 2; ++s) d = MFMA(ktf[tt][s], vfs[s], d);
              S[t] = d; CHK(11, d[0] + d[1] + d[2] + d[3]); } } }
        LBAR();
#pragma unroll
        for (int it = 0; it < 4; ++it)
#pragma unroll
            for (int j = 0; j < 4; ++j) OST[(16 * it + 4 * q4 + j) * 132 + 16 * wave + lr] = O[it][j];
        LBAR();
        { float o[16]; float ss = 0.f;
#pragma unroll
          for (int j = 0; j < 4; ++j) { const f32x4 t = *(const LAS f32x4*)(OST + pr * 132 + 16 * pp + 4 * j); o[4 * j] = t[0]; o[4 * j + 1] = t[1]; o[4 * j + 2] = t[2]; o[4 * j + 3] = t[3]; ss += (t[0] * t[0] + t[1] * t[1]) + (t[2] * t[2] + t[3] * t[3]); }
          ss += __shfl_xor(ss, 1); ss += __shfl_xor(ss, 2); ss += __shfl_xor(ss, 4);
          const float rstd = __builtin_amdgcn_rsqf(ss * (1.f / HD) + EPS * 2.0813689810056077f); CHK(12, ss); CHK(13, rstd);
          const LAS f32x4* wp = (const LAS f32x4*)(DNW + 16 * pp);
#pragma unroll
          for (int j = 0; j < 4; ++j) { const f32x4 t = wp[j]; o[4 * j] *= rstd * t[0]; o[4 * j + 1] *= rstd * t[1]; o[4 * j + 2] *= rstd * t[2]; o[4 * j + 3] *= rstd * t[3]; }
          { float z[16]; unpack8(zs0, z); unpack8(zs1, z + 8);
#pragma unroll
            for (int j = 0; j < 16; ++j) o[j] *= z[j]; }
          bf16* dst = P1 + (row0 + pr) * LDP + VOFF + h * 128 + 16 * pp;
          if (!dry) { *(u32x4*)dst = pack8((f32x4){o[0], o[1], o[2], o[3]}, (f32x4){o[4], o[5], o[6], o[7]});
          *(u32x4*)(dst + 8) = pack8((f32x4){o[8], o[9], o[10], o[11]}, (f32x4){o[12], o[13], o[14], o[15]}); } }
        LBAR();
    }
#if DBG_STAGE == 3

#endif
}

#ifndef KPRE
#define KPRE 16
#endif
__device__ __forceinline__ void attn_block(const Args& a, LAS unsigned char* lds, int b, int hh, int rb0, int nrb, int tid_in) {
    const bf16* QC = (const bf16*)((const unsigned char*)a.out + 128 * MiB); const bf16* Kc = (const bf16*)(a.ws + WS_KV); const bf16* VTg = (const bf16*)(a.ws + WS_VT); unsigned char* AO8 = a.ws + WS_P1;
    LAS bf16* KS = (LAS bf16*)lds;
    const char* Kb = (const char*)(Kc + (size_t)b * 256 * 2048 + hh * 256);
    const char* Vb = (const char*)(VTg + (size_t)(b * 4 + hh) * 256 * 256);
    { int tid = tid_in; asm volatile("" : "+v"(tid));
#pragma unroll
      for (int it = 0; it < 16; ++it) { const int idx = it * 512 + tid, key = idx >> 5, pc = idx & 31;
          *(LAS u32x4*)(KS + key * 264 + pc * 8) = *(const u32x4*)(Kb + (unsigned)(key * 4096 + pc * 16)); } }
    bf16x8 qf[2][8];
    { int tid = tid_in; asm volatile("" : "+v"(tid)); const int lr = tid & 15, q4 = (tid >> 4) & 3; const size_t qrow0 = (size_t)b * SEQ + (size_t)rb0 * 256 + 32 * (tid >> 6) + lr;
#pragma unroll
      for (int t = 0; t < 2; ++t)
#pragma unroll
          for (int s = 0; s < 8; ++s) qf[t][s] = *(const bf16x8*)(QC + (qrow0 + 16 * t) * D + hh * 256 + 64 * (s >> 1) + 16 * q4 + 8 * (s & 1)); }
#pragma unroll 1
    for (int u = 0; u < nrb; ++u) {
        int tid = tid_in; asm volatile("" : "+v"(tid));
        const int lane = tid & 63, lr = lane & 15, q4 = lane >> 4;
        u32x4 vpre[16];
#pragma unroll
        for (int it = 0; it < 16; ++it) { const int idx = it * 512 + tid, dv = idx >> 5, pc = idx & 31; vpre[it] = *(const u32x4*)(Vb + (unsigned)(dv * 512 + pc * 16)); }
        __syncthreads();
        bf16x8 pf[2][8]; float sum0 = 0.f, sum1 = 0.f;
#pragma unroll
        for (int s2 = 0; s2 < 8; ++s2) { f32x4 e[2][2];
#pragma unroll
            for (int hk = 0; hk < 2; ++hk) { const int kt = 2 * s2 + hk; f32x4 d0 = {0.f, 0.f, 0.f, 0.f}, d1 = {0.f, 0.f, 0.f, 0.f};
                bf16x8 kf[8];
#pragma unroll
                for (int s = 0; s < 8; ++s) kf[s] = frag_nat_v(KS, 264, 16 * kt + lr, 64 * (s >> 1) + 16 * q4 + 8 * (s & 1));
#pragma unroll
                for (int s = 0; s < 8; ++s) { d0 = MFMA(kf[s], qf[0][s], d0); d1 = MFMA(kf[s], qf[1][s], d1); }
#pragma unroll
                for (int j = 0; j < 4; ++j) { const float e0 = __builtin_amdgcn_exp2f(__builtin_amdgcn_fmed3f(d0[j] * 1.4426950408889634f, -126.f, 115.f)), e1 = __builtin_amdgcn_exp2f(__builtin_amdgcn_fmed3f(d1[j] * 1.4426950408889634f, -126.f, 115.f)); e[0][hk][j] = e0; e[1][hk][j] = e1; sum0 += e0; sum1 += e1; } }
            pf[0][s2] = pack8v(e[0][0], e[0][1]); pf[1][s2] = pack8v(e[1][0], e[1][1]); }
        sum0 += __shfl_xor(sum0, 16); sum0 += __shfl_xor(sum0, 32); sum1 += __shfl_xor(sum1, 16); sum1 += __shfl_xor(sum1, 32);
        const float inv0 = __builtin_amdgcn_rcpf(sum0) * F8_SAO, inv1 = __builtin_amdgcn_rcpf(sum1) * F8_SAO;
        __syncthreads();
        int tid2 = tid_in; asm volatile("" : "+v"(tid2));
#pragma unroll
        for (int it = 0; it < 16; ++it) { const int idx = it * 512 + tid2, dv = idx >> 5, pc = idx & 31;
            const int ldr = (dv & ~63) | (((dv >> 2) & 3) << 4) | (((dv >> 4) & 3) << 2) | (dv & 3);
            *(LAS u32x4*)(KS + ldr * 264 + pc * 8) = vpre[it]; }
#pragma unroll
        for (int it = 16; it < 16; ++it) { const int idx = it * 512 + tid2, dv = idx >> 5, pc = idx & 31;
            *(LAS u32x4*)(KS + dv * 264 + pc * 8) = *(const u32x4*)(Vb + (unsigned)(dv * 512 + pc * 16)); }
        __syncthreads();
        const bool more = (u + 1 < nrb);
        u32x4 kpre[KPRE];
#pragma unroll
        for (int it = 0; it < KPRE; ++it) { const int idx = it * 512 + tid2, key = idx >> 5, pc = idx & 31; kpre[it] = *(const u32x4*)(Kb + (unsigned)(key * 4096 + pc * 16)); }
        bf16x8 qn[2][8];
        { const size_t qrown = (size_t)b * SEQ + (size_t)(rb0 + (more ? u + 1 : u)) * 256 + 32 * (tid2 >> 6) + (tid2 & 15);
#pragma unroll
          for (int t = 0; t < 2; ++t)
#pragma unroll
              for (int s = 0; s < 8; ++s) qn[t][s] = *(const bf16x8*)(QC + (qrown + 16 * t) * D + hh * 256 + 64 * (s >> 1) + 16 * ((tid2 >> 4) & 3) + 8 * (s & 1)); }
        const int lr2 = tid2 & 15, q42 = (tid2 >> 4) & 3; const size_t qrow2 = (size_t)b * SEQ + (size_t)(rb0 + u) * 256 + 32 * (tid2 >> 6) + lr2;
#pragma unroll 1
        for (int dg = 0; dg < 4; ++dg) { unsigned o0[4], o1[4];
#pragma unroll
            for (int dl = 0; dl < 4; ++dl) { f32x4 d0 = {0.f, 0.f, 0.f, 0.f}, d1 = {0.f, 0.f, 0.f, 0.f};
                bf16x8 vf[8];
#pragma unroll
                for (int s = 0; s < 8; ++s) vf[s] = frag_perm(KS, 264, 64 * dg + 16 * dl + lr2, 32 * s, q42);
#pragma unroll
                for (int s = 0; s < 8; ++s) { d0 = MFMA(vf[s], pf[0][s], d0); d1 = MFMA(vf[s], pf[1][s], d1); }
                d0 *= inv0; d1 *= inv1;
                o0[dl] = pk4_fp8(d0[0], d0[1], d0[2], d0[3]); o1[dl] = pk4_fp8(d1[0], d1[1], d1[2], d1[3]);
                __builtin_amdgcn_sched_barrier(0); }
            *(u32x4*)(AO8 + qrow2 * D + hh * 256 + 64 * dg + 16 * q42) = (u32x4){o0[0], o0[1], o0[2], o0[3]};
            *(u32x4*)(AO8 + (qrow2 + 16) * D + hh * 256 + 64 * dg + 16 * q42) = (u32x4){o1[0], o1[1], o1[2], o1[3]}; }
        __syncthreads();
#pragma unroll
        for (int it = 0; it < KPRE; ++it) { const int idx = it * 512 + tid2, key = idx >> 5, pc = idx & 31; *(LAS u32x4*)(KS + key * 264 + pc * 8) = kpre[it]; }
        if (more) {
#pragma unroll
            for (int it = KPRE; it < 16; ++it) { const int idx = it * 512 + tid2, key = idx >> 5, pc = idx & 31; *(LAS u32x4*)(KS + key * 264 + pc * 8) = *(const u32x4*)(Kb + (unsigned)(key * 4096 + pc * 16)); } }
#pragma unroll
        for (int t = 0; t < 2; ++t)
#pragma unroll
            for (int s = 0; s < 8; ++s) qf[t][s] = qn[t][s];
    }
    __syncthreads();
}

constexpr int RT_LG = 0, RT_CNT = 49152, RT_WH = 53248, RT_WL = 95488;
__device__ __forceinline__ void router_iter(const Args& a, LAS unsigned char* lds, int row0, bool live, int tid, int wave, int lane, unsigned* cnt) {
    const float* w3 = a.in[I_NORM3];
    const bf16* WH = (const bf16*)(a.ws + WS_WRT); const bf16* WL = WH + 80 * 1024;
    float* rstd3 = (float*)(a.ws + WS_RSTD3); int* toke = (int*)(a.ws + WS_TOKE); float* tokw = (float*)(a.ws + WS_TOKW); int* tokp = (int*)(a.ws + WS_TOKP);
    LAS float* LG = (LAS float*)(lds + RT_LG + wave * 6144); LAS int* LCNT = (LAS int*)(lds + RT_CNT); LAS int* LBASE = LCNT + 64;
    LAS bf16* WHs = (LAS bf16*)(lds + RT_WH); LAS bf16* WLs = (LAS bf16*)(lds + RT_WL);
    const int lr = lane & 15, q4 = lane >> 4;
    const bf16* hp = h2row(a.ws, (size_t)((live ? row0 : 0) + lr)) + 8 * q4;
    if (tid < 64) LCNT[tid] = 0;
    float ss = 0.f;
#pragma unroll 8
    for (int kb = 0; kb < 32; ++kb) { float xf[8]; unpack8(*(const u32x4*)(hp + 32 * kb), xf); const f32x4 x0 = {xf[0], xf[1], xf[2], xf[3]}, x1 = {xf[4], xf[5], xf[6], xf[7]};
        ss += (x0[0] * x0[0] + x0[1] * x0[1]) + (x0[2] * x0[2] + x0[3] * x0[3]) + (x1[0] * x1[0] + x1[1] * x1[1]) + (x1[2] * x1[2] + x1[3] * x1[3]); }
    ss += __shfl_xor(ss, 16); ss += __shfl_xor(ss, 32);
    const float rstd = 1.0f / sqrtf(ss * (1.f / D) + EPS);
    if (live && q4 == 0) rstd3[row0 + lr] = rstd;
    f32x4 acc[5];
#pragma unroll
    for (int ct = 0; ct < 5; ++ct) acc[ct] = (f32x4){0.f, 0.f, 0.f, 0.f};
#pragma unroll 1
    for (int kq = 0; kq < 4; ++kq) {
        __syncthreads();
#pragma unroll
        for (int i = 0; i < 10; ++i) { const int idx = i * 512 + tid, arr = idx / 2560, rem = idx % 2560, row = rem >> 5, pc = rem & 31;
            *(LAS u32x4*)((arr ? WLs : WHs) + row * 264 + pc * 8) = *(const u32x4*)((arr ? WL : WH) + row * 1024 + kq * 256 + pc * 8); }
        __syncthreads();
#pragma unroll 2
        for (int kb2 = 0; kb2 < 8; ++kb2) { const int kb = kq * 8 + kb2;
            float xf[8]; unpack8(*(const u32x4*)(hp + 32 * kb), xf); const f32x4 x0 = {xf[0], xf[1], xf[2], xf[3]}, x1 = {xf[4], xf[5], xf[6], xf[7]};
            const f32x4 g0 = *(const f32x4*)(w3 + 32 * kb + 8 * q4), g1 = *(const f32x4*)(w3 + 32 * kb + 8 * q4 + 4);
            const f32x4 u0 = x0 * rstd * g0, u1 = x1 * rstd * g1;
            const u32x4 hi = pack8(u0, u1); float hf[8]; unpack8(hi, hf);
            const f32x4 l0 = {u0[0] - hf[0], u0[1] - hf[1], u0[2] - hf[2], u0[3] - hf[3]}, l1 = {u1[0] - hf[4], u1[1] - hf[5], u1[2] - hf[6], u1[3] - hf[7]};
            const bf16x8 ah = __builtin_bit_cast(bf16x8, hi), al = pack8v(l0, l1);
#pragma unroll
            for (int ct = 0; ct < 5; ++ct) { const bf16x8 bh = frag_nat(WHs, 264, 16 * ct + lr, 32 * kb2 + 8 * q4), bl = frag_nat(WLs, 264, 16 * ct + lr, 32 * kb2 + 8 * q4);
                acc[ct] = MFMA(ah, bh, acc[ct]); acc[ct] = MFMA(ah, bl, acc[ct]); acc[ct] = MFMA(al, bh, acc[ct]); }
        }
    }
#pragma unroll
    for (int ct = 0; ct < 5; ++ct)
#pragma unroll
        for (int j = 0; j < 4; ++j) LG[(4 * q4 + j) * 81 + 16 * ct + lr] = acc[ct][j];
    LDS_WAIT(); asm volatile("" ::: "memory");
    int e0 = 0, e1 = 0, k0 = 0, k1 = 0;
    if (live && lane < 16) {
        const LAS float* lg = LG + lane * 81; const float* bg = a.in[I_BRG]; const float* be = a.in[I_BRE];
        float gl[8]; int grp = 0; float gm = -3.0e38f;
        const f32x4 bg0 = *(const f32x4*)bg, bg1 = *(const f32x4*)(bg + 4); const float bgv[8] = {bg0[0], bg0[1], bg0[2], bg0[3], bg1[0], bg1[1], bg1[2], bg1[3]};
#pragma unroll
        for (int j = 0; j < 8; ++j) { gl[j] = lg[j] + bgv[j]; if (gl[j] > gm) { gm = gl[j]; grp = j; } }
        float gs = 0.f;
#pragma unroll
        for (int j = 0; j < 8; ++j) gs += __expf(gl[j] - gm);
        const float pg = 1.0f / gs;
        float el[8]; float m1 = -3.0e38f, m2 = -3.0e38f; int i1 = 0, i2 = 0;
        const f32x4 be0 = *(const f32x4*)(be + grp * 8), be1 = *(const f32x4*)(be + grp * 8 + 4); const float bev[8] = {be0[0], be0[1], be0[2], be0[3], be1[0], be1[1], be1[2], be1[3]};
#pragma unroll
        for (int j = 0; j < 8; ++j) { el[j] = lg[8 + grp * 8 + j] + bev[j];
            if (el[j] > m1) { m2 = m1; i2 = i1; m1 = el[j]; i1 = j; } else if (el[j] > m2) { m2 = el[j]; i2 = j; } }
        const float e2 = __expf(m2 - m1); const float t1 = 1.0f / (1.0f + e2), t2 = e2 / (1.0f + e2);
        const int tok = row0 + lane;
        e0 = grp * 8 + i1; e1 = grp * 8 + i2;
        toke[2 * tok] = e0; toke[2 * tok + 1] = e1; tokw[2 * tok] = pg * t1; tokw[2 * tok + 1] = pg * t2;
        k0 = atomicAdd((int*)(LCNT + e0), 1); k1 = atomicAdd((int*)(LCNT + e1), 1);
    }
    __syncthreads();
    if (tid < 64) { const int c = LCNT[tid]; LBASE[tid] = c ? (int)atomicAdd(cnt + tid, (unsigned)c) : 0; }
    __syncthreads();
    if (live && lane < 16) { const int tok = row0 + lane; tokp[2 * tok] = LBASE[e0] + k0; tokp[2 * tok + 1] = LBASE[e1] + k1; }
}

__device__ __forceinline__ int build_moe_tables(const Args& a, LAS unsigned char* lds, int tid) {
    LAS int* OFF = (LAS int*)(lds + LDS_T2E + 1024); LAS unsigned char* T2E = lds + LDS_T2E;
    const unsigned* cnt = (const unsigned*)(a.ws + WS_CTL) + CW_CNT;
    if (tid < 64) {
        const int nt = ((int)cnt[tid] + 255) >> 8; int v = nt;
#pragma unroll
        for (int o = 1; o < 64; o <<= 1) { const int t = __shfl_up(v, o); if (tid >= o) v += t; }
        const int start = v - nt;
        OFF[tid] = start << 8; if (tid == 63) OFF[NEXP] = v << 8;
        for (int t = 0; t < nt; ++t) T2E[start + t] = (unsigned char)tid;
    }
    __syncthreads();
    return OFF[NEXP] >> 8;
}

__global__ void __launch_bounds__(512, 2) fwd(Args a) {
    extern __shared__ __attribute__((aligned(16))) unsigned char lds_raw[];
    LAS unsigned char* lds = (LAS unsigned char*)lds_raw;
    const int tid = threadIdx.x, lane = tid & 63, wave = __builtin_amdgcn_readfirstlane(tid >> 6);
    const int G = gridDim.x;
    unsigned char* ws = a.ws;
    volatile LAS unsigned* MISC = (volatile LAS unsigned*)(lds + LDS_MISC);
    if (tid < 16) MISC[tid] = 0u;
    __syncthreads();
    unsigned* ctl = (unsigned*)(ws + WS_CTL);
    XcdBarrier bar; bar.bar = ctl + CW_BAR; bar.x = 0; bar.st = MISC;
    if (MK_N_LAUNCHES == 1) bar = xcd_barrier_post(ctl + CW_BAR, MISC);
    const int lo = a.ph_lo, hi = a.ph_hi;
#if DBG_STAGE == 5
    if (blockIdx.x == 0 && tid == 0) ((unsigned long long*)(ctl + 64))[0] = wall_clock64();
#endif
#ifndef PH_MASK
#define PH_MASK 0x7fff
#endif
#define IN(k) (((PH_MASK >> (k)) & 1) && lo <= (k) && (k) < hi)
#if DBG_STAGE == 5
#define SEAM(k) do { if (IN(k) && IN((k) + 1)) xcd_barrier(bar); if (blockIdx.x == 0 && tid == 0) ((unsigned long long*)(ctl + 64))[(k) + 1] = wall_clock64(); } while (0)
#else
#define SEAM(k) do { if (IN(k) && IN((k) + 1)) xcd_barrier(bar); } while (0)
#endif
    bf16* P1 = (bf16*)(ws + WS_P1);
    const pg8::Gemm g1024{D, D, D};

    if (IN(0)) REPEAT(0) { p0_prologue(a, lds, G, tid, wave, lane); REPSYNC(0); } SEAM(0);
    if (IN(1)) REPEAT(1) {
#ifndef NO_G1A
        { pg8::DenseOrder2 S; S.init(NTOK / 256, N1A / 256 + 4, G, blockIdx.x, a.out, D, ws + WS_B1A, D); S.B2 = (const char*)(ws + WS_B1B); S.nsplit = N1A / 256;
          pg8::EpiPerm<F1a> E{{P1, (float*)(ws + WS_G), (float*)(ws + WS_BETA), ws}};
          pg8::gemm_phase(lds, g1024, S, E); }
#endif
        REPSYNC(1);
    } SEAM(1);
    if (IN(2)) {
        const int blk = blockIdx.x; const bool wide = (G >= 256); const bool dry = false;
        { const int first = wide ? (blk < 128 ? blk : 128) : blk, step = wide ? 128 : G;
          for (int u = first; u < 128; u += step) { gdn_unit(a, lds, u >> 3, u & 7, tid, wave, lane, dry); __syncthreads(); } }
        { const int first = wide ? ((blk >= 128 && blk < 256) ? blk - 128 : 160) : blk, step = wide ? 128 : G;
          for (int u = first; u < 160; u += step) { rg_unit(a, lds, u / 10, u % 10, tid, wave, lane, dry); __syncthreads(); } }
        const int Gp = wide ? G - 128 : G, cp = wide ? blk - 128 : blk;
        if (!wide || blk >= 128) {
            pg8::DenseOrder S; S.init(NB * NMEM / 256, 2 * D / 256, Gp, cp, ws + WS_MEMN, D, ws + WS_WKVT, D);
            pg8::EpiPerm<FBf> E{{(bf16*)(ws + WS_KV), 2 * D}};
            pg8::gemm_phase(lds, g1024, S, E); }
        {
          pg8::RangeOrder S; S.init(NTOK / 256, 2 * D / 256, 1, 0, (unsigned char*)a.out + 128 * MiB, D, ws + WS_B1B + 2 * MiB, D, 1);
          if (wide) { const int j = blk - 160;
              S.start = blk >= 160 ? 18 * j : blk >= 128 ? 1728 + 6 * (blk - 128) : 1920 + blk;
              S.count = blk >= 160 ? 18 : blk >= 128 ? 6 : 1; }
          else { const int per = (2048 + G - 1) / G; S.start = blk * per; S.count = per; }
          pg8::EpiPerm<FGate> E{{(unsigned char*)a.out}};
          pg8::gemm_phase<pg8::EpiPerm<FGate>, pg8::RangeOrder, true>(lds, g1024, S, E); }
        __syncthreads();
        if (!wide) expert_convert(a, lds, cp * 8 + wave, Gp * 8, wave, lane);
        else if (blk >= 160) expert_convert(a, lds, (blk - 160) * 8 + wave, 96 * 8, wave, lane);
#if DBG_STAGE == 5
        if (tid == 0) ((unsigned long long*)(ctl + 1024))[blockIdx.x] = wall_clock64();
#endif
    } SEAM(2);
    if (IN(3)) {
        {
          const bf16* KV = (const bf16*)(ws + WS_KV); bf16* VT = (bf16*)(ws + WS_VT); LAS bf16* T = (LAS bf16*)(lds + wave * 9216);
          for (int it = blockIdx.x * 8 + wave; it < NB * CAH * 16; it += G * 8) { const int bh = it >> 4, kb = (it >> 2) & 3, db = it & 3, b_ = bh >> 2, h_ = bh & 3;
              const bf16* src = KV + ((size_t)b_ * 256 + 64 * kb + lane) * 2048 + 1024 + h_ * 256 + 64 * db;
#pragma unroll
              for (int q = 0; q < 8; ++q) { const u32x4 w = *(const u32x4*)(src + 8 * q); const unsigned ww[4] = {w.x, w.y, w.z, w.w};
#pragma unroll
                  for (int j = 0; j < 4; ++j) { T[(8 * q + 2 * j) * 72 + lane] = (bf16)(ww[j] & 0xffffu); T[(8 * q + 2 * j + 1) * 72 + lane] = (bf16)(ww[j] >> 16); } }
              LDS_WAIT(); asm volatile("" ::: "memory");
              bf16* dst = VT + ((size_t)bh * 256 + 64 * db + lane) * 256 + 64 * kb;
#pragma unroll
              for (int q = 0; q < 8; ++q) *(u32x4*)(dst + 8 * q) = *(const LAS u32x4*)(T + lane * 72 + 8 * q);
              LDS_WAIT(); asm volatile("" ::: "memory"); }
          __syncthreads(); }
    }
    if (IN(4)) {
        { pg8::DenseOrder S; S.init(NTOK / 256, D / 256, G, blockIdx.x, P1 + RXOFF, LDP, ws + WS_WAT, DRNN);
          pg8::EpiPerm2<F2a> E{{(bf16*)((unsigned char*)a.out + 128 * MiB), (const unsigned char*)a.out}}; pg8::gemm_phase(lds, pg8::Gemm{LDP, DRNN, DRNN}, S, E); }
        { pg8::DenseOrder S; S.init(NTOK / 256, D / 256, G, blockIdx.x, P1 + VOFF, LDP, ws + WS_WBT, D);
          pg8::EpiPerm2<F2b> E{{(bf16*)((unsigned char*)a.out + 128 * MiB), (const unsigned char*)a.out}}; pg8::gemm_phase(lds, pg8::Gemm{LDP, D, D}, S, E); }
    } SEAM(4);
    if (IN(5)) {
        pg8::DenseOrder S; S.init(NTOK / 256, D / 256, G, blockIdx.x, (unsigned char*)a.out + 128 * MiB, D, ws + WS_WOT, D);
        EpiH1 E{a.in[I_X], (bf16*)a.out, D, (float*)(ws + WS_SSQ), ws + WS_H2A}; pg8::gemm_phase(lds, g1024, S, E);
    } SEAM(5);
    if (IN(7)) {
        pg8::DenseOrder S; S.init(NTOK / 256, D / 256, G, blockIdx.x, ws + WS_H2A, D, ws + WS_WCQT, D, 1);
        pg8::EpiPerm2<FQc> E{{(bf16*)((unsigned char*)a.out + 128 * MiB), (const float*)(ws + WS_SSQ)}}; pg8::gemm_phase<pg8::EpiPerm2<FQc>, pg8::DenseOrder, true>(lds, g1024, S, E);
    } SEAM(7);
    if (IN(8)) REPEAT(8) {
        constexpr int NU = NB * CAH * 16; const int per = (NU + G - 1) / G;
#pragma unroll 1
        for (int i = 0; i < per; ) { const int id = blockIdx.x * per + i; if (id >= NU) break;
            const int left = 16 - (id & 15), n = (per - i) < left ? (per - i) : left; attn_block(a, lds, id >> 6, (id >> 4) & 3, id & 15, n, tid); i += n; }
        REPSYNC(8);
    } SEAM(8);
    if (IN(9)) {
        pg8::DenseOrder S; S.init(NTOK / 256, D / 256, G, blockIdx.x, ws + WS_P1, D, ws + WS_WCOT, D, 1);
        EpiH2 E{(const bf16*)a.out, ws}; pg8::gemm_phase<EpiH2, pg8::DenseOrder, true>(lds, g1024, S, E);
    } SEAM(9);
    if (IN(10)) {
        unsigned* cnt = ctl + CW_CNT;
        const int niter = (NTOK + G * 128 - 1) / (G * 128);
        for (int it = 0; it < niter; ++it) { const int r0 = (blockIdx.x * 8 + wave) * 16 + it * G * 128; router_iter(a, lds, r0, r0 < NTOK, tid, wave, lane, cnt); __syncthreads(); }
    } SEAM(10);
    if (IN(11)) {
        build_moe_tables(a, lds, tid);
        const LAS int* OFF = (const LAS int*)(lds + LDS_T2E + 1024);
        const int* toke = (const int*)(ws + WS_TOKE); const int* tokp = (const int*)(ws + WS_TOKP); int* s2tk = (int*)(ws + WS_S2TK);
        const float* rstd3 = (const float*)(ws + WS_RSTD3); unsigned char* XS = ws + WS_XS;
        f32x4 gw[4];
#pragma unroll
        for (int j = 0; j < 4; ++j) gw[j] = ((const f32x4*)a.in[I_NORM3] + lane)[64 * j];
        for (int m = blockIdx.x * 8 + wave; m < NTOK; m += 2 * G * 8) {
            const int mB = m + G * 8; const bool hasB = mB < NTOK; const int mb = hasB ? mB : m;
            u32x2 hA[4], hB[4];
            { const u32x2* xa = (const u32x2*)h2row(ws, (size_t)m) + lane; const u32x2* xb = (const u32x2*)h2row(ws, (size_t)mb) + lane;
#pragma unroll
              for (int j = 0; j < 4; ++j) { hA[j] = xa[64 * j]; hB[j] = xb[64 * j]; } }
            const float rA = rstd3[m] * F8_SA, rB = rstd3[mb] * F8_SA;
            int s0 = 0, s1 = 0;
            if (lane < 2) { const int mm = lane ? mb : m; s0 = OFF[toke[2 * mm]] + tokp[2 * mm]; s1 = OFF[toke[2 * mm + 1]] + tokp[2 * mm + 1]; if (lane == 0 || hasB) { s2tk[s0] = 2 * mm; s2tk[s1] = 2 * mm + 1; } }
            const int a0 = __shfl(s0, 0), a1 = __shfl(s1, 0), b0 = __shfl(s0, 1), b1 = __shfl(s1, 1);
            { unsigned* o0 = (unsigned*)(XS + (size_t)a0 * D) + lane; unsigned* o1 = (unsigned*)(XS + (size_t)a1 * D) + lane;
#pragma unroll
              for (int j = 0; j < 4; ++j) { const u32x2 hw = hA[j]; const f32x4 v = (f32x4){bflo(hw.x), bfhi(hw.x), bflo(hw.y), bfhi(hw.y)} * rA * gw[j]; const unsigned o = pk4_fp8(v[0], v[1], v[2], v[3]); o0[64 * j] = o; o1[64 * j] = o; } }
            if (hasB) { unsigned* o0 = (unsigned*)(XS + (size_t)b0 * D) + lane; unsigned* o1 = (unsigned*)(XS + (size_t)b1 * D) + lane;
#pragma unroll
              for (int j = 0; j < 4; ++j) { const u32x2 hw = hB[j]; const f32x4 v = (f32x4){bflo(hw.x), bfhi(hw.x), bflo(hw.y), bfhi(hw.y)} * rB * gw[j]; const unsigned o = pk4_fp8(v[0], v[1], v[2], v[3]); o0[64 * j] = o; o1[64 * j] = o; } }
        }
    } SEAM(11);
    if (IN(12)) {
        const int nT = build_moe_tables(a, lds, tid);
        pg8::MoeOrder S; S.init(nT, 4, G, blockIdx.x, ws + WS_XS, D, ws + WS_WGU, D, 1); S.t2e = lds + LDS_T2E; S.ebytes = (size_t)1024 * 1024;
        pg8::EpiPerm<FM1> E{{ws + WS_HID}}; pg8::gemm_phase<pg8::EpiPerm<FM1>, pg8::MoeOrder, true>(lds, g1024, S, E);
    } SEAM(12);
#if DBG_STAGE == 3
    if (IN(13)) {
        unsigned flags = 0;
        for (size_t m = blockIdx.x * 8 + wave; m < (size_t)NTOK; m += G * 8) { const bf16* rowp = P1 + m * LDP;
            for (int cidx = lane; cidx < LDP; cidx += 64) { const unsigned v = rowp[cidx]; if ((v & 0x7f80u) == 0x7f80u) flags |= (cidx < 1280 ? 1u : cidx < 2560 ? 8u : cidx < 4608 ? 4u : 2u); } }
        for (size_t i = (size_t)blockIdx.x * 512 + tid; i < (size_t)NTOK * D; i += (size_t)G * 512) { const float v = a.out[i]; if (!(fabsf(v) < 1e30f)) flags |= 16u; else if (fabsf(v) > 100.f) flags |= 32u; }
        if (flags) atomicOr((unsigned*)(ws + WS_CTL) + 16, flags);
    }
    if (0) {
#else
    if (IN(13)) {
#endif
        const int nT = build_moe_tables(a, lds, tid);
        pg8::MoeOrder S; S.init(nT, 4, G, blockIdx.x, ws + WS_HID, DEXP, ws + WS_WD, DEXP, 1); S.t2e = lds + LDS_T2E; S.ebytes = (size_t)1024 * 512;
        pg8::EpiPerm2<FM2> E{{ws + WS_YE, (const int*)(ws + WS_S2TK), (const float*)(ws + WS_TOKW)}}; pg8::gemm_phase<pg8::EpiPerm2<FM2>, pg8::MoeOrder, true>(lds, pg8::Gemm{DEXP, DEXP, DEXP}, S, E);
    } SEAM(13);
    if (IN(14)) {
        const unsigned char* YE = ws + WS_YE;
#if DBG_STAGE == 6
        {
          typedef int v8i_ __attribute__((ext_vector_type(8)));
          f32x4 d1 = {0.f, 0.f, 0.f, 0.f}, d2 = {0.f, 0.f, 0.f, 0.f};
          { v8i_ A, B; float two = 2.f, onehalf = 1.5f; asm volatile("" : "+v"(two), "+v"(onehalf));
            const int pa = (int)pk4_fp8(two, two, two, two), pb = (int)pk4_fp8(onehalf, onehalf, onehalf, onehalf);
#pragma unroll
            for (int q = 0; q < 8; ++q) { A[q] = pa; B[q] = pb; }
            d1 = __builtin_amdgcn_mfma_scale_f32_16x16x128_f8f6f4(A, B, d1, 0, 0, 0, 0, 0, 0); }
          for (int g0 = 0; g0 < 4; ++g0) for (int e0 = 0; e0 < 32; ++e0) { v8i_ A, B;
#pragma unroll
              for (int q = 0; q < 8; ++q) { const bool hit = ((lane >> 4) == g0) && (q == (e0 >> 2)); A[q] = hit ? (0x40 << (8 * (e0 & 3))) : 0; B[q] = hit ? (0x3c << (8 * (e0 & 3))) : 0; }
              asm volatile("v_mfma_f32_16x16x128_f8f6f4 %0, %1, %2, %0\n\ts_nop 15\n\ts_nop 15\n\ts_nop 15" : "+v"(d2) : "v"(A), "v"(B)); }
          const float dv = 4.f + ((d1[0] == 384.f && d1[3] == 384.f) ? 1.f : 0.f) + ((d2[0] == 384.f && d2[3] == 384.f) ? 2.f : 0.f);
          for (int m = blockIdx.x * 8 + wave; m < NTOK; m += G * 8) { f32x4* xr = (f32x4*)(a.out + (size_t)m * D) + lane;
#pragma unroll
              for (int j = 0; j < 4; ++j) xr[64 * j] = (f32x4){dv, dv, dv, dv}; } }
        if (0)
#endif
#if DBG_STAGE == 5
        { const unsigned long long* st = (const unsigned long long*)(ctl + 64); const unsigned long long* pb = (const unsigned long long*)(ctl + 1024);
          unsigned long long gmax = 0, rmax = 0; for (int i = 0; i < 128; ++i) { if (pb[i] > gmax) gmax = pb[i]; if (pb[128 + i] > rmax) rmax = pb[128 + i]; }
          float tv[2]; const int sel[2] = {PROBE_A, PROBE_B};
          for (int q = 0; q < 2; ++q) { const int p = sel[q]; unsigned long long d;
              if (p == 100) d = gmax - st[2]; else if (p == 101) d = rmax - st[2]; else if (p >= 200) d = st[(p - 200) % 20 + 1] - st[(p - 200) / 20]; else d = st[p + 1] - st[p];
              tv[q] = (float)d * 0.01f; }
          const float v1 = 1.5f * (rintf(2.f * log2f(fmaxf(tv[0], 1.f))) * 0.5f), v2 = 30.f + 2.0f * (rintf(2.f * log2f(fmaxf(tv[1], 1.f))) * 0.5f);
          for (int m = blockIdx.x * 8 + wave; m < NTOK; m += G * 8) { f32x4* xr = (f32x4*)(a.out + (size_t)m * D) + lane;
#pragma unroll
              for (int j = 0; j < 4; ++j) xr[64 * j] = (f32x4){v1, v1, v1, v1};
              if (m == 0 && lane == 0) a.out[0] = v2; } }
        if (0)
#endif
#if DBG_STAGE == 3
        { const int dvi = ((const int*)(ws + WS_CTL))[16]; const float dv = dvi ? (float)dvi : 50.f;
          for (int m = blockIdx.x * 8 + wave; m < NTOK; m += G * 8) { f32x4* xr = (f32x4*)(a.out + (size_t)m * D) + lane;
#pragma unroll
              for (int j = 0; j < 4; ++j) xr[64 * j] = (f32x4){dv, dv, dv, dv}; } }
        if (0)
#endif
        for (int m = blockIdx.x * 8 + wave; m < NTOK; m += G * 8) {
            f32x4* xr = (f32x4*)(a.out + (size_t)m * D) + lane; const f32x4* wr_ = (const f32x4*)a.in[I_NORMF] + lane;
            const f32x4* xin = (DBG_STAGE == 1) ? (const f32x4*)(a.in[I_X] + (size_t)m * D) + lane : (const f32x4*)xr;
            const unsigned* y0 = (const unsigned*)(YE + (size_t)(2 * m) * D) + lane; const unsigned* y1 = (const unsigned*)(YE + (size_t)(2 * m + 1) * D) + lane;
            f32x4 v[4], gw[4]; float s = 0.f;
#pragma unroll
            for (int j = 0; j < 4; ++j) gw[j] = wr_[64 * j];
            const u32x2* h2p = (const u32x2*)h2row(ws, (size_t)m) + lane;
#pragma unroll
            for (int j = 0; j < 4; ++j) { f32x4 t; if (DBG_STAGE == 0) { const u32x2 hw = h2p[64 * j]; t = (f32x4){bflo(hw.x), bfhi(hw.x), bflo(hw.y), bfhi(hw.y)}; } else t = xin[64 * j];
                if (DBG_STAGE == 0) { const unsigned p = y0[64 * j], q = y1[64 * j];
                    const f32x2 p0 = __builtin_amdgcn_cvt_pk_f32_fp8((int)p, false), p1 = __builtin_amdgcn_cvt_pk_f32_fp8((int)p, true), q0 = __builtin_amdgcn_cvt_pk_f32_fp8((int)q, false), q1 = __builtin_amdgcn_cvt_pk_f32_fp8((int)q, true);
                    t[0] += (p0[0] + q0[0]) * (1.f / F8_SY); t[1] += (p0[1] + q0[1]) * (1.f / F8_SY); t[2] += (p1[0] + q1[0]) * (1.f / F8_SY); t[3] += (p1[1] + q1[1]) * (1.f / F8_SY); }
#ifdef DBG_SANITIZE
#pragma unroll
                for (int q = 0; q < 4; ++q) if (!(fabsf(t[q]) < 1e30f)) t[q] = 0.f;
#endif
                v[j] = t; s += (t[0] * t[0] + t[1] * t[1]) + (t[2] * t[2] + t[3] * t[3]); }
            const float rstd = 1.0f / sqrtf(wave_sum(s) * (1.f / D) + EPS);
#pragma unroll
            for (int j = 0; j < 4; ++j) xr[64 * j] = v[j] * rstd * gw[j];
        }
    }
#undef IN
#undef SEAM
}

constexpr int NPHASE = 15;
extern "C" void kernel_launch(void* const* d_in, const int* in_sizes, int n_in, void* d_out, int out_size, void* d_ws, size_t ws_size, hipStream_t stream) {
    static int grid = 0;
    if (grid == 0) {
        if (n_in != 32 || out_size != NTOK * D || ws_size < WS_END) { fprintf(stderr, "kernel_launch: unexpected shapes (n_in %d out %d ws %zu)\n", n_in, out_size, ws_size); grid = -1; return; }
        int dev = 0, cus = 0;
        if (hipGetDevice(&dev) != hipSuccess || hipDeviceGetAttribute(&cus, hipDeviceAttributeMultiprocessorCount, dev) != hipSuccess) { grid = -1; return; }
        if (hipFuncSetAttribute((const void*)fwd, hipFuncAttributeMaxDynamicSharedMemorySize, LDS_BYTES) != hipSuccess) { fprintf(stderr, "kernel_launch: hipFuncSetAttribute failed\n"); grid = -1; return; }
        int per_cu = 0;
        if (hipOccupancyMaxActiveBlocksPerMultiprocessor(&per_cu, (const void*)fwd, 512, LDS_BYTES) != hipSuccess || per_cu < 1) { fprintf(stderr, "kernel_launch: occupancy query says %d\n", per_cu); (void)hipGetLastError(); }
        grid = cus;
    }
    if (grid < 0) return;
    hipMemsetAsync((char*)d_ws + WS_CTL, 0, CTL_ZERO_BYTES, stream);
    Args a{};
    for (int i = 0; i < 32; ++i) a.in[i] = (const float*)d_in[i];
    a.out = (float*)d_out; a.ws = (unsigned char*)d_ws;
    if (MK_N_LAUNCHES == 1) { a.ph_lo = 0; a.ph_hi = NPHASE; hipLaunchKernelGGL(fwd, dim3(grid), dim3(512), LDS_BYTES, stream, a); }
    else for (int p = 0; p < NPHASE; ++p) { a.ph_lo = p; a.ph_hi = p + 1; hipLaunchKernelGGL(fwd, dim3(grid), dim3(512), LDS_BYTES, stream, a); }
}
```
